# Optimizing an MI355X kernel written in HIP

```python
import math
import jax, jax.numpy as jnp
from jax import lax
import numpy as np

D_MODEL = 1024
BATCH = 2
SEQ = 16384
DEPTH = 4

CTX_LEN = 256
GRID_W = 64
D_FF = 2816
RG_WIDTH = 512
RG_HEADS = 8
RG_HEAD_DIM = RG_WIDTH // RG_HEADS
RG_C = 8.0
CONV_W = 4
GLA_HEADS = 4
GLA_DK = 64
GLA_DV = 128
GLA_KW = GLA_HEADS * GLA_DK
GLA_VW = GLA_HEADS * GLA_DV
GLA_RANK = 16
GLA_GATE_NORM = 16.0
GLA_CHUNK = 64
MIX_WIDTH = RG_WIDTH + GLA_VW
IN_WIDTH = 2 * RG_WIDTH + 2 * GLA_KW + 2 * GLA_VW + 2 * GLA_RANK
N_MOD = 9
EPS = 1e-6

kernel_name = "hybrid_rglru_gla_macaron_dit"


def rmsnorm(x, g):
    xf = x.astype(jnp.float32)
    y = xf * lax.rsqrt(jnp.mean(xf * xf, axis=-1, keepdims=True) + EPS)
    return (y * g.astype(jnp.float32)).astype(x.dtype)


def ada_in(h, m, g, j):
    return rmsnorm(h, g) * (1 + m[:, 3 * j + 1][:, None]) + m[:, 3 * j][:, None]


def ada_gate(m, j):
    return m[:, 3 * j + 2][:, None]


def swiglu(u, w1, w3, w2):
    return (jax.nn.silu(u @ w1) * (u @ w3)) @ w2


def split_proj(p):
    outs = []
    off = 0
    for w in (RG_WIDTH, RG_WIDTH, GLA_KW, GLA_KW, GLA_VW, GLA_VW, 2 * GLA_RANK):
        outs.append(p[..., off:off + w])
        off += w
    return outs


def short_conv(x, w, b):
    t = x.shape[1]
    xp = jnp.pad(x, ((0, 0), (2, 1), (0, 0)))
    y = xp[:, 0:t] * w[0]
    for k in range(1, CONV_W):
        y = y + xp[:, k:k + t] * w[k]
    return y + b


def _combine(e1, e2):
    a1, b1 = e1
    a2, b2 = e2
    return a1 * a2, a2 * b1 + b2


def linear_scan(a, b, h0, reverse):
    if reverse:
        a, b = a[:, ::-1], b[:, ::-1]
    b = b.at[:, 0].add(a[:, 0] * h0)
    _, h = lax.associative_scan(_combine, (a, b), axis=1)
    return h[:, ::-1] if reverse else h


def rg_lru_dir(xc, h0, lam, wa, ba, wi, bi, reverse):
    bsz, t, _ = xc.shape
    xh = xc.reshape(bsz, t, RG_HEADS, RG_HEAD_DIM)
    r = jax.nn.sigmoid(jnp.einsum('bthi,hij->bthj', xh, wa).reshape(bsz, t, RG_WIDTH) + ba)
    i = jax.nn.sigmoid(jnp.einsum('bthi,hij->bthj', xh, wi).reshape(bsz, t, RG_WIDTH) + bi)
    log_a = -RG_C * r * jax.nn.softplus(-lam)
    a = jnp.exp(log_a)
    inp = jnp.sqrt(-jnp.expm1(2 * log_a)) * (i * xc)
    return linear_scan(a, inp, h0, reverse)


def to_heads(x, n_heads):
    bsz, t, _ = x.shape
    return x.reshape(bsz, t, n_heads, -1).transpose(0, 2, 1, 3)


def col_major(x, rows):
    bsz, h, t, d = x.shape
    return jnp.swapaxes(x.reshape(bsz, h, rows, GRID_W, d), 2, 3).reshape(bsz, h, t, d)


def row_major(x, rows):
    bsz, h, t, d = x.shape
    return jnp.swapaxes(x.reshape(bsz, h, GRID_W, rows, d), 2, 3).reshape(bsz, h, t, d)


def gla_chunked(q, k, v, g, s0):
    bsz, h, t, _ = q.shape
    dv = v.shape[-1]
    n = t // GLA_CHUNK

    def chunks(z):
        return jnp.moveaxis(z.reshape(bsz, h, n, GLA_CHUNK, z.shape[-1]), 2, 0)

    mask = jnp.tril(jnp.ones((GLA_CHUNK, GLA_CHUNK), dtype=bool))[:, :, None]

    def step(s, inp):
        qc, kc, vc, gc = inp
        b = jnp.cumsum(gc, axis=2)
        o_inter = jnp.einsum('bhtk,bhkv->bhtv', qc * jnp.exp(b), s)
        diff = b[:, :, :, None, :] - b[:, :, None, :, :]
        decay = jnp.where(mask, jnp.exp(jnp.minimum(diff, 0.0)), 0.0)
        att = jnp.einsum('bhtk,bhsk,bhtsk->bhts', qc, kc, decay)
        o = o_inter + jnp.einsum('bhts,bhsv->bhtv', att, vc)
        b_last = b[:, :, -1:, :]
        s_new = (jnp.exp(b_last[:, :, 0, :])[..., None] * s
                 + jnp.einsum('bhsk,bhsv->bhkv', kc * jnp.exp(b_last - b), vc))
        return s_new, o

    s_fin, o = lax.scan(step, s0, (chunks(q), chunks(k), chunks(v), chunks(g)))
    return jnp.moveaxis(o, 0, 2).reshape(bsz, h, t, dv), s_fin


def gla_log_gate(lr, wup, bup, d):
    z = lr[..., d * GLA_RANK:(d + 1) * GLA_RANK] @ wup + bup
    return jax.nn.log_sigmoid(z.astype(jnp.float32)) / GLA_GATE_NORM


def gla_out(o, og, gnorm):
    bsz, h, t, dv = o.shape
    o = rmsnorm(o.transpose(0, 2, 1, 3), gnorm.reshape(h, dv)).reshape(bsz, t, h * dv)
    return o.astype(og.dtype) * jax.nn.silu(og)


def mixer(u_c, u_l, w_in, conv_w, conv_b, lam, wa, ba, wi, bi, wup, bup, gnorm, w_out, need_ctx):
    bsz = u_l.shape[0]
    rows = u_l.shape[1] // GRID_W
    xr_c, gr_c, q_c, k_c, v_c, og_c, lr_c = split_proj(u_c @ w_in)
    xr_l, gr_l, q_l, k_l, v_l, og_l, lr_l = split_proj(u_l @ w_in)

    xc_c = short_conv(xr_c, conv_w, conv_b)
    xc_l = short_conv(xr_l, conv_w, conv_b)
    zero_h = jnp.zeros((bsz, RG_WIDTH), xc_c.dtype)
    h_c_dirs, h_l_dirs = [], []
    for d, rev in ((0, False), (1, True)):
        h_c = rg_lru_dir(xc_c, zero_h, lam[d], wa[d], ba[d], wi[d], bi[d], rev)
        h_end = h_c[:, 0] if rev else h_c[:, -1]
        h_l = rg_lru_dir(xc_l, h_end, lam[d], wa[d], ba[d], wi[d], bi[d], rev)
        h_c_dirs.append(h_c)
        h_l_dirs.append(h_l)
    rg_l = jax.nn.gelu(gr_l) * (h_l_dirs[0] + h_l_dirs[1])

    qs = GLA_DK ** -0.5
    hc = (to_heads(q_c * qs, GLA_HEADS), to_heads(k_c, GLA_HEADS), to_heads(v_c, GLA_HEADS))
    hl = tuple(col_major(to_heads(z, GLA_HEADS), rows) for z in (q_l * qs, k_l, v_l))
    s0 = jnp.zeros((bsz, GLA_HEADS, GLA_DK, GLA_DV), jnp.float32)
    o_c_dirs, o_l_dirs = [], []
    for d, rev in ((0, False), (1, True)):
        g_c = to_heads(gla_log_gate(lr_c, wup[d], bup[d], d), GLA_HEADS)
        g_l = col_major(to_heads(gla_log_gate(lr_l, wup[d], bup[d], d), GLA_HEADS), rows)
        ac = hc + (g_c,)
        al = hl + (g_l,)
        if rev:
            ac = tuple(z[:, :, ::-1] for z in ac)
            al = tuple(z[:, :, ::-1] for z in al)
        o_c, s_c = gla_chunked(*ac, s0)
        o_l, _ = gla_chunked(*al, s_c)
        if rev:
            o_c, o_l = o_c[:, :, ::-1], o_l[:, :, ::-1]
        o_c_dirs.append(o_c)
        o_l_dirs.append(o_l)
    gla_l = gla_out(row_major(o_l_dirs[0] + o_l_dirs[1], rows), og_l, gnorm)
    y_l = (jnp.concatenate([rg_l, gla_l.astype(rg_l.dtype)], axis=-1) @ w_out).astype(u_l.dtype)

    y_c = None
    if need_ctx:
        rg_c = jax.nn.gelu(gr_c) * (h_c_dirs[0] + h_c_dirs[1])
        gla_c = gla_out(o_c_dirs[0] + o_c_dirs[1], og_c, gnorm)
        y_c = (jnp.concatenate([rg_c, gla_c.astype(rg_c.dtype)], axis=-1) @ w_out).astype(u_c.dtype)
    return y_c, y_l


def setup_inputs(seed: int = 0) -> dict:
    key = jax.random.key(seed)
    ks = jax.random.split(key, 32)

    def nrm(k, shape, scale):
        return jax.random.normal(k, shape, jnp.float32) * scale

    a0 = jax.random.uniform(ks[13], (DEPTH, 2, RG_WIDTH), jnp.float32, 0.9, 0.999)
    s = a0 ** (1.0 / RG_C)
    rg_lam = jnp.log(s) - jnp.log1p(-s)
    return {
        "x": nrm(ks[0], (BATCH, SEQ, D_MODEL), 1.0),
        "c": nrm(ks[1], (BATCH, D_MODEL), 1.0),
        "ctx": nrm(ks[2], (BATCH, CTX_LEN, D_MODEL), 1.0),
        "c_ctx": nrm(ks[3], (D_MODEL,), 1.0),
        "w_mod": nrm(ks[4], (DEPTH, D_MODEL, N_MOD * D_MODEL), 0.5 * D_MODEL ** -0.5),
        "b_mod": nrm(ks[5], (DEPTH, N_MOD * D_MODEL), 0.02),
        "norm_g": 1.0 + nrm(ks[6], (DEPTH, 3, D_MODEL), 0.02),
        "ffn_w1": nrm(ks[7], (DEPTH, 2, D_MODEL, D_FF), D_MODEL ** -0.5),
        "ffn_w3": nrm(ks[8], (DEPTH, 2, D_MODEL, D_FF), D_MODEL ** -0.5),
        "ffn_w2": nrm(ks[9], (DEPTH, 2, D_FF, D_MODEL), D_FF ** -0.5),
        "w_in": nrm(ks[10], (DEPTH, D_MODEL, IN_WIDTH), D_MODEL ** -0.5),
        "conv_w": nrm(ks[11], (DEPTH, CONV_W, RG_WIDTH), CONV_W ** -0.5),
        "conv_b": nrm(ks[12], (DEPTH, RG_WIDTH), 0.02),
        "rg_lam": rg_lam,
        "rg_wa": nrm(ks[14], (DEPTH, 2, RG_HEADS, RG_HEAD_DIM, RG_HEAD_DIM), RG_HEAD_DIM ** -0.5),
        "rg_ba": nrm(ks[15], (DEPTH, 2, RG_WIDTH), 0.02),
        "rg_wi": nrm(ks[16], (DEPTH, 2, RG_HEADS, RG_HEAD_DIM, RG_HEAD_DIM), RG_HEAD_DIM ** -0.5),
        "rg_bi": nrm(ks[17], (DEPTH, 2, RG_WIDTH), 0.02),
        "gla_wup": nrm(ks[18], (DEPTH, 2, GLA_RANK, GLA_KW), GLA_RANK ** -0.5),
        "gla_bup": nrm(ks[19], (DEPTH, 2, GLA_KW), 0.1),
        "gla_norm_g": 1.0 + nrm(ks[20], (DEPTH, GLA_VW), 0.02),
        "w_out": nrm(ks[21], (DEPTH, MIX_WIDTH, D_MODEL), MIX_WIDTH ** -0.5),
        "final_g": 1.0 + nrm(ks[22], (D_MODEL,), 0.02),
    }


def reference(x, c, ctx, c_ctx, w_mod, b_mod, norm_g, ffn_w1, ffn_w3, ffn_w2, w_in,
              conv_w, conv_b, rg_lam, rg_wa, rg_ba, rg_wi, rg_bi, gla_wup, gla_bup,
              gla_norm_g, w_out, final_g):
    bsz = x.shape[0]
    h_l = x
    h_c = ctx
    sc = jax.nn.silu(c)
    sc_ctx = jax.nn.silu(c_ctx)[None]
    for l in range(DEPTH):
        last = l == DEPTH - 1
        m_l = (sc @ w_mod[l] + b_mod[l]).reshape(bsz, N_MOD, D_MODEL)
        m_c = (sc_ctx @ w_mod[l] + b_mod[l]).reshape(1, N_MOD, D_MODEL)

        h_l = h_l + 0.5 * ada_gate(m_l, 0) * swiglu(ada_in(h_l, m_l, norm_g[l, 0], 0),
                                                     ffn_w1[l, 0], ffn_w3[l, 0], ffn_w2[l, 0])
        h_c = h_c + 0.5 * ada_gate(m_c, 0) * swiglu(ada_in(h_c, m_c, norm_g[l, 0], 0),
                                                     ffn_w1[l, 0], ffn_w3[l, 0], ffn_w2[l, 0])

        u_l = ada_in(h_l, m_l, norm_g[l, 1], 1)
        u_c = ada_in(h_c, m_c, norm_g[l, 1], 1)
        y_c, y_l = mixer(u_c, u_l, w_in[l], conv_w[l], conv_b[l], rg_lam[l], rg_wa[l], rg_ba[l],
                         rg_wi[l], rg_bi[l], gla_wup[l], gla_bup[l], gla_norm_g[l], w_out[l],
                         not last)
        h_l = h_l + ada_gate(m_l, 1) * y_l

        h_l = h_l + 0.5 * ada_gate(m_l, 2) * swiglu(ada_in(h_l, m_l, norm_g[l, 2], 2),
                                                     ffn_w1[l, 1], ffn_w3[l, 1], ffn_w2[l, 1])
        if not last:
            h_c = h_c + ada_gate(m_c, 1) * y_c
            h_c = h_c + 0.5 * ada_gate(m_c, 2) * swiglu(ada_in(h_c, m_c, norm_g[l, 2], 2),
                                                         ffn_w1[l, 1], ffn_w3[l, 1], ffn_w2[l, 1])
    return rmsnorm(h_l, final_g)
```

```cpp
#include <hip/hip_runtime.h>
#include <hip/hip_cooperative_groups.h>
#include <cstdio>
#include <cstdint>
namespace cg = cooperative_groups;
namespace pg8 {
#define PG8_LAS __attribute__((address_space(3)))
typedef unsigned short bf16_t;
typedef short bf16x8 __attribute__((ext_vector_type(8)));
typedef float f32x4 __attribute__((ext_vector_type(4)));
typedef unsigned u32x4 __attribute__((ext_vector_type(4)));
constexpr int BM = 256, BK = 64, HALF = 128, HTB = HALF * BK * 2  , STAGE_BYTES = 8 * HTB, NXCD = 8, WGM = 8;

__host__ __device__ __forceinline__ int lds_byte(int r, int c) { const int st = (r >> 4) * 2 + (c >> 5), rr = r & 15, cc = c & 31, ob = rr * 64 + cc * 2; return st * 1024 + (ob ^ (((ob >> 9) & 1) << 5)); }
__host__ __device__ __forceinline__ void stage_rc(int b, int& R, int& C) { const int st = b / 1024, sb = b % 1024, swz = sb ^ (((sb >> 9) & 1) << 5); R = (st >> 1) * 16 + swz / 64; C = (st & 1) * 32 + (swz % 64) / 2; }
__host__ __device__ __forceinline__ int perm32(int rho) { const int n = rho >> 4, i = rho & 15; return 8 * (i >> 2) + 4 * n + (i & 3); }

struct Unit { int pm, pn, kb, nk; };
struct Gemm { const bf16_t* A; const bf16_t* Bt; int M, N, K, ldk; };

struct StaticOrder {
    int nM, nN, nwg, G, c;
    __host__ __device__ void init(int M, int N, int G_, int c_) { nM = M / BM; nN = N / BM; nwg = nM * nN; G = G_; c = c_; }
    __host__ __device__ bool next(int i, Unit& u) const {
        const long L = (long)i * G + c; if (L >= nwg) return false;
        int wgid = (int)L; { const int q = nwg / NXCD, r = nwg % NXCD, xcd = wgid % NXCD, off = wgid / NXCD; wgid = (xcd < r ? xcd * (q + 1) : r * (q + 1) + (xcd - r) * q) + off; }
        const int nig = WGM * nN, gid = wgid / nig, fm = gid * WGM, gsz = (nM - fm) < WGM ? (nM - fm) : WGM;
        u.pm = fm + ((wgid % nig) % gsz); u.pn = (wgid % nig) / gsz; u.kb = 0; u.nk = 0; return true;
    }
    __device__ __forceinline__ void a_ready(const Unit&) const {}
    __device__ __forceinline__ void done(const Unit&) const {}
};
struct SplitKOrder {
    int pm0, nN, nsplit, kc, nun, G, c;
    __host__ __device__ void init(int pm0_, int nM_, int nN_, int nsplit_, int kc_, int G_, int c_) { pm0 = pm0_; nN = nN_; nsplit = nsplit_; kc = kc_; nun = nM_ * nN_ * nsplit_; G = G_; c = c_; }
    __host__ __device__ bool next(int i, Unit& u) const {
        const int L = i * G + c; if (L >= nun) return false;
        const int tile = L / nsplit, ks = L - tile * nsplit;
        u.pm = pm0 + tile / nN; u.pn = tile % nN; u.kb = ks * kc; u.nk = kc / BK; return true;
    }
    __device__ __forceinline__ void a_ready(const Unit&) const {}
    __device__ __forceinline__ void done(const Unit&) const {}
};
__device__ __forceinline__ unsigned cvt_pk_bf16(float lo, float hi) { unsigned r; asm volatile("v_cvt_pk_bf16_f32 %0, %1, %2" : "=v"(r) : "v"(lo), "v"(hi)); return r; }
template <class Epi, class Sched, bool ALIGN_EPI = false, bool SP2 = false>
__device__ __forceinline__ void gemm_phase(PG8_LAS unsigned char* lds, const Gemm g, const Sched& S, const Epi& E, int tid_in) {
    int tid = tid_in; asm volatile("" : "+v"(tid));
    const int wid = __builtin_amdgcn_readfirstlane(tid >> 6), lane = tid & 63, wr = wid >> 2, wc = wid & 3, fr = lane & 15, fq = lane >> 4;
    const int K = g.ldk, nt_all = g.K / BK;
    unsigned voffA[2], voffB[2];
#pragma unroll
    for (int i = 0; i < 2; ++i) { int R, C; stage_rc(tid * 16 + i * 8192, R, C); const int Rb = Epi::PERM ? ((R & ~31) + perm32(R & 31)) : R;
        voffA[i] = (unsigned)(R * K + C) * 2u; voffB[i] = (unsigned)(Rb * K + C) * 2u; }
    const size_t kstep = (size_t)(BK * 2);
    const size_t hstep = (size_t)HALF * K * 2;
    const size_t tstep = 2 * hstep;
    const unsigned ldsw = (unsigned)wid * 1024u;
    const int aoff = lds_byte(wr * 64 + fr, fq * 8), boff = lds_byte(wc * 32 + fr, fq * 8);
#define PG8_SA(b, h) (((b) * 2 + (h)) * HTB)
#define PG8_SB(b, h) ((4 + (b) * 2 + (h)) * HTB)
#define PG8_STAGE(bufoff, gbase, voff) do { _Pragma("unroll") for (int _i = 0; _i < 2; ++_i) \
        __builtin_amdgcn_global_load_lds((const unsigned*)((const char*)(gbase) + (voff)[_i]), (PG8_LAS unsigned*)(lds + (bufoff) + ldsw + _i * 8192), 16, 0, 0); } while (0)
#define PG8_LDA(dst, b, h) do { _Pragma("unroll") for (int m = 0; m < 4; ++m) _Pragma("unroll") for (int k = 0; k < 2; ++k) dst[m][k] = *(const PG8_LAS bf16x8*)(lds + PG8_SA(b, h) + aoff + m * 2048 + k * 1024); } while (0)
#define PG8_LDB(dst, b, h) do { _Pragma("unroll") for (int n = 0; n < 2; ++n) _Pragma("unroll") for (int k = 0; k < 2; ++k) dst[n][k] = *(const PG8_LAS bf16x8*)(lds + PG8_SB(b, h) + boff + n * 2048 + k * 1024); } while (0)
#define PG8_MMA(ai, bj, At, Bt) do { __builtin_amdgcn_s_setprio(1); _Pragma("unroll") for (int m = 0; m < 4; ++m) _Pragma("unroll") for (int n = 0; n < 2; ++n) _Pragma("unroll") for (int k = 0; k < 2; ++k) \
        acc[ai][bj][m][n] = __builtin_amdgcn_mfma_f32_16x16x32_bf16(Bt[n][k], At[m][k], acc[ai][bj][m][n], 0, 0, 0); __builtin_amdgcn_s_setprio(0); } while (0)
#define PG8_WAIT_V(n) asm volatile("s_waitcnt vmcnt(" #n ")" ::: "memory")
#define PG8_WAIT_L(n) asm volatile("s_waitcnt lgkmcnt(" #n ")" ::: "memory")
#define PG8_BAR __builtin_amdgcn_s_barrier()
#define PG8_SCHED __builtin_amdgcn_sched_barrier(0)
    Unit cur, nxt; int ui = 0;
    if (!S.next(0, cur)) return;
    f32x4 acc[2][2][4][2];
#pragma unroll
    for (int a = 0; a < 2; ++a)
#pragma unroll
        for (int b = 0; b < 2; ++b)
#pragma unroll
            for (int m = 0; m < 4; ++m)
#pragma unroll
                for (int n = 0; n < 2; ++n) acc[a][b][m][n] = (f32x4){0.f, 0.f, 0.f, 0.f};
    bf16x8 At[4][2], B0[2][2], B1[2][2];
    const char* cA = (const char*)g.A + (size_t)cur.pm * tstep + (size_t)cur.kb * 2; const char* cB = (const char*)g.Bt + (size_t)cur.pn * tstep + (size_t)cur.kb * 2;
    S.a_ready(cur);
    if constexpr (SP2) {
        PG8_STAGE(PG8_SB(0, 0), cB, voffB); PG8_STAGE(PG8_SB(0, 1), cB + hstep, voffB); PG8_STAGE(PG8_SA(0, 0), cA, voffA); PG8_STAGE(PG8_SA(0, 1), cA + hstep, voffA);
        if (wr == 1) PG8_BAR;
        PG8_WAIT_V(2); PG8_BAR;
        PG8_STAGE(PG8_SB(1, 0), cB + kstep, voffB); PG8_STAGE(PG8_SA(1, 0), cA + kstep, voffA); PG8_STAGE(PG8_SB(1, 1), cB + hstep + kstep, voffB);
        PG8_WAIT_V(6); PG8_BAR;
    } else {
        PG8_STAGE(PG8_SB(0, 0), cB, voffB); PG8_STAGE(PG8_SA(0, 0), cA, voffA); PG8_STAGE(PG8_SB(0, 1), cB + hstep, voffB); PG8_STAGE(PG8_SA(0, 1), cA + hstep, voffA);
        if (wr == 1) PG8_BAR;
        PG8_WAIT_V(4); PG8_BAR;
        PG8_STAGE(PG8_SB(1, 0), cB + kstep, voffB); PG8_STAGE(PG8_SA(1, 0), cA + kstep, voffA); PG8_STAGE(PG8_SB(1, 1), cB + hstep + kstep, voffB);
        PG8_WAIT_V(6); PG8_BAR;
    }
    for (;;) {
        const bool has_next = S.next(ui + 1, nxt);
        const char* nA = has_next ? (const char*)g.A + (size_t)nxt.pm * tstep + (size_t)nxt.kb * 2 : cA; const char* nB = has_next ? (const char*)g.Bt + (size_t)nxt.pn * tstep + (size_t)nxt.kb * 2 : cB;
        const int nt = cur.nk ? cur.nk : nt_all;
        for (int t = 0; t < nt; t += 2) {
            const bool last = (t == nt - 2);
            const char* a1 = cA + (size_t)(t + 1) * kstep;
            const char* a2 = last ? nA : cA + (size_t)(t + 2) * kstep; const char* b2 = last ? nB : cB + (size_t)(t + 2) * kstep;
            const char* a3 = a2 + kstep; const char* b3 = b2 + kstep;
            if (last && has_next) S.a_ready(nxt);
            if constexpr (SP2) {
            PG8_LDB(B0, 0, 0); PG8_LDB(B1, 0, 1); PG8_SCHED; PG8_LDA(At, 0, 0); PG8_STAGE(PG8_SA(1, 1), a1 + hstep, voffA);
            PG8_WAIT_V(8); PG8_WAIT_L(0); PG8_BAR; PG8_MMA(0, 0, At, B0); PG8_MMA(0, 1, At, B1); PG8_BAR; PG8_SCHED;
            PG8_LDA(At, 0, 1); PG8_STAGE(PG8_SB(0, 0), b2, voffB); PG8_STAGE(PG8_SB(0, 1), b2 + hstep, voffB); PG8_STAGE(PG8_SA(0, 0), a2, voffA);
            PG8_WAIT_V(8); PG8_WAIT_L(0); PG8_BAR; PG8_MMA(1, 0, At, B0); PG8_MMA(1, 1, At, B1); PG8_BAR; PG8_SCHED;
            PG8_LDB(B0, 1, 0); PG8_LDB(B1, 1, 1); PG8_SCHED; PG8_LDA(At, 1, 0); PG8_STAGE(PG8_SA(0, 1), a2 + hstep, voffA);
            PG8_WAIT_V(8); PG8_WAIT_L(0); PG8_BAR; PG8_MMA(0, 0, At, B0); PG8_MMA(0, 1, At, B1); PG8_BAR; PG8_SCHED;
            PG8_LDA(At, 1, 1); PG8_STAGE(PG8_SB(1, 0), b3, voffB); PG8_STAGE(PG8_SB(1, 1), b3 + hstep, voffB); PG8_STAGE(PG8_SA(1, 0), a3, voffA);
            PG8_WAIT_V(8); PG8_WAIT_L(0); PG8_BAR; PG8_MMA(1, 0, At, B0); PG8_MMA(1, 1, At, B1); PG8_BAR; PG8_SCHED;
            } else {
            PG8_LDB(B0, 0, 0); PG8_SCHED; PG8_LDA(At, 0, 0); PG8_STAGE(PG8_SA(1, 1), a1 + hstep, voffA);
            PG8_WAIT_L(8); PG8_BAR; PG8_WAIT_L(0); PG8_MMA(0, 0, At, B0); PG8_BAR; PG8_SCHED;
            PG8_LDB(B1, 0, 1); PG8_STAGE(PG8_SB(0, 0), b2, voffB);
            PG8_BAR; PG8_WAIT_L(0); PG8_MMA(0, 1, At, B1); PG8_BAR;
            PG8_LDA(At, 0, 1); PG8_STAGE(PG8_SA(0, 0), a2, voffA);
            PG8_BAR; PG8_WAIT_L(0); PG8_MMA(1, 0, At, B0); PG8_BAR; PG8_SCHED;
            PG8_STAGE(PG8_SB(0, 1), b2 + hstep, voffB);
            PG8_WAIT_V(6); PG8_BAR; PG8_MMA(1, 1, At, B1); PG8_BAR;
            PG8_LDB(B0, 1, 0); PG8_SCHED; PG8_LDA(At, 1, 0); PG8_STAGE(PG8_SA(0, 1), a2 + hstep, voffA);
            PG8_WAIT_L(8); PG8_BAR; PG8_WAIT_L(0); PG8_MMA(0, 0, At, B0); PG8_BAR; PG8_SCHED;
            PG8_LDB(B1, 1, 1); PG8_STAGE(PG8_SB(1, 0), b3, voffB);
            PG8_BAR; PG8_WAIT_L(0); PG8_MMA(0, 1, At, B1); PG8_BAR;
            PG8_LDA(At, 1, 1); PG8_STAGE(PG8_SA(1, 0), a3, voffA);
            PG8_BAR; PG8_WAIT_L(0); PG8_MMA(1, 0, At, B0); PG8_BAR; PG8_SCHED;
            PG8_STAGE(PG8_SB(1, 1), b3 + hstep, voffB);
            PG8_WAIT_V(6); PG8_BAR; PG8_MMA(1, 1, At, B1); PG8_BAR;
            }
        }
        if constexpr (ALIGN_EPI) { if (wr == 0) PG8_BAR; }
        if constexpr (!Epi::AFTER_DRAIN) { E(acc, cur, wr, wc, fr, fq); S.done(cur); }
        if (!has_next) break;
#pragma unroll
        for (int a = 0; a < 2; ++a)
#pragma unroll
            for (int b = 0; b < 2; ++b)
#pragma unroll
                for (int m = 0; m < 4; ++m)
#pragma unroll
                    for (int n = 0; n < 2; ++n) acc[a][b][m][n] = (f32x4){0.f, 0.f, 0.f, 0.f};
        cur = nxt; cA = nA; cB = nB; ++ui;
        if constexpr (ALIGN_EPI) { if (wr == 1) PG8_BAR; }
    }
    PG8_WAIT_V(0);
    if constexpr (!ALIGN_EPI) { if (wr == 0) PG8_BAR; }
    PG8_BAR;
    if constexpr (Epi::AFTER_DRAIN) { E.fused(acc, cur, wr, wc, fr, fq, lds, wid, lane); S.done(cur); }
#undef PG8_SA
#undef PG8_SB
#undef PG8_STAGE
#undef PG8_LDA
#undef PG8_LDB
#undef PG8_MMA
#undef PG8_WAIT_V
#undef PG8_WAIT_L
#undef PG8_BAR
#undef PG8_SCHED
}
}

#define LAS __attribute__((address_space(3)))
typedef unsigned short bf16_t;
typedef short bf16x8 __attribute__((ext_vector_type(8)));
typedef float f32x4 __attribute__((ext_vector_type(4)));
typedef unsigned u32x4 __attribute__((ext_vector_type(4)));
typedef unsigned u32x2 __attribute__((ext_vector_type(2)));
typedef __bf16 bf16x2_t __attribute__((ext_vector_type(2)));

constexpr int DM = 1024, DFF = 2816, NLAYER = 4, NMOD = 9;
constexpr int TL = 32768, TC = 512, TT = TL + TC;
constexpr int PW = 2816;
constexpr int NCH = 260;
constexpr int LDS_BYTES = 155648;
constexpr int NTHREADS = 512;

constexpr size_t MiB = 1u << 20;
constexpr size_t WS_MOD = 0, WS_HCTX = 1 * MiB, WS_WG = 3 * MiB, WS_RGA = 4 * MiB, WS_RGH = 7 * MiB, WS_RGC = 10 * MiB, WS_GLD = 13 * MiB,
                 WS_BAR = 15 * MiB, WS_W13 = 16 * MiB, WS_W2 = 38 * MiB, WS_WIN = 49 * MiB, WS_WOUT = 55 * MiB, WS_U = 58 * MiB, WS_MIX = 123 * MiB,
                 WS_GP = 188 * MiB, WS_QK = 367 * MiB, WS_GLS = 432 * MiB, WS_PART = 562 * MiB, WS_SS = 585 * MiB, WS_BIAS = 588 * MiB, WS_RS = 588 * MiB + 512 * 1024, WS_END = 589 * MiB;

struct Params {
    const float *x, *c, *ctx, *c_ctx, *w_mod, *b_mod, *norm_g, *ffn_w1, *ffn_w3, *ffn_w2, *w_in, *conv_w, *conv_b, *rg_lam, *rg_wa, *rg_ba, *rg_wi, *rg_bi,
        *gla_wup, *gla_bup, *gla_norm_g, *w_out, *final_g;
    float* out; unsigned char* ws;
};

typedef const __attribute__((address_space(4))) Params& PREF;
#define WAVE_SYNC() asm volatile("s_waitcnt lgkmcnt(0)" ::: "memory")

__device__ __forceinline__ unsigned f2bf(float f) { unsigned r; asm("v_cvt_pk_bf16_f32 %0, %1, %1" : "=v"(r) : "v"(f)); return r & 0xffffu; }
__device__ __forceinline__ unsigned pk2(float lo, float hi) { unsigned r; asm("v_cvt_pk_bf16_f32 %0, %1, %2" : "=v"(r) : "v"(lo), "v"(hi)); return r; }
__device__ __forceinline__ float bf2f(unsigned h) { return __builtin_bit_cast(float, h << 16); }
__device__ __forceinline__ float rcpf_(float x) { return __builtin_amdgcn_rcpf(x); }
__device__ __forceinline__ float sigmoid_f(float x) { return rcpf_(1.f + __expf(-x)); }
__device__ __forceinline__ float silu_f(float x) { return x * sigmoid_f(x); }
__device__ __forceinline__ float gelu_tanh_f(float x) { const float y = 0.7978845608028654f * (x + 0.044715f * x * x * x); return x * sigmoid_f(2.f * y); }
__device__ __forceinline__ float shx(float v, int m, int lane) { return __builtin_bit_cast(float, __builtin_amdgcn_ds_bpermute((lane ^ m) << 2, __builtin_bit_cast(int, v))); }
__device__ __forceinline__ float wave_sum(float v, int lane) {
#pragma unroll
    for (int o = 1; o < 64; o <<= 1) v += shx(v, o, lane);
    return v;
}
__device__ __forceinline__ f32x4 mfma16(bf16x8 a, bf16x8 b, f32x4 c) { return __builtin_amdgcn_mfma_f32_16x16x32_bf16(a, b, c, 0, 0, 0); }

__device__ __forceinline__ float row_rs(const float* rsv, int row) { return rsv[row]; }
struct EpiSwiglu {
    static constexpr bool PERM = true, AFTER_DRAIN = false;
    bf16_t* G; const float* ss; const float* bias;
    __device__ __forceinline__ void operator()(const f32x4 (&acc)[2][2][4][2], const pg8::Unit& u, int wr, int wc, int fr, int fq) const {
        asm volatile("" : "+v"(fr), "+v"(fq));
        const int row0 = u.pm * 256 + wr * 64 + fr, col0 = u.pn * 128 + wc * 32 + 8 * fq;
        const float* bp = bias + (size_t)((u.pm * 256) >> 14) * 5632 + col0;
        const f32x4 c10 = *(const f32x4*)bp, c11 = *(const f32x4*)(bp + 4), c30 = *(const f32x4*)(bp + 2816), c31 = *(const f32x4*)(bp + 2816 + 4);
#pragma unroll
        for (int ai = 0; ai < 2; ++ai)
#pragma unroll
            for (int m = 0; m < 4; ++m) {
                const int row = row0 + ai * 128 + m * 16; const float rs = row_rs(ss, row);
                const f32x4 a0 = acc[ai][0][m][0] * rs + c10, a1 = acc[ai][0][m][1] * rs + c11, b0 = acc[ai][1][m][0] * rs + c30, b1 = acc[ai][1][m][1] * rs + c31;
                u32x4 w;
                w.x = pk2(silu_f(a0[0]) * b0[0], silu_f(a0[1]) * b0[1]); w.y = pk2(silu_f(a0[2]) * b0[2], silu_f(a0[3]) * b0[3]);
                w.z = pk2(silu_f(a1[0]) * b1[0], silu_f(a1[1]) * b1[1]); w.w = pk2(silu_f(a1[2]) * b1[2], silu_f(a1[3]) * b1[3]);
                *(u32x4*)(G + (size_t)row * PW + col0) = w;
            }
    }
};
struct EpiStore {
    static constexpr bool PERM = true, AFTER_DRAIN = false;
    bf16_t* O; int ldc; const float* ss; const float* bias;
    __device__ __forceinline__ void operator()(const f32x4 (&acc)[2][2][4][2], const pg8::Unit& u, int wr, int wc, int fr, int fq) const {
        asm volatile("" : "+v"(fr), "+v"(fq));
        const int row0 = u.pm * 256 + wr * 64 + fr, col0 = u.pn * 256 + wc * 32 + 8 * fq;
        const float* bp = bias + (size_t)((u.pm * 256) >> 14) * 5632 + col0;
        f32x4 cb[2][2];
#pragma unroll
        for (int bj = 0; bj < 2; ++bj) { cb[bj][0] = *(const f32x4*)(bp + bj * 128); cb[bj][1] = *(const f32x4*)(bp + bj * 128 + 4); }
#pragma unroll
        for (int ai = 0; ai < 2; ++ai)
#pragma unroll
            for (int m = 0; m < 4; ++m) {
                const int row = row0 + ai * 128 + m * 16; const float rs = row_rs(ss, row);
#pragma unroll
                for (int bj = 0; bj < 2; ++bj) {
                    const f32x4 v0 = acc[ai][bj][m][0] * rs + cb[bj][0], v1 = acc[ai][bj][m][1] * rs + cb[bj][1];
                    u32x4 w; w.x = pk2(v0[0], v0[1]); w.y = pk2(v0[2], v0[3]); w.z = pk2(v1[0], v1[1]); w.w = pk2(v1[2], v1[3]);
                    *(u32x4*)(O + (size_t)row * ldc + col0 + bj * 128) = w;
                }
            }
    }
};
struct EpiResid {
    static constexpr bool PERM = true, AFTER_DRAIN = false;
    const float* hin_lat; float* hout_lat; unsigned char* wsb; const float* gate; const float* ngn; const float* scn; float coef; int emit;
    __device__ __forceinline__ void operator()(const f32x4 (&acc)[2][2][4][2], const pg8::Unit& u, int wr, int wc, int fr, int fq) const {
        asm volatile("" : "+v"(fr), "+v"(fq));
        float* const hout_ctx = (float*)(wsb + WS_HCTX); float* const part = (float*)(wsb + WS_PART); bf16_t* const Un = emit ? (bf16_t*)(wsb + WS_U) : (bf16_t*)nullptr; float* const ssn = (float*)(wsb + WS_SS);
        const int rowt = u.pm * 256; const int grp = rowt >> 14;
        const bool isctx = rowt >= TL;
        if (isctx) {
            const int row0 = rowt - TL + wr * 64 + fr, col0 = u.pn * 256 + wc * 32 + 8 * fq;
            const float* gp = gate + (size_t)2 * (NMOD * DM) + col0;
            float* pb = part + (size_t)(u.kb >> 8) * (TC * DM);
#pragma unroll
            for (int bj = 0; bj < 2; ++bj) {
                const f32x4 g0 = *(const f32x4*)(gp + bj * 128) * coef, g1 = *(const f32x4*)(gp + bj * 128 + 4) * coef;
#pragma unroll
                for (int ai = 0; ai < 2; ++ai)
#pragma unroll
                    for (int m = 0; m < 4; ++m) {
                        float* o = pb + (size_t)(row0 + ai * 128 + m * 16) * DM + col0 + bj * 128;
                        *(f32x4*)o = g0 * acc[ai][bj][m][0]; *(f32x4*)(o + 4) = g1 * acc[ai][bj][m][1];
                    }
            }
            return;
        }
        const float* hin = hin_lat; float* hout = hout_lat;
        const int row0 = rowt + wr * 64 + fr, col0 = u.pn * 256 + wc * 32 + 8 * fq;
        const float* gp = gate + (size_t)grp * (NMOD * DM) + col0;
        float sq[2][4];
#pragma unroll
        for (int ai = 0; ai < 2; ++ai)
#pragma unroll
            for (int m = 0; m < 4; ++m) sq[ai][m] = 0.f;
#pragma unroll
        for (int bj = 0; bj < 2; ++bj) {
            const f32x4 g0 = *(const f32x4*)(gp + bj * 128) * coef, g1 = *(const f32x4*)(gp + bj * 128 + 4) * coef;
            f32x4 s0 = {0.f, 0.f, 0.f, 0.f}, s1 = s0;
            if (Un) { const float* np_ = ngn + col0 + bj * 128; const float* sp_ = scn + (size_t)grp * (NMOD * DM) + col0 + bj * 128;
                s0 = *(const f32x4*)np_ * (*(const f32x4*)sp_ + 1.f); s1 = *(const f32x4*)(np_ + 4) * (*(const f32x4*)(sp_ + 4) + 1.f); }
#pragma unroll
            for (int ai = 0; ai < 2; ++ai)
#pragma unroll
                for (int m = 0; m < 4; ++m) {
                    const size_t off = (size_t)(row0 + ai * 128 + m * 16) * DM + col0 + bj * 128;
                    const f32x4 h0 = *(const f32x4*)(hin + off) + g0 * acc[ai][bj][m][0], h1 = *(const f32x4*)(hin + off + 4) + g1 * acc[ai][bj][m][1];
                    *(f32x4*)(hout + off) = h0;
                    *(f32x4*)(hout + off + 4) = h1;
                    if (Un) {
                        sq[ai][m] += ((h0[0] * h0[0] + h0[1] * h0[1]) + (h0[2] * h0[2] + h0[3] * h0[3])) + ((h1[0] * h1[0] + h1[1] * h1[1]) + (h1[2] * h1[2] + h1[3] * h1[3]));
                        const f32x4 u0 = h0 * s0, u1 = h1 * s1;
                        u32x4 w; w.x = pk2(u0[0], u0[1]); w.y = pk2(u0[2], u0[3]); w.z = pk2(u1[0], u1[1]); w.w = pk2(u1[2], u1[3]);
                        *(u32x4*)(Un + off) = w;
                    }
                }
        }
        if (Un) {
#pragma unroll
            for (int ai = 0; ai < 2; ++ai)
#pragma unroll
                for (int m = 0; m < 4; ++m) { float t = sq[ai][m]; t += shx(t, 16, fq * 16 + fr); t += shx(t, 32, fq * 16 + fr);
                    if (fq == 0) ssn[(size_t)(row0 + ai * 128 + m * 16) * 16 + u.pn * 4 + wc] = t; }
        }
    }
};

struct DownOrder {
    pg8::StaticOrder so; pg8::SplitKOrder sk; int nlat, nctx, inv;
    __device__ bool next(int i, pg8::Unit& u) const {
        const int L = i * so.G + so.c;
        if (L < nlat) return so.next(i, u);
        const int Lc = L - nlat; if (Lc >= nctx) return false;
        const int tile = (Lc * inv) >> 16, ks = Lc - tile * sk.nsplit;
        u.pm = sk.pm0 + (tile >> 2); u.pn = tile & 3; u.kb = ks * 256; u.nk = 4; return true;
    }
    __device__ __forceinline__ void a_ready(const pg8::Unit&) const {}
    __device__ __forceinline__ void done(const pg8::Unit&) const {}
};

__device__ __forceinline__ void transpose_item(const float* __restrict__ W, int K, int ldn, bf16_t* __restrict__ WT, int drow, int k0, int n0, LAS float* scr, int lane) {
    float wv[32];
#pragma unroll
    for (int i = 0; i < 32; ++i) { const int kk = 2 * i + (lane >> 5); wv[i] = W[(size_t)(k0 + kk) * ldn + n0 + (lane & 31)]; }
#pragma unroll
    for (int i = 0; i < 32; ++i) { const int kk = 2 * i + (lane >> 5); scr[kk * 33 + (lane & 31)] = wv[i]; }
    WAVE_SYNC();
    const int c = lane & 7;
#pragma unroll
    for (int j = 0; j < 4; ++j) { const int n = (lane >> 3) + 8 * j; const LAS float* s = scr + (8 * c) * 33 + n;
        u32x4 o; o.x = pk2(s[0 * 33], s[1 * 33]); o.y = pk2(s[2 * 33], s[3 * 33]); o.z = pk2(s[4 * 33], s[5 * 33]); o.w = pk2(s[6 * 33], s[7 * 33]);
        *(u32x4*)(WT + (size_t)(drow + n0 + n) * K + k0 + 8 * c) = o; }
    WAVE_SYNC();
}

__device__ __forceinline__ void convert_weights(PREF p, int l, LAS unsigned char* lds, int gw, int NGW, int wave, int lane) {
    LAS float* scr = (LAS float*)(lds + wave * 16384);
    unsigned char* ws = p.ws;
    bf16_t* W13 = (bf16_t*)(ws + WS_W13); bf16_t* W2 = (bf16_t*)(ws + WS_W2); bf16_t* WIN = (bf16_t*)(ws + WS_WIN); bf16_t* WOUT = (bf16_t*)(ws + WS_WOUT);
    constexpr int I_UP = 16 * 88, I_DN = 44 * 32, I_IN = 16 * 81, I_OUT = 16 * 32;
    constexpr int NIT = 4 * I_UP + 2 * I_DN + I_IN + I_OUT;
    for (int it = gw; it < NIT; it += NGW) {
        int r = it;
        if (r < 4 * I_UP) { const int seg = r / I_UP; r -= seg * I_UP; const int f = seg >> 1, is3 = seg & 1;
            const int kb = r / 88, nb = r % 88, n0 = nb * 32;
            const float* W = (is3 ? p.ffn_w3 : p.ffn_w1) + (size_t)(l * 2 + f) * DM * DFF;
            transpose_item(W, DM, DFF, W13 + (size_t)f * 5632 * DM, (n0 >> 7) * 256 + (n0 & 127) + is3 * 128 - n0, kb * 64, n0, scr, lane); continue; }
        r -= 4 * I_UP;
        if (r < 2 * I_DN) { const int f = r / I_DN; r -= f * I_DN; const int kb = r / 32, nb = r % 32;
            transpose_item(p.ffn_w2 + (size_t)(l * 2 + f) * DFF * DM, DFF, DM, W2 + (size_t)f * DM * DFF, 0, kb * 64, nb * 32, scr, lane); continue; }
        r -= 2 * I_DN;
        if (r < I_IN) { const int kb = r / 81, nb = r % 81;
            transpose_item(p.w_in + (size_t)l * DM * 2592, DM, 2592, WIN, 0, kb * 64, nb * 32, scr, lane); continue; }
        r -= I_IN;
        { const int kb = r / 32, nb = r % 32; transpose_item(p.w_out + (size_t)l * DM * DM, DM, DM, WOUT, 0, kb * 64, nb * 32, scr, lane); }
    }
}

__device__ __forceinline__ void phase_mods(PREF p, LAS unsigned char* lds, int tid, int wave, int lane) {
    LAS float* sS = (LAS float*)lds;
    LAS float* red = (LAS float*)(lds + 12288);
    float* mod = (float*)(p.ws + WS_MOD);
    for (int i = tid; i < 3072; i += NTHREADS) { const int g = i >> 10, k = i & 1023; const float xv = g < 2 ? p.c[g * 1024 + k] : p.c_ctx[k]; sS[i] = silu_f(xv); }
    __syncthreads();
    for (int item = blockIdx.x; item < NLAYER * 144; item += gridDim.x) {
        const int l = item / 144, nc = item % 144;
        const float* W = p.w_mod + (size_t)l * DM * (NMOD * DM) + nc * 64 + lane;
        float a0 = 0.f, a1 = 0.f, a2 = 0.f; const int k0 = wave * 128;
#pragma unroll 16
        for (int kk = 0; kk < 128; ++kk) { const int k = k0 + kk; const float w = W[(size_t)k * (NMOD * DM)]; a0 += sS[k] * w; a1 += sS[1024 + k] * w; a2 += sS[2048 + k] * w; }
        red[(wave * 3 + 0) * 64 + lane] = a0; red[(wave * 3 + 1) * 64 + lane] = a1; red[(wave * 3 + 2) * 64 + lane] = a2;
        __syncthreads();
        if (wave < 3) { float s = p.b_mod[l * (NMOD * DM) + nc * 64 + lane];
#pragma unroll
            for (int w = 0; w < 8; ++w) s += red[(w * 3 + wave) * 64 + lane];
            mod[(size_t)(l * 3 + wave) * (NMOD * DM) + nc * 64 + lane] = s; }
        __syncthreads();
    }
}

__device__ __forceinline__ void phase_gatew(PREF p, int gtid, int gthreads) {
    bf16_t* WgT = (bf16_t*)(p.ws + WS_WG);
    for (int e = gtid; e < NLAYER * 2 * 2 * 8 * 4096; e += gthreads) {
        const int i = e & 63, j = (e >> 6) & 63, h = (e >> 12) & 7, ty = (e >> 15) & 1, d = (e >> 16) & 1, l = e >> 17;
        const float* src = ty ? p.rg_wi : p.rg_wa;
        WgT[e] = (bf16_t)f2bf(src[(size_t)((l * 2 + d) * 8 + h) * 4096 + i * 64 + j]);
    }
}

__device__ __forceinline__ void phase_norm(PREF p, int l, int jn, int rbeg, int rend, bool first, int nsplit, int gw, int NGW, int lane) {
    const float* mod = (const float*)(p.ws + WS_MOD); const float* hctx = (const float*)(p.ws + WS_HCTX); bf16_t* U = (bf16_t*)(p.ws + WS_U); float* SS = (float*)(p.ws + WS_SS);
    const float* ng = p.norm_g + (size_t)(l * 3 + jn) * DM;
    for (int row = rbeg + gw; row < rend; row += NGW) {
        const float* src = row < TL ? ((first ? p.x : p.out) + (size_t)row * DM) : ((first ? p.ctx : hctx) + (size_t)(row - TL) * DM);
        const float* mb = mod + (size_t)(l * 3 + (row >> 14)) * (NMOD * DM);
        f32x4 v[4]; float ss = 0.f;
#pragma unroll
        for (int j = 0; j < 4; ++j) v[j] = *(const f32x4*)(src + 4 * lane + 256 * j);
        if (row >= TL && nsplit > 0) {
            const float* pr = (const float*)(p.ws + WS_PART) + (size_t)(row - TL) * DM + 4 * lane;
            for (int k = 0; k < nsplit; ++k)
#pragma unroll
                for (int j = 0; j < 4; ++j) v[j] += *(const f32x4*)(pr + (size_t)k * (TC * DM) + 256 * j);
            float* dst = (float*)(p.ws + WS_HCTX) + (size_t)(row - TL) * DM + 4 * lane;
#pragma unroll
            for (int j = 0; j < 4; ++j) *(f32x4*)(dst + 256 * j) = v[j];
        }
#pragma unroll
        for (int j = 0; j < 4; ++j) ss += (v[j][0] * v[j][0] + v[j][1] * v[j][1]) + (v[j][2] * v[j][2] + v[j][3] * v[j][3]);
        ss = wave_sum(ss, lane);
        if (lane == 0) ((float*)(p.ws + WS_RS))[row] = __builtin_amdgcn_rsqf(ss * (1.f / DM) + 1e-6f);
#pragma unroll
        for (int j = 0; j < 4; ++j) { const int col = 4 * lane + 256 * j;
            const f32x4 g = *(const f32x4*)(ng + col), sc = *(const f32x4*)(mb + (3 * jn + 1) * DM + col);
            const f32x4 o = v[j] * g * (sc + 1.f);
            u32x2 w; w.x = pk2(o[0], o[1]); w.y = pk2(o[2], o[3]);
            *(u32x2*)(U + (size_t)row * DM + col) = w; }
    }
}
__device__ __forceinline__ void phase_rs(PREF p, int gtid, int gthreads) {
    const float* SS = (const float*)(p.ws + WS_SS); float* RS = (float*)(p.ws + WS_RS);
    for (int row = gtid; row < TL; row += gthreads) {
        const f32x4 a = *(const f32x4*)(SS + (size_t)row * 16), b = *(const f32x4*)(SS + (size_t)row * 16 + 4), c = *(const f32x4*)(SS + (size_t)row * 16 + 8), d = *(const f32x4*)(SS + (size_t)row * 16 + 12);
        const float t = (((a[0] + a[1]) + (a[2] + a[3])) + ((b[0] + b[1]) + (b[2] + b[3]))) + (((c[0] + c[1]) + (c[2] + c[3])) + ((d[0] + d[1]) + (d[2] + d[3])));
        RS[row] = __builtin_amdgcn_rsqf(t * (1.f / DM) + 1e-6f);
    }
}
__device__ __forceinline__ void phase_bias(PREF p, int l, LAS unsigned char* lds, int tid, int wave, int lane) {
    LAS float* sS = (LAS float*)lds;
    LAS float* red = (LAS float*)(lds + 12288);
    const float* mod = (const float*)(p.ws + WS_MOD); float* BIAS = (float*)(p.ws + WS_BIAS);
    for (int item = blockIdx.x; item < 217; item += gridDim.x) {
        int mi, nc;
        if (item < 44) { mi = 0; nc = item; } else if (item < 88) { mi = 1; nc = item - 44; } else if (item < 129) { mi = 2; nc = item - 88; } else if (item < 173) { mi = 3; nc = item - 129; } else { mi = 4; nc = item - 173; }
        const int jn = mi < 2 ? 0 : (mi == 2 ? 1 : 2), slot = jn, boff = (mi == 1 || mi == 4) ? 2816 : 0, f = mi >= 3 ? 1 : 0;
        const int ldn = mi == 2 ? 2592 : DFF;
        const float* Wm = mi == 2 ? p.w_in + (size_t)l * DM * 2592 : ((mi == 1 || mi == 4) ? p.ffn_w3 : p.ffn_w1) + (size_t)(l * 2 + f) * DM * DFF;
        for (int i = tid; i < 3072; i += NTHREADS) { const int g = i >> 10, k = i & 1023; sS[i] = mod[(size_t)(l * 3 + g) * (NMOD * DM) + (3 * jn) * DM + k]; }
        __syncthreads();
        const int n = nc * 64 + lane; const bool nv = n < ldn;
        const float* W = Wm + (nv ? n : 0);
        float a0 = 0.f, a1 = 0.f, a2 = 0.f; const int k0 = wave * 128;
#pragma unroll 16
        for (int kk = 0; kk < 128; ++kk) { const int k = k0 + kk; const float w = W[(size_t)k * ldn]; a0 += sS[k] * w; a1 += sS[1024 + k] * w; a2 += sS[2048 + k] * w; }
        red[(wave * 3 + 0) * 64 + lane] = a0; red[(wave * 3 + 1) * 64 + lane] = a1; red[(wave * 3 + 2) * 64 + lane] = a2;
        __syncthreads();
        if (wave < 3 && nv) { float sum = 0.f;
#pragma unroll
            for (int w = 0; w < 8; ++w) sum += red[(w * 3 + wave) * 64 + lane];
            BIAS[(size_t)(slot * 3 + wave) * 5632 + boff + n] = sum; }
        __syncthreads();
    }
}
__device__ __forceinline__ void phase_final(PREF p, int gw, int NGW, int lane) {
    for (int row = gw; row < TL; row += NGW) {
        float* src = p.out + (size_t)row * DM;
        f32x4 v[4]; float ss = 0.f;
#pragma unroll
        for (int j = 0; j < 4; ++j) { v[j] = *(const f32x4*)(src + 4 * lane + 256 * j); ss += (v[j][0] * v[j][0] + v[j][1] * v[j][1]) + (v[j][2] * v[j][2] + v[j][3] * v[j][3]); }
        const float rs = __builtin_amdgcn_rsqf(wave_sum(ss, lane) * (1.f / DM) + 1e-6f);
#pragma unroll
        for (int j = 0; j < 4; ++j) { const int col = 4 * lane + 256 * j; const f32x4 g = *(const f32x4*)(p.final_g + col); *(f32x4*)(src + col) = v[j] * rs * g; }
    }
}

__device__ __forceinline__ int scan_order(int d, int step) { return d == 0 ? step : (step < 4 ? 3 - step : 263 - step); }

template <bool FINAL, int D>
__device__ __forceinline__ void rg_dir(PREF p, int l, int h, int ch, int sidx, int rowbase  , LAS bf16_t* sXc, LAS float* stg, int lane) {
    const bf16_t* __restrict__ P = (const bf16_t*)(p.ws + WS_GP); const bf16_t* __restrict__ WgT = (const bf16_t*)(p.ws + WS_WG);
    float* __restrict__ RGA = (float*)(p.ws + WS_RGA); float* __restrict__ RGH = (float*)(p.ws + WS_RGH); const float* __restrict__ RGC = (const float*)(p.ws + WS_RGC);
    bf16_t* __restrict__ MIX = (bf16_t*)(p.ws + WS_MIX);
    bf16_t* __restrict__ TMP = (bf16_t*)(p.ws + WS_U);
    const bf16_t* wr_ = WgT + (size_t)(((l * 2 + D) * 2 + 0) * 8 + h) * 4096; const bf16_t* wi_ = WgT + (size_t)(((l * 2 + D) * 2 + 1) * 8 + h) * 4096;
    const float ba = p.rg_ba[(l * 2 + D) * 512 + ch], bi = p.rg_bi[(l * 2 + D) * 512 + ch], lam = p.rg_lam[(l * 2 + D) * 512 + ch];
    const float e_ = __expf(-lam), u_ = 1.f + e_;
    const float l1p = (u_ == 1.f) ? e_ : __logf(u_) * e_ * rcpf_(u_ - 1.f);
    const float sp8 = -8.f * 1.4426950408889634f * l1p;
    float hc = FINAL ? RGC[sidx] : 0.f, Ap = 1.f;
    bf16x8 Br[4][2], Bi[4][2];
#pragma unroll
    for (int nt = 0; nt < 4; ++nt) { const int o0 = (nt * 16 + (lane & 15)) * 64 + (lane >> 4) * 8;
        Br[nt][0] = *(const bf16x8*)(wr_ + o0); Br[nt][1] = *(const bf16x8*)(wr_ + o0 + 32); Bi[nt][0] = *(const bf16x8*)(wi_ + o0); Bi[nt][1] = *(const bf16x8*)(wi_ + o0 + 32); }
    if (FINAL && D == 1) asm volatile("s_waitcnt vmcnt(0)" ::: "memory");
#pragma unroll 1
    for (int mi = 0; mi < 4; ++mi) { const int mt = D ? 3 - mi : mi;
        float grv[16], hfv[16];
        if (FINAL && D == 1) {
#pragma unroll
            for (int ti = 0; ti < 16; ++ti) { const size_t row = (size_t)(rowbase + mt * 16 + 15 - ti); grv[ti] = __builtin_bit_cast(float, (unsigned)P[row * PW + 512 + ch]); hfv[ti] = __builtin_bit_cast(float, (unsigned)TMP[row * 512 + ch]); }
            __builtin_amdgcn_sched_barrier(0);
#pragma unroll
            for (int ti = 0; ti < 16; ++ti) { grv[ti] = bf2f(__builtin_bit_cast(unsigned, grv[ti])); hfv[ti] = bf2f(__builtin_bit_cast(unsigned, hfv[ti])); }
        }
        const bf16x8 A0 = *(const LAS bf16x8*)(sXc + (mt * 16 + (lane & 15)) * 72 + (lane >> 4) * 8), A1 = *(const LAS bf16x8*)(sXc + (mt * 16 + (lane & 15)) * 72 + 32 + (lane >> 4) * 8);
        f32x4 ar[4], ai[4];
#pragma unroll
        for (int nt = 0; nt < 4; ++nt) { const f32x4 z = {0.f, 0.f, 0.f, 0.f};
            ar[nt] = mfma16(A0, Br[nt][0], z); ar[nt] = mfma16(A1, Br[nt][1], ar[nt]); ai[nt] = mfma16(A0, Bi[nt][0], z); ai[nt] = mfma16(A1, Bi[nt][1], ai[nt]); }
        WAVE_SYNC();
#pragma unroll
        for (int nt = 0; nt < 4; ++nt)
#pragma unroll
            for (int j = 0; j < 4; ++j) { const int o = ((lane >> 4) * 4 + j) * 64 + nt * 16 + (lane & 15); stg[o] = ar[nt][j]; stg[1024 + o] = ai[nt][j]; }
        WAVE_SYNC();
        float av[16], iv[16];
#pragma unroll
        for (int ti = 0; ti < 16; ++ti) { const int tk = D ? 15 - ti : ti;
            const float zr = stg[tk * 64 + lane] + ba, zi = stg[1024 + tk * 64 + lane] + bi;
            const float r = sigmoid_f(zr), ig = sigmoid_f(zi);
            const float a = __builtin_amdgcn_exp2f(r * sp8);
            const float xc = bf2f(sXc[(mt * 16 + tk) * 72 + lane]);
            av[ti] = a; iv[ti] = __builtin_amdgcn_sqrtf(fmaxf(1.f - a * a, 0.f)) * ig * xc;
            if (FINAL && D == 1) grv[ti] = gelu_tanh_f(grv[ti]);
        }
#pragma unroll
        for (int ti = 0; ti < 16; ++ti) { const int tk = D ? 15 - ti : ti;
            hc = av[ti] * hc + iv[ti]; Ap *= av[ti];
            if (FINAL) { const size_t row = (size_t)(rowbase + mt * 16 + tk);
                if (D == 0) TMP[row * 512 + ch] = (bf16_t)f2bf(hc);
                else MIX[row * DM + ch] = (bf16_t)f2bf(grv[ti] * (hfv[ti] + hc)); }
        }
    }
    if (!FINAL) { RGA[sidx] = Ap; RGH[sidx] = hc; }
}

template <bool FINAL>
__device__ __forceinline__ void rg_item(PREF p, int l, int item, LAS unsigned char* wl, int lane) {
    const bf16_t* __restrict__ P = (const bf16_t*)(p.ws + WS_GP);
    const int h = item & 7, rest = item >> 3;
    const int ci = rest < 512 ? 4 + (rest & 255) : ((rest - 512) & 3), b = rest < 512 ? (rest >> 8) : ((rest - 512) >> 2);
    const int seq_row0 = ci < 4 ? TL + b * 256 : b * 16384;
    const int t0 = ci < 4 ? ci * 64 : (ci - 4) * 64;
    const int seqlen = ci < 4 ? 256 : 16384;
    const int ch = h * 64 + lane;
    LAS bf16_t* sXc = (LAS bf16_t*)wl;
    LAS float* stg = (LAS float*)(wl + 9216);
    {
        const float cw0 = p.conv_w[(l * 4 + 0) * 512 + ch], cw1 = p.conv_w[(l * 4 + 1) * 512 + ch], cw2 = p.conv_w[(l * 4 + 2) * 512 + ch], cw3 = p.conv_w[(l * 4 + 3) * 512 + ch];
        const float cb = p.conv_b[l * 512 + ch];
        float xv[67]; unsigned xr_[67];
#pragma unroll
        for (int i = 0; i < 67; ++i) { const int t = t0 - 2 + i; const int tc = t < 0 ? 0 : (t >= seqlen ? seqlen - 1 : t);
            xr_[i] = P[(size_t)(seq_row0 + tc) * PW + ch]; }
        __builtin_amdgcn_sched_barrier(0);
#pragma unroll
        for (int i = 0; i < 67; ++i) { const int t = t0 - 2 + i; const int tc = t < 0 ? 0 : (t >= seqlen ? seqlen - 1 : t); xv[i] = (t == tc) ? bf2f(xr_[i]) : 0.f; }
#pragma unroll
        for (int tt = 0; tt < 64; ++tt) { const float xc = xv[tt] * cw0 + xv[tt + 1] * cw1 + xv[tt + 2] * cw2 + xv[tt + 3] * cw3 + cb; sXc[tt * 72 + lane] = (bf16_t)f2bf(xc); }
    }
    WAVE_SYNC();
    const int sidx0 = ((b * NCH + ci) * 2) * 512 + ch;
    rg_dir<FINAL, 0>(p, l, h, ch, sidx0, seq_row0 + t0, sXc, stg, lane);
    rg_dir<FINAL, 1>(p, l, h, ch, sidx0 + 512, seq_row0 + t0, sXc, stg, lane);
    WAVE_SYNC();
}

__device__ __forceinline__ void rg_carry(PREF p, int wave, int lane) {
    if (wave != 0 || blockIdx.x < 128 || blockIdx.x >= 160) return;
    const int gtid = ((int)blockIdx.x - 128) * 64 + lane;
    const float* __restrict__ RGA = (const float*)(p.ws + WS_RGA); const float* __restrict__ RGH = (const float*)(p.ws + WS_RGH); float* __restrict__ RGC = (float*)(p.ws + WS_RGC);
    const int b = gtid >> 10, d = (gtid >> 9) & 1, ch = gtid & 511;
    float h = 0.f;
    for (int s0 = 0; s0 < NCH; s0 += 26) {
        float av[26], hv[26];
#pragma unroll
        for (int k = 0; k < 26; ++k) { const int idx = ((b * NCH + scan_order(d, s0 + k)) * 2 + d) * 512 + ch; av[k] = RGA[idx]; hv[k] = RGH[idx]; }
#pragma unroll
        for (int k = 0; k < 26; ++k) { const int idx = ((b * NCH + scan_order(d, s0 + k)) * 2 + d) * 512 + ch; RGC[idx] = h; h = av[k] * h + hv[k]; }
    }
}

__device__ __forceinline__ void gla_rows(int b, int cj, int& row0, int& rstride) {
    if (cj < 4) { row0 = TL + b * 256 + cj * 64; rstride = 1; }
    else { const int q = cj - 4; row0 = b * 16384 + ((q & 3) * 64) * 64 + (q >> 2); rstride = 64; }
}

__device__ __forceinline__ void gl1_item(PREF p, int l, int item, bool valid, LAS unsigned char* pl, int sw, int lane) {
    const bf16_t* __restrict__ P = (const bf16_t*)(p.ws + WS_GP); bf16_t* __restrict__ QK = (bf16_t*)(p.ws + WS_QK);
    float* __restrict__ GLS = (float*)(p.ws + WS_GLS); float* __restrict__ GLD = (float*)(p.ws + WS_GLD);
    LAS bf16_t* sVt = (LAS bf16_t*)pl;
    LAS bf16_t* sKt = (LAS bf16_t*)(pl + 18432 + sw * 9216);
    LAS float* sD = (LAS float*)(pl + 36864 + sw * 256);
    const int d = sw;
    const int h = item & 3, rest = item >> 2;
    const int cj = rest < 512 ? 4 + (rest & 255) : ((rest - 512) & 3), b = rest < 512 ? (rest >> 8) : ((rest - 512) >> 2);
    int row0, rstride; gla_rows(b, cj, row0, rstride);
    const int seq = (b * 4 + h) * 2 + d;
    if (valid) {
        const bf16_t* prl = P + (size_t)(row0 + lane * rstride) * PW + 2560 + d * 16;
        const u32x4 lra = *(const u32x4*)prl, lrb = *(const u32x4*)(prl + 8);
        unsigned lrp[8] = {lra.x, lra.y, lra.z, lra.w, lrb.x, lrb.y, lrb.z, lrb.w};
        float qc[16], kc[16];
#pragma unroll
        for (int ss = 0; ss < 16; ++ss) { const int i = d ? 63 - ss : ss; const bf16_t* pr = P + (size_t)(row0 + i * rstride) * PW + h * 64 + lane;
            qc[ss] = __builtin_bit_cast(float, (unsigned)pr[1024]); kc[ss] = __builtin_bit_cast(float, (unsigned)pr[1280]); }
        __builtin_amdgcn_sched_barrier(0);
#pragma unroll
        for (int ss = 0; ss < 16; ++ss) { qc[ss] = bf2f(__builtin_bit_cast(unsigned, qc[ss])); kc[ss] = bf2f(__builtin_bit_cast(unsigned, kc[ss])); }
        unsigned wupp[8];
#pragma unroll
        for (int r2 = 0; r2 < 8; ++r2) wupp[r2] = pk2(p.gla_wup[(size_t)((l * 2 + d) * 16 + 2 * r2) * 256 + h * 64 + lane], p.gla_wup[(size_t)((l * 2 + d) * 16 + 2 * r2 + 1) * 256 + h * 64 + lane]);
        const float bup = p.gla_bup[(l * 2 + d) * 256 + h * 64 + lane];
#pragma unroll 1
        for (int g2 = 0; g2 < 2; ++g2) {
            unsigned vr[16];
#pragma unroll
            for (int ii = 0; ii < 16; ++ii) { const int i = 32 * sw + g2 * 16 + ii; vr[ii] = *(const unsigned*)(P + (size_t)(row0 + i * rstride) * PW + 1536 + h * 128 + 2 * lane); }
#pragma unroll
            for (int ii = 0; ii < 16; ++ii) { const int i = 32 * sw + g2 * 16 + ii; sVt[(2 * lane) * 72 + i] = (bf16_t)(vr[ii] & 0xffffu); sVt[(2 * lane + 1) * 72 + i] = (bf16_t)(vr[ii] >> 16); }
        }
        float bc = 0.f;
#pragma unroll 1
        for (int g4 = 0; g4 < 4; ++g4) {
            float qn[16], kn[16];
            if (g4 < 3) {
#pragma unroll
                for (int ss = 0; ss < 16; ++ss) { const int s = (g4 + 1) * 16 + ss; const int i = d ? 63 - s : s; const bf16_t* pr = P + (size_t)(row0 + i * rstride) * PW + h * 64 + lane;
                    qn[ss] = __builtin_bit_cast(float, (unsigned)pr[1024]); kn[ss] = __builtin_bit_cast(float, (unsigned)pr[1280]); }
                __builtin_amdgcn_sched_barrier(0);
            }
            float gv[16];
#pragma unroll
            for (int ss = 0; ss < 16; ++ss) { const int s = g4 * 16 + ss; const int i = d ? 63 - s : s;
                float z = bup;
#pragma unroll
                for (int r2 = 0; r2 < 8; ++r2) { const unsigned w = (unsigned)__builtin_amdgcn_readlane((int)lrp[r2], i);
                    z = __builtin_amdgcn_fdot2_f32_bf16(__builtin_bit_cast(bf16x2_t, w), __builtin_bit_cast(bf16x2_t, wupp[r2]), z, false); }
                gv[ss] = -(fmaxf(-z, 0.f) + __logf(1.f + __expf(-fabsf(z)))) * (1.f / 16.f);
                __builtin_amdgcn_sched_barrier(0);
            }
#pragma unroll
            for (int ss = 0; ss < 16; ++ss) { const int s = g4 * 16 + ss; const int i = d ? 63 - s : s; const size_t rowi = (size_t)(row0 + i * rstride);
                bc += gv[ss];
                const float en = __expf(-bc), ep = __expf(bc);
                const float kt = kc[ss] * en, qt = qc[ss] * 0.125f * ep;
                const unsigned ktb = f2bf(kt);
                sKt[lane * 72 + i] = (bf16_t)ktb;
                QK[rowi * 1024 + d * 512 + h * 64 + lane] = (bf16_t)f2bf(qt);
                QK[rowi * 1024 + d * 512 + 256 + h * 64 + lane] = (bf16_t)ktb;
            }
#pragma unroll
            for (int ss = 0; ss < 16; ++ss) { qc[ss] = bf2f(__builtin_bit_cast(unsigned, qn[ss])); kc[ss] = bf2f(__builtin_bit_cast(unsigned, kn[ss])); }
        }
        const float Dv = __expf(bc);
        sD[lane] = Dv; GLD[(size_t)(seq * NCH + cj) * 64 + lane] = Dv;
    }
    __syncthreads();
    if (valid) {
        bf16x8 Ak[4][2]; f32x4 Dm[4];
#pragma unroll
        for (int mt = 0; mt < 4; ++mt) { Dm[mt] = *(const LAS f32x4*)(sD + mt * 16 + (lane >> 4) * 4);
#pragma unroll
            for (int ks = 0; ks < 2; ++ks) Ak[mt][ks] = *(const LAS bf16x8*)(sKt + (mt * 16 + (lane & 15)) * 72 + ks * 32 + (lane >> 4) * 8); }
        bf16_t* So = (bf16_t*)GLS + (size_t)(seq * NCH + cj) * 8192;
#pragma unroll 2
        for (int nt = 0; nt < 8; ++nt) {
            const bf16x8 B0 = *(const LAS bf16x8*)(sVt + (nt * 16 + (lane & 15)) * 72 + (lane >> 4) * 8), B1 = *(const LAS bf16x8*)(sVt + (nt * 16 + (lane & 15)) * 72 + 32 + (lane >> 4) * 8);
#pragma unroll
            for (int mt = 0; mt < 4; ++mt) { f32x4 acc = {0.f, 0.f, 0.f, 0.f}; acc = mfma16(Ak[mt][0], B0, acc); acc = mfma16(Ak[mt][1], B1, acc);
                acc = acc * Dm[mt];
                u32x2 w; w.x = pk2(acc[0], acc[1]); w.y = pk2(acc[2], acc[3]);
                *(u32x2*)(So + (nt * 16 + (lane & 15)) * 64 + mt * 16 + (lane >> 4) * 4) = w; }
        }
    }
    __syncthreads();
}

__device__ __forceinline__ void gl2_scan(PREF p, int gtid, int gthreads) {
    unsigned* __restrict__ GLS = (unsigned*)(p.ws + WS_GLS); const float* __restrict__ GLD = (const float*)(p.ws + WS_GLD);
    for (int g = gtid; g < 16 * 4096; g += gthreads) {
        const int seq = g >> 12, e2 = g & 4095, kk = (e2 * 2) & 63, d = seq & 1;
        float S0 = 0.f, S1 = 0.f;
        for (int s0 = 0; s0 < NCH; s0 += 20) {
            unsigned dv[20]; float D0[20], D1[20];
#pragma unroll
            for (int k = 0; k < 20; ++k) { const int cj = scan_order(d, s0 + k); dv[k] = GLS[(size_t)(seq * NCH + cj) * 4096 + e2];
                const float* dp = GLD + (size_t)(seq * NCH + cj) * 64 + kk; D0[k] = dp[0]; D1[k] = dp[1]; }
#pragma unroll
            for (int k = 0; k < 20; ++k) { const int cj = scan_order(d, s0 + k); GLS[(size_t)(seq * NCH + cj) * 4096 + e2] = pk2(S0, S1);
                S0 = D0[k] * S0 + bf2f(dv[k] & 0xffffu); S1 = D1[k] * S1 + __builtin_bit_cast(float, dv[k] & 0xffff0000u); }
        }
    }
}

__device__ __forceinline__ void gl3_item(PREF p, int l, int item, bool valid, LAS unsigned char* sl, int w4, int t256, int lane) {
    const bf16_t* __restrict__ P = (const bf16_t*)(p.ws + WS_GP); const bf16_t* __restrict__ QK = (const bf16_t*)(p.ws + WS_QK);
    const float* __restrict__ GLS = (const float*)(p.ws + WS_GLS); bf16_t* __restrict__ MIX = (bf16_t*)(p.ws + WS_MIX);
    LAS bf16_t* sVt = (LAS bf16_t*)sl;
    LAS bf16_t* sS = (LAS bf16_t*)(sl + 18432);
    LAS bf16_t* sAtt = (LAS bf16_t*)(sl + 55296);
    const int h = item & 3, rest = item >> 2;
    const int cj = rest < 512 ? 4 + (rest & 255) : ((rest - 512) & 3), b = rest < 512 ? (rest >> 8) : ((rest - 512) >> 2);
    int row0, rstride; gla_rows(b, cj, row0, rstride);
    f32x4 o[8];
#pragma unroll
    for (int nt = 0; nt < 8; ++nt) o[nt] = (f32x4){0.f, 0.f, 0.f, 0.f};
    bf16x8 Aq[2][2], Bk[4][2];
    const size_t rowi_a = (size_t)(row0 + (16 * w4 + (lane & 15)) * rstride);
    if (valid) {
        unsigned vr[16]; u32x4 sv[2][4];
#pragma unroll
        for (int ii = 0; ii < 16; ++ii) { const int i = 16 * w4 + ii; vr[ii] = *(const unsigned*)(P + (size_t)(row0 + i * rstride) * PW + 1536 + h * 128 + 2 * lane); }
#pragma unroll
        for (int d = 0; d < 2; ++d) { const bf16_t* Sg = (const bf16_t*)GLS + (size_t)(((b * 4 + h) * 2 + d) * NCH + cj) * 8192;
#pragma unroll
            for (int r = 0; r < 4; ++r) sv[d][r] = *(const u32x4*)(Sg + (r * 256 + t256) * 8); }
#pragma unroll
        for (int d = 0; d < 2; ++d)
#pragma unroll
            for (int ks = 0; ks < 2; ++ks) Aq[d][ks] = *(const bf16x8*)(QK + rowi_a * 1024 + d * 512 + h * 64 + ks * 32 + (lane >> 4) * 8);
#pragma unroll
        for (int nt = 0; nt < 4; ++nt) { const size_t rows = (size_t)(row0 + (nt * 16 + (lane & 15)) * rstride);
#pragma unroll
            for (int ks = 0; ks < 2; ++ks) Bk[nt][ks] = *(const bf16x8*)(QK + rows * 1024 + 256 + h * 64 + ks * 32 + (lane >> 4) * 8); }
#pragma unroll
        for (int ii = 0; ii < 16; ++ii) { const int i = 16 * w4 + ii; sVt[(2 * lane) * 72 + i] = (bf16_t)(vr[ii] & 0xffffu); sVt[(2 * lane + 1) * 72 + i] = (bf16_t)(vr[ii] >> 16); }
#pragma unroll
        for (int d = 0; d < 2; ++d)
#pragma unroll
            for (int r = 0; r < 4; ++r) { const int e = (r * 256 + t256) * 8; *(LAS u32x4*)(sS + d * 9216 + (e >> 6) * 72 + (e & 63)) = sv[d][r]; }
    }
    __syncthreads();
    if (valid) {
#pragma unroll
        for (int d = 0; d < 2; ++d) {
            f32x4 att[4];
#pragma unroll
            for (int nt = 0; nt < 4; ++nt) { att[nt] = (f32x4){0.f, 0.f, 0.f, 0.f};
#pragma unroll
                for (int ks = 0; ks < 2; ++ks) att[nt] = mfma16(Aq[d][ks], Bk[nt][ks], att[nt]); }
            if (d == 0) {
#pragma unroll
                for (int nt = 0; nt < 4; ++nt) { const size_t rows = (size_t)(row0 + (nt * 16 + (lane & 15)) * rstride);
#pragma unroll
                    for (int ks = 0; ks < 2; ++ks) Bk[nt][ks] = *(const bf16x8*)(QK + rows * 1024 + 512 + 256 + h * 64 + ks * 32 + (lane >> 4) * 8); }
            }
            WAVE_SYNC();
#pragma unroll
            for (int nt = 0; nt < 4; ++nt)
#pragma unroll
                for (int j = 0; j < 4; ++j) { const int i_ = 16 * w4 + (lane >> 4) * 4 + j, s_ = nt * 16 + (lane & 15); const bool keep = d == 0 ? (s_ <= i_) : (s_ >= i_);
                    sAtt[i_ * 72 + s_] = keep ? (bf16_t)f2bf(att[nt][j]) : (bf16_t)0; }
            WAVE_SYNC();
            bf16x8 Aa[2];
#pragma unroll
            for (int ks = 0; ks < 2; ++ks) Aa[ks] = *(const LAS bf16x8*)(sAtt + (16 * w4 + (lane & 15)) * 72 + ks * 32 + (lane >> 4) * 8);
#pragma unroll
            for (int nt = 0; nt < 8; ++nt)
#pragma unroll
                for (int ks = 0; ks < 2; ++ks) { const int bo = (nt * 16 + (lane & 15)) * 72 + ks * 32 + (lane >> 4) * 8;
                    o[nt] = mfma16(Aa[ks], *(const LAS bf16x8*)(sVt + bo), o[nt]); o[nt] = mfma16(Aq[d][ks], *(const LAS bf16x8*)(sS + d * 9216 + bo), o[nt]); }
        }
        const float* gn = p.gla_norm_g + l * 512 + h * 128;
        unsigned ogr[4][8];
#pragma unroll
        for (int j = 0; j < 4; ++j) { const size_t rowi = (size_t)(row0 + (16 * w4 + (lane >> 4) * 4 + j) * rstride);
#pragma unroll
            for (int nt = 0; nt < 8; ++nt) ogr[j][nt] = P[rowi * PW + 2048 + h * 128 + nt * 16 + (lane & 15)]; }
        __builtin_amdgcn_sched_barrier(0);
#pragma unroll
        for (int j = 0; j < 4; ++j) {
            float ss = 0.f;
#pragma unroll
            for (int nt = 0; nt < 8; ++nt) ss += o[nt][j] * o[nt][j];
            ss += shx(ss, 1, lane); ss += shx(ss, 2, lane); ss += shx(ss, 4, lane); ss += shx(ss, 8, lane);
            const float rs = __builtin_amdgcn_rsqf(ss * (1.f / 128.f) + 1e-6f);
            const size_t rowi = (size_t)(row0 + (16 * w4 + (lane >> 4) * 4 + j) * rstride);
            float ogv[8];
#pragma unroll
            for (int nt = 0; nt < 8; ++nt) ogv[nt] = bf2f(ogr[j][nt]);
#pragma unroll
            for (int nt = 0; nt < 8; ++nt) { const int vv = nt * 16 + (lane & 15);
                MIX[rowi * DM + 512 + h * 128 + vv] = (bf16_t)f2bf(o[nt][j] * rs * gn[vv] * silu_f(ogv[nt])); }
        }
    }
    __syncthreads();
}

#define XB_TMO      128
#define XB_XCNT(j)  (256  + 64 * (j))
#define XB_XSUB(j)  (1280 + 64 * (j))
#define XB_XGEN(j)  (2304 + 64 * (j))
#define XB_TOP      3328
#define XB_TOPGEN   3392
#define XCD_BAR_WORDS 3456
#define XB_SPIN_CAP (1u << 18)

__device__ __forceinline__ unsigned xb_ld(unsigned* p)              { return __hip_atomic_load(p, __ATOMIC_RELAXED, __HIP_MEMORY_SCOPE_AGENT); }
__device__ __forceinline__ unsigned xb_add(unsigned* p, unsigned v) { return __hip_atomic_fetch_add(p, v, __ATOMIC_RELAXED, __HIP_MEMORY_SCOPE_AGENT); }
__device__ __forceinline__ unsigned xb_xcc_id() { return (unsigned)__builtin_amdgcn_s_getreg((3 << 11) | 20) & 0xFu; }
#define XB_SPIN(cond, bar) do { unsigned _sp = 0; while (cond) { __builtin_amdgcn_s_sleep(1); \
    if ((++_sp & 255u) == 0u) { if (xb_ld(&(bar)[XB_TMO])) break; if (_sp > XB_SPIN_CAP) { atomicAdd(&(bar)[XB_TMO], 1u); break; } } } } while (0)

struct XcdBarrier {
    unsigned* bar; unsigned x;
    volatile LAS unsigned* st;
};

__device__ __forceinline__ XcdBarrier xcd_barrier_post(unsigned* bar, volatile LAS unsigned* st) {
    XcdBarrier b; b.bar = bar; b.x = xb_xcc_id(); b.st = st;
    if (threadIdx.x == 0) (void)xb_add(&bar[XB_XCNT(b.x)], 1u);
    return b;
}
__device__ __forceinline__ void xcd_barrier_complete(unsigned* bar, unsigned x, unsigned& nloc, unsigned& nx) {
    const unsigned G = gridDim.x * gridDim.y * gridDim.z;
    unsigned sum, cnt, mine, sp = 0u;
    for (;;) {
        sum = 0u; cnt = 0u; mine = 0u;
#pragma unroll
        for (unsigned j = 0; j < 16; ++j) { const unsigned c = xb_ld(&bar[XB_XCNT(j)]); sum += c; cnt += (c > 0u) ? 1u : 0u; mine = (j == x) ? c : mine; }
        if (sum == G) break;
        __builtin_amdgcn_s_sleep(1);
        if ((++sp & 255u) == 0u) { if (xb_ld(&bar[XB_TMO])) break; if (sp > XB_SPIN_CAP) { atomicAdd(&bar[XB_TMO], 1u); break; } }
    }
    nloc = mine > 0u ? mine : 1u; nx = cnt > 0u ? cnt : 1u;
}

__device__ __forceinline__ void xcd_barrier(const XcdBarrier& b, int xb_tid) {
    asm volatile("s_waitcnt vmcnt(0)" ::: "memory");
    __syncthreads();
    if (xb_tid == 0) {
        unsigned* bar = b.bar;
        __builtin_amdgcn_s_waitcnt(0);
        unsigned nloc = b.st[0], nx = b.st[1];
        if (nloc == 0u) { xcd_barrier_complete(bar, b.x, nloc, nx); b.st[0] = nloc; b.st[1] = nx; }
        const unsigned old = xb_add(&bar[XB_XSUB(b.x)], 1u);
        const unsigned gen = old / nloc;
        if (old + 1u == (gen + 1u) * nloc) {
            __builtin_amdgcn_fence(__ATOMIC_RELEASE, "agent");
            asm volatile("s_waitcnt vmcnt(0)" ::: "memory");
            const unsigned og = xb_add(&bar[XB_TOP], 1u);
            const unsigned tg = og / nx;
            if (og + 1u == (tg + 1u) * nx) xb_add(&bar[XB_TOPGEN], 1u);
            else XB_SPIN(xb_ld(&bar[XB_TOPGEN]) == tg, bar);
            __builtin_amdgcn_fence(__ATOMIC_ACQUIRE, "agent");
            xb_add(&bar[XB_XGEN(b.x)], 1u);
            asm volatile("s_waitcnt vmcnt(0)" ::: "memory");
        } else {
            XB_SPIN(xb_ld(&bar[XB_XGEN(b.x)]) == gen, bar);
            __builtin_amdgcn_fence(__ATOMIC_ACQUIRE, "agent");
            asm volatile("s_waitcnt vmcnt(0)" ::: "memory");
        }
    }
    __syncthreads();
}

__device__ __forceinline__ int lane_id_volatile() { int l; asm volatile("v_mbcnt_lo_u32_b32 %0, -1, 0\n\tv_mbcnt_hi_u32_b32 %0, -1, %0" : "=v"(l)); return l; }
__global__ void __launch_bounds__(NTHREADS, 2) mega_fwd(Params p_arg) {
    extern __shared__ __attribute__((aligned(16))) unsigned char lds_raw[];
    LAS unsigned char* lds = (LAS unsigned char*)lds_raw;
    cg::grid_group grid = cg::this_grid();
    const int G = gridDim.x, NGW = G * 8, gthreads = G * NTHREADS;
    const int wave_s = __builtin_amdgcn_readfirstlane((int)threadIdx.x >> 6);
#define MYTID() (wave_s * 64 + lane_id_volatile())
    volatile LAS unsigned* bst = (volatile LAS unsigned*)(lds + LDS_BYTES - 64);
    if (threadIdx.x < 2) bst[threadIdx.x] = 0u;
    if (blockIdx.x == 0) { unsigned* bw = (unsigned*)(p_arg.ws + WS_BAR); for (int i = threadIdx.x; i < XCD_BAR_WORDS; i += NTHREADS) bw[i] = 0u; }
#define KARGS() const __attribute__((address_space(4))) Params* pk_ = (const __attribute__((address_space(4))) Params*)__builtin_amdgcn_kernarg_segment_ptr(); asm volatile("" : "+s"(pk_)); PREF p = *pk_;

    {
    KARGS();
    const int tid = threadIdx.x, lane = tid & 63, wave = __builtin_amdgcn_readfirstlane(tid >> 6);
    const int gw = blockIdx.x * 8 + wave, gtid = blockIdx.x * NTHREADS + tid;
    phase_mods(p, lds, tid, wave, lane);
    phase_gatew(p, gtid, gthreads);
    { float* hc_ = (float*)(p.ws + WS_HCTX); for (int i = gtid; i < TC * DM / 4; i += gthreads) ((f32x4*)hc_)[i] = ((const f32x4*)p.ctx)[i]; }
    __syncthreads();
    convert_weights(p, 0, lds, gw, NGW, wave, lane);
    }
    grid.sync();
    (void)xcd_barrier_post((unsigned*)(p_arg.ws + WS_BAR), bst);

    for (int st = 0; st < NLAYER * 12; ++st) {
#ifndef DUP_MASK
#define DUP_MASK 0
#endif
        const int s_ = st % 12;
        const int sbit = (s_ == 0 || s_ == 3 || s_ == 9) ? 1 : (s_ == 1 || s_ == 10) ? 2 : (s_ == 4) ? 4 : (s_ == 5) ? 8 : (s_ == 7) ? 16 : 0;
        const int nrep = (DUP_MASK & sbit) ? 2 : 1;
        for (int rep = 0; rep < nrep; ++rep) {
        KARGS();
        unsigned char* ws = p.ws;
        bf16_t* U = (bf16_t*)(ws + WS_U); bf16_t* MIX = (bf16_t*)(ws + WS_MIX); bf16_t* GP = (bf16_t*)(ws + WS_GP);
        float* hctx = (float*)(ws + WS_HCTX); const float* mod = (const float*)(ws + WS_MOD);
#define PHASE_IDS() const int tid = MYTID(); const int lane = tid & 63, wave = __builtin_amdgcn_readfirstlane(tid >> 6); const int gw = blockIdx.x * 8 + wave, gtid = blockIdx.x * NTHREADS + tid; (void)gw; (void)gtid; (void)lane;
        const int l = st / 12, s = st % 12;
        const bool lastl = (l == NLAYER - 1);
        const int rows = (lastl && s >= 8) ? TL : TT;
        switch (s) {
        case 0: case 3: case 9: {
            PHASE_IDS();
            const int jn = s == 0 ? 0 : (s == 3 ? 1 : 2);
            if (s == 0) { phase_bias(p, l, lds, tid, wave, lane); if (l > 0) convert_weights(p, l, lds, gw, NGW, wave, lane); }
            if (st != 0) phase_rs(p, gtid, gthreads);
            phase_norm(p, l, jn, st == 0 ? 0 : TL, rows, st == 0, s == 0 ? (l > 0 ? DFF / 256 : 0) : (s == 3 ? DFF / 256 : DM / 256), gw, NGW, lane);
        } break;
        case 1: case 10: {
            PHASE_IDS();
            const int f = s == 1 ? 0 : 1;
            pg8::Gemm g{U, (const bf16_t*)(ws + WS_W13) + (size_t)f * 5632 * DM, rows, 5632, DM, DM};
            pg8::StaticOrder S; S.init(rows, 5632, G, (int)blockIdx.x);
            EpiSwiglu E{GP, (const float*)(ws + WS_RS), (const float*)(ws + WS_BIAS) + (size_t)(f ? 2 : 0) * 3 * 5632};
            pg8::gemm_phase<EpiSwiglu, pg8::StaticOrder, true, true>(lds, g, S, E, tid);
        } break;
        case 2: case 8: case 11: {
            PHASE_IDS();
            const bool isout = (s == 8);
            const int f = s == 2 ? 0 : 1;
            const int Kd = isout ? DM : DFF;
            const bf16_t* Ad = isout ? MIX : GP; const bf16_t* Bd = isout ? (const bf16_t*)(ws + WS_WOUT) : (const bf16_t*)(ws + WS_W2) + (size_t)f * DM * DFF;
            const int gidx = s == 2 ? 2 : (s == 8 ? 5 : 8);
            const bool first = (st == 2);
            const float* gate = mod + (size_t)l * 3 * (NMOD * DM) + gidx * DM; const float coef = isout ? 1.f : 0.5f;
            pg8::Gemm g{Ad, Bd, rows, DM, Kd, Kd};
            DownOrder S; S.so.init(TL, DM, G, (int)blockIdx.x); S.sk.init(TL / 256, TC / 256, DM / 256, Kd / 256, 256, G, (int)blockIdx.x); S.nlat = (TL / 256) * (DM / 256); S.nctx = rows == TT ? S.sk.nun : 0; S.inv = isout ? 16384 : 5958;
            const int ln = s == 11 ? l + 1 : l, jnn = s == 2 ? 1 : (s == 8 ? 2 : 0);
            const bool emit = ln < NLAYER;
            EpiResid E{first ? p.x : p.out, p.out, ws, gate, p.norm_g + (size_t)((emit ? ln : 0) * 3 + jnn) * DM, mod + (size_t)(emit ? ln : 0) * 3 * (NMOD * DM) + (3 * jnn + 1) * DM, coef, emit ? 1 : 0};
            pg8::gemm_phase<EpiResid, DownOrder, true, true>(lds, g, S, E, tid);
        } break;
        case 4: {
            PHASE_IDS();
            pg8::Gemm g{U, (const bf16_t*)(ws + WS_WIN), rows, PW, DM, DM};
            pg8::StaticOrder S; S.init(rows, PW, G, (int)blockIdx.x);
            EpiStore E{GP, PW, (const float*)(ws + WS_RS), (const float*)(ws + WS_BIAS) + (size_t)1 * 3 * 5632};
            pg8::gemm_phase<EpiStore, pg8::StaticOrder, true, true>(lds, g, S, E, tid);
        } break;
        case 5: {
            PHASE_IDS();
            for (int r2 = 0; r2 < ((DUP_MASK & 32) ? 2 : 1); ++r2)
            for (int item = gw; item < 2 * NCH * 8; item += NGW) rg_item<false>(p, l, item, lds + wave * 18432, lane);
            __syncthreads();
            const int NP = G * 4, pgid = NP - 1 - (blockIdx.x * 4 + (wave >> 1));
            for (int r2 = 0; r2 < ((DUP_MASK & (64 | 128)) ? 2 : 1); ++r2)
            for (int it = 0; it * NP < 2 * NCH * 4; ++it) { const int item = it * NP + pgid; gl1_item(p, l, item, item < 2 * NCH * 4, lds + (wave >> 1) * 37376, wave & 1, lane); }
        } break;
        case 6: {
            PHASE_IDS();
            rg_carry(p, wave, lane);
            gl2_scan(p, gtid, gthreads);
        } break;
        case 7: {
            PHASE_IDS();
            const int nrg = lastl ? 2 * 256 * 8 : 2 * NCH * 8, ngl = lastl ? 2 * 256 * 4 : 2 * NCH * 4;
            for (int item = gw; item < nrg; item += NGW) rg_item<true>(p, l, item, lds + wave * 18432, lane);
            __syncthreads();
            const int NS = G * 2, sgid = NS - 1 - (blockIdx.x * 2 + (wave >> 2));
            for (int r2 = 0; r2 < ((DUP_MASK & (64 | 256)) ? 2 : 1); ++r2)
            for (int it = 0; it * NS < ngl; ++it) { const int item = it * NS + sgid; gl3_item(p, l, item, item < ngl, lds + (wave >> 2) * 64512, wave & 3, tid & 255, lane); }
        } break;
        }
        { XcdBarrier xb_; xb_.bar = (unsigned*)(p.ws + WS_BAR); xb_.x = xb_xcc_id(); xb_.st = (volatile LAS unsigned*)(lds + LDS_BYTES - 64); xcd_barrier(xb_, MYTID()); }
        }
    }
    { KARGS(); const int tid = MYTID(), lane = tid & 63, wave = __builtin_amdgcn_readfirstlane(tid >> 6); phase_final(p, blockIdx.x * 8 + wave, NGW, lane); }
}

extern "C" void kernel_launch(void* const* d_in, const int* in_sizes, int n_in, void* d_out, int out_size, void* d_ws, size_t ws_size, hipStream_t stream) {
    static int grid_blocks = 0;
    if (grid_blocks == 0) {
        if (n_in != 23 || ws_size < WS_END) { fprintf(stderr, "kernel_launch: unexpected n_in %d or ws_size %zu (< %zu)\n", n_in, ws_size, (size_t)WS_END); grid_blocks = -1; return; }
        int dev = 0, cus = 0, per_cu = 0;
        hipGetDevice(&dev);
        hipDeviceGetAttribute(&cus, hipDeviceAttributeMultiprocessorCount, dev);
        if (hipFuncSetAttribute((const void*)mega_fwd, hipFuncAttributeMaxDynamicSharedMemorySize, LDS_BYTES) != hipSuccess) { fprintf(stderr, "kernel_launch: hipFuncSetAttribute failed\n"); grid_blocks = -1; return; }
        if (hipOccupancyMaxActiveBlocksPerMultiprocessor(&per_cu, (const void*)mega_fwd, NTHREADS, LDS_BYTES) != hipSuccess || per_cu < 1) { fprintf(stderr, "kernel_launch: occupancy query says %d\n", per_cu); per_cu = 1; }
        (void)hipGetLastError();
        grid_blocks = cus;
    }
    if (grid_blocks < 0) return;
    Params p{};
    const float** pp = (const float**)&p;
    for (int i = 0; i < 23; ++i) pp[i] = (const float*)d_in[i];
    p.out = (float*)d_out; p.ws = (unsigned char*)d_ws;
    void* args[] = {&p};
    hipError_t e = hipLaunchCooperativeKernel((const void*)mega_fwd, dim3(grid_blocks), dim3(NTHREADS), args, LDS_BYTES, stream);
    if (e != hipSuccess) fprintf(stderr, "cooperative launch failed: %s (grid %d)\n", hipGetErrorString(e), grid_blocks);
}
```

```cpp
#include <hip/hip_runtime.h>
#include <hip/hip_cooperative_groups.h>
#include <cstdio>
#include <cstdint>
namespace cg = cooperative_groups;
namespace pg8 {
#define PG8_LAS __attribute__((address_space(3)))
typedef unsigned short bf16_t;
typedef short bf16x8 __attribute__((ext_vector_type(8)));
typedef float f32x4 __attribute__((ext_vector_type(4)));
typedef unsigned u32x4 __attribute__((ext_vector_type(4)));
constexpr int BM = 256, BK = 64, HALF = 128, HTB = HALF * BK * 2  , STAGE_BYTES = 8 * HTB, NXCD = 8, WGM = 8;

__host__ __device__ __forceinline__ int lds_byte(int r, int c) { const int st = (r >> 4) * 2 + (c >> 5), rr = r & 15, cc = c & 31, ob = rr * 64 + cc * 2; return st * 1024 + (ob ^ (((ob >> 9) & 1) << 5)); }
__host__ __device__ __forceinline__ void stage_rc(int b, int& R, int& C) { const int st = b / 1024, sb = b % 1024, swz = sb ^ (((sb >> 9) & 1) << 5); R = (st >> 1) * 16 + swz / 64; C = (st & 1) * 32 + (swz % 64) / 2; }
__host__ __device__ __forceinline__ int perm32(int rho) { const int n = rho >> 4, i = rho & 15; return 8 * (i >> 2) + 4 * n + (i & 3); }

struct Unit { int pm, pn, kb, nk; };
struct Gemm { const bf16_t* A; const bf16_t* Bt; int M, N, K, ldk; };

struct StaticOrder {
    int nM, nN, nwg, G, c;
    __host__ __device__ void init(int M, int N, int G_, int c_) { nM = M / BM; nN = N / BM; nwg = nM * nN; G = G_; c = c_; }
    __host__ __device__ bool next(int i, Unit& u) const {
        const long L = (long)i * G + c; if (L >= nwg) return false;
        int wgid = (int)L; { const int q = nwg / NXCD, r = nwg % NXCD, xcd = wgid % NXCD, off = wgid / NXCD; wgid = (xcd < r ? xcd * (q + 1) : r * (q + 1) + (xcd - r) * q) + off; }
        const int nig = WGM * nN, gid = wgid / nig, fm = gid * WGM, gsz = (nM - fm) < WGM ? (nM - fm) : WGM;
        u.pm = fm + ((wgid % nig) % gsz); u.pn = (wgid % nig) / gsz; u.kb = 0; u.nk = 0; return true;
    }
    __device__ __forceinline__ void a_ready(const Unit&) const {}
    __device__ __forceinline__ void done(const Unit&) const {}
};
struct SplitKOrder {
    int pm0, nN, nsplit, kc, nun, G, c;
    __host__ __device__ void init(int pm0_, int nM_, int nN_, int nsplit_, int kc_, int G_, int c_) { pm0 = pm0_; nN = nN_; nsplit = nsplit_; kc = kc_; nun = nM_ * nN_ * nsplit_; G = G_; c = c_; }
    __host__ __device__ bool next(int i, Unit& u) const {
        const int L = i * G + c; if (L >= nun) return false;
        const int tile = L / nsplit, ks = L - tile * nsplit;
        u.pm = pm0 + tile / nN; u.pn = tile % nN; u.kb = ks * kc; u.nk = kc / BK; return true;
    }
    __device__ __forceinline__ void a_ready(const Unit&) const {}
    __device__ __forceinline__ void done(const Unit&) const {}
};
__device__ __forceinline__ unsigned cvt_pk_bf16(float lo, float hi) { unsigned r; asm volatile("v_cvt_pk_bf16_f32 %0, %1, %2" : "=v"(r) : "v"(lo), "v"(hi)); return r; }
template <class Epi, class Sched, bool ALIGN_EPI = false, bool SP2 = false>
__device__ __forceinline__ void gemm_phase(PG8_LAS unsigned char* lds, const Gemm g, const Sched& S, const Epi& E, int tid_in) {
    int tid = tid_in; asm volatile("" : "+v"(tid));
    const int wid = __builtin_amdgcn_readfirstlane(tid >> 6), lane = tid & 63, wr = wid >> 2, wc = wid & 3, fr = lane & 15, fq = lane >> 4;
    const int K = g.ldk, nt_all = g.K / BK;
    unsigned voffA[2], voffB[2];
#pragma unroll
    for (int i = 0; i < 2; ++i) { int R, C; stage_rc(tid * 16 + i * 8192, R, C); const int Rb = Epi::PERM ? ((R & ~31) + perm32(R & 31)) : R;
        voffA[i] = (unsigned)(R * K + C) * 2u; voffB[i] = (unsigned)(Rb * K + C) * 2u; }
    const size_t kstep = (size_t)(BK * 2);
    const size_t hstep = (size_t)HALF * K * 2;
    const size_t tstep = 2 * hstep;
    const unsigned ldsw = (unsigned)wid * 1024u;
    const int aoff = lds_byte(wr * 64 + fr, fq * 8), boff = lds_byte(wc * 32 + fr, fq * 8);
#define PG8_SA(b, h) (((b) * 2 + (h)) * HTB)
#define PG8_SB(b, h) ((4 + (b) * 2 + (h)) * HTB)
#define PG8_STAGE(bufoff, gbase, voff) do { _Pragma("unroll") for (int _i = 0; _i < 2; ++_i) \
        __builtin_amdgcn_global_load_lds((const unsigned*)((const char*)(gbase) + (voff)[_i]), (PG8_LAS unsigned*)(lds + (bufoff) + ldsw + _i * 8192), 16, 0, 0); } while (0)
#define PG8_LDA(dst, b, h) do { _Pragma("unroll") for (int m = 0; m < 4; ++m) _Pragma("unroll") for (int k = 0; k < 2; ++k) dst[m][k] = *(const PG8_LAS bf16x8*)(lds + PG8_SA(b, h) + aoff + m * 2048 + k * 1024); } while (0)
#define PG8_LDB(dst, b, h) do { _Pragma("unroll") for (int n = 0; n < 2; ++n) _Pragma("unroll") for (int k = 0; k < 2; ++k) dst[n][k] = *(const PG8_LAS bf16x8*)(lds + PG8_SB(b, h) + boff + n * 2048 + k * 1024); } while (0)
#define PG8_MMA(ai, bj, At, Bt) do { __builtin_amdgcn_s_setprio(1); _Pragma("unroll") for (int m = 0; m < 4; ++m) _Pragma("unroll") for (int n = 0; n < 2; ++n) _Pragma("unroll") for (int k = 0; k < 2; ++k) \
        acc[ai][bj][m][n] = __builtin_amdgcn_mfma_f32_16x16x32_bf16(Bt[n][k], At[m][k], acc[ai][bj][m][n], 0, 0, 0); __builtin_amdgcn_s_setprio(0); } while (0)
#define PG8_WAIT_V(n) asm volatile("s_waitcnt vmcnt(" #n ")" ::: "memory")
#define PG8_WAIT_L(n) asm volatile("s_waitcnt lgkmcnt(" #n ")" ::: "memory")
#define PG8_BAR __builtin_amdgcn_s_barrier()
#define PG8_SCHED __builtin_amdgcn_sched_barrier(0)
    Unit cur, nxt; int ui = 0;
    if (!S.next(0, cur)) return;
    f32x4 acc[2][2][4][2];
#pragma unroll
    for (int a = 0; a < 2; ++a)
#pragma unroll
        for (int b = 0; b < 2; ++b)
#pragma unroll
            for (int m = 0; m < 4; ++m)
#pragma unroll
                for (int n = 0; n < 2; ++n) acc[a][b][m][n] = (f32x4){0.f, 0.f, 0.f, 0.f};
    bf16x8 At[4][2], B0[2][2], B1[2][2];
    const char* cA = (const char*)g.A + (size_t)cur.pm * tstep + (size_t)cur.kb * 2; const char* cB = (const char*)g.Bt + (size_t)cur.pn * tstep + (size_t)cur.kb * 2;
    S.a_ready(cur);
    if constexpr (SP2) {
        PG8_STAGE(PG8_SB(0, 0), cB, voffB); PG8_STAGE(PG8_SB(0, 1), cB + hstep, voffB); PG8_STAGE(PG8_SA(0, 0), cA, voffA); PG8_STAGE(PG8_SA(0, 1), cA + hstep, voffA);
        if (wr == 1) PG8_BAR;
        PG8_WAIT_V(2); PG8_BAR;
        PG8_STAGE(PG8_SB(1, 0), cB + kstep, voffB); PG8_STAGE(PG8_SA(1, 0), cA + kstep, voffA); PG8_STAGE(PG8_SB(1, 1), cB + hstep + kstep, voffB);
        PG8_WAIT_V(6); PG8_BAR;
    } else {
        PG8_STAGE(PG8_SB(0, 0), cB, voffB); PG8_STAGE(PG8_SA(0, 0), cA, voffA); PG8_STAGE(PG8_SB(0, 1), cB + hstep, voffB); PG8_STAGE(PG8_SA(0, 1), cA + hstep, voffA);
        if (wr == 1) PG8_BAR;
        PG8_WAIT_V(4); PG8_BAR;
        PG8_STAGE(PG8_SB(1, 0), cB + kstep, voffB); PG8_STAGE(PG8_SA(1, 0), cA + kstep, voffA); PG8_STAGE(PG8_SB(1, 1), cB + hstep + kstep, voffB);
        PG8_WAIT_V(6); PG8_BAR;
    }
    for (;;) {
        const bool has_next = S.next(ui + 1, nxt);
        const char* nA = has_next ? (const char*)g.A + (size_t)nxt.pm * tstep + (size_t)nxt.kb * 2 : cA; const char* nB = has_next ? (const char*)g.Bt + (size_t)nxt.pn * tstep + (size_t)nxt.kb * 2 : cB;
        const int nt = cur.nk ? cur.nk : nt_all;
        for (int t = 0; t < nt; t += 2) {
            const bool last = (t == nt - 2);
            const char* a1 = cA + (size_t)(t + 1) * kstep;
            const char* a2 = last ? nA : cA + (size_t)(t + 2) * kstep; const char* b2 = last ? nB : cB + (size_t)(t + 2) * kstep;
            const char* a3 = a2 + kstep; const char* b3 = b2 + kstep;
            if (last && has_next) S.a_ready(nxt);
            if constexpr (SP2) {
            PG8_LDB(B0, 0, 0); PG8_LDB(B1, 0, 1); PG8_SCHED; PG8_LDA(At, 0, 0); PG8_STAGE(PG8_SA(1, 1), a1 + hstep, voffA);
            PG8_WAIT_V(8); PG8_WAIT_L(0); PG8_BAR; PG8_MMA(0, 0, At, B0); PG8_MMA(0, 1, At, B1); PG8_BAR; PG8_SCHED;
            PG8_LDA(At, 0, 1); PG8_STAGE(PG8_SB(0, 0), b2, voffB); PG8_STAGE(PG8_SB(0, 1), b2 + hstep, voffB); PG8_STAGE(PG8_SA(0, 0), a2, voffA);
            PG8_WAIT_V(8); PG8_WAIT_L(0); PG8_BAR; PG8_MMA(1, 0, At, B0); PG8_MMA(1, 1, At, B1); PG8_BAR; PG8_SCHED;
            PG8_LDB(B0, 1, 0); PG8_LDB(B1, 1, 1); PG8_SCHED; PG8_LDA(At, 1, 0); PG8_STAGE(PG8_SA(0, 1), a2 + hstep, voffA);
            PG8_WAIT_V(8); PG8_WAIT_L(0); PG8_BAR; PG8_MMA(0, 0, At, B0); PG8_MMA(0, 1, At, B1); PG8_BAR; PG8_SCHED;
            PG8_LDA(At, 1, 1); PG8_STAGE(PG8_SB(1, 0), b3, voffB); PG8_STAGE(PG8_SB(1, 1), b3 + hstep, voffB); PG8_STAGE(PG8_SA(1, 0), a3, voffA);
            PG8_WAIT_V(8); PG8_WAIT_L(0); PG8_BAR; PG8_MMA(1, 0, At, B0); PG8_MMA(1, 1, At, B1); PG8_BAR; PG8_SCHED;
            } else {
            PG8_LDB(B0, 0, 0); PG8_SCHED; PG8_LDA(At, 0, 0); PG8_STAGE(PG8_SA(1, 1), a1 + hstep, voffA);
            PG8_WAIT_L(8); PG8_BAR; PG8_WAIT_L(0); PG8_MMA(0, 0, At, B0); PG8_BAR; PG8_SCHED;
            PG8_LDB(B1, 0, 1); PG8_STAGE(PG8_SB(0, 0), b2, voffB);
            PG8_BAR; PG8_WAIT_L(0); PG8_MMA(0, 1, At, B1); PG8_BAR;
            PG8_LDA(At, 0, 1); PG8_STAGE(PG8_SA(0, 0), a2, voffA);
            PG8_BAR; PG8_WAIT_L(0); PG8_MMA(1, 0, At, B0); PG8_BAR; PG8_SCHED;
            PG8_STAGE(PG8_SB(0, 1), b2 + hstep, voffB);
            PG8_WAIT_V(6); PG8_BAR; PG8_MMA(1, 1, At, B1); PG8_BAR;
            PG8_LDB(B0, 1, 0); PG8_SCHED; PG8_LDA(At, 1, 0); PG8_STAGE(PG8_SA(0, 1), a2 + hstep, voffA);
            PG8_WAIT_L(8); PG8_BAR; PG8_WAIT_L(0); PG8_MMA(0, 0, At, B0); PG8_BAR; PG8_SCHED;
            PG8_LDB(B1, 1, 1); PG8_STAGE(PG8_SB(1, 0), b3, voffB);
            PG8_BAR; PG8_WAIT_L(0); PG8_MMA(0, 1, At, B1); PG8_BAR;
            PG8_LDA(At, 1, 1); PG8_STAGE(PG8_SA(1, 0), a3, voffA);
            PG8_BAR; PG8_WAIT_L(0); PG8_MMA(1, 0, At, B0); PG8_BAR; PG8_SCHED;
            PG8_STAGE(PG8_SB(1, 1), b3 + hstep, voffB);
            PG8_WAIT_V(6); PG8_BAR; PG8_MMA(1, 1, At, B1); PG8_BAR;
            }
        }
        if constexpr (ALIGN_EPI) { if (wr == 0) PG8_BAR; }
        if constexpr (!Epi::AFTER_DRAIN) { E(acc, cur, wr, wc, fr, fq); S.done(cur); }
        if (!has_next) break;
#pragma unroll
        for (int a = 0; a < 2; ++a)
#pragma unroll
            for (int b = 0; b < 2; ++b)
#pragma unroll
                for (int m = 0; m < 4; ++m)
#pragma unroll
                    for (int n = 0; n < 2; ++n) acc[a][b][m][n] = (f32x4){0.f, 0.f, 0.f, 0.f};
        cur = nxt; cA = nA; cB = nB; ++ui;
        if constexpr (ALIGN_EPI) { if (wr == 1) PG8_BAR; }
    }
    PG8_WAIT_V(0);
    if constexpr (!ALIGN_EPI) { if (wr == 0) PG8_BAR; }
    PG8_BAR;
    if constexpr (Epi::AFTER_DRAIN) { E.fused(acc, cur, wr, wc, fr, fq, lds, wid, lane); S.done(cur); }
#undef PG8_SA
#undef PG8_SB
#undef PG8_STAGE
#undef PG8_LDA
#undef PG8_LDB
#undef PG8_MMA
#undef PG8_WAIT_V
#undef PG8_WAIT_L
#undef PG8_BAR
#undef PG8_SCHED
}
}

#define LAS __attribute__((address_space(3)))
typedef unsigned short bf16_t;
typedef short bf16x8 __attribute__((ext_vector_type(8)));
typedef float f32x4 __attribute__((ext_vector_type(4)));
typedef unsigned u32x4 __attribute__((ext_vector_type(4)));
typedef unsigned u32x2 __attribute__((ext_vector_type(2)));
typedef __bf16 bf16x2_t __attribute__((ext_vector_type(2)));

constexpr int DM = 1024, DFF = 2816, NLAYER = 4, NMOD = 9;
constexpr int TL = 32768, TC = 512, TT = TL + TC;
constexpr int PW = 2816;
constexpr int NCH = 260;
constexpr int LDS_BYTES = 155648;
constexpr int NTHREADS = 512;

constexpr size_t MiB = 1u << 20;
constexpr size_t WS_MOD = 0, WS_HCTX = 1 * MiB, WS_WG = 3 * MiB, WS_RGA = 4 * MiB, WS_RGH = 7 * MiB, WS_RGC = 10 * MiB, WS_GLD = 13 * MiB,
                 WS_BAR = 15 * MiB, WS_W13 = 16 * MiB, WS_W2 = 38 * MiB, WS_WIN = 49 * MiB, WS_WOUT = 55 * MiB, WS_U = 58 * MiB, WS_MIX = 123 * MiB,
                 WS_GP = 188 * MiB, WS_QK = 367 * MiB, WS_GLS = 432 * MiB, WS_PART = 562 * MiB, WS_SS = 585 * MiB, WS_BIAS = 588 * MiB, WS_RS = 588 * MiB + 512 * 1024, WS_END = 589 * MiB;

struct Params {
    const float *x, *c, *ctx, *c_ctx, *w_mod, *b_mod, *norm_g, *ffn_w1, *ffn_w3, *ffn_w2, *w_in, *conv_w, *conv_b, *rg_lam, *rg_wa, *rg_ba, *rg_wi, *rg_bi,
        *gla_wup, *gla_bup, *gla_norm_g, *w_out, *final_g;
    float* out; unsigned char* ws;
};

typedef const __attribute__((address_space(4))) Params& PREF;
#define WAVE_SYNC() asm volatile("s_waitcnt lgkmcnt(0)" ::: "memory")

__device__ __forceinline__ unsigned f2bf(float f) { unsigned r; asm("v_cvt_pk_bf16_f32 %0, %1, %1" : "=v"(r) : "v"(f)); return r & 0xffffu; }
__device__ __forceinline__ unsigned pk2(float lo, float hi) { unsigned r; asm("v_cvt_pk_bf16_f32 %0, %1, %2" : "=v"(r) : "v"(lo), "v"(hi)); return r; }
__device__ __forceinline__ float bf2f(unsigned h) { return __builtin_bit_cast(float, h << 16); }
__device__ __forceinline__ float rcpf_(float x) { return __builtin_amdgcn_rcpf(x); }
__device__ __forceinline__ float sigmoid_f(float x) { return rcpf_(1.f + __expf(-x)); }
__device__ __forceinline__ float silu_f(float x) { return x * sigmoid_f(x); }
__device__ __forceinline__ float gelu_tanh_f(float x) { const float y = 0.7978845608028654f * (x + 0.044715f * x * x * x); return x * sigmoid_f(2.f * y); }
__device__ __forceinline__ float shx(float v, int m, int lane) { return __builtin_bit_cast(float, __builtin_amdgcn_ds_bpermute((lane ^ m) << 2, __builtin_bit_cast(int, v))); }
__device__ __forceinline__ float wave_sum(float v, int lane) {
#pragma unroll
    for (int o = 1; o < 64; o <<= 1) v += shx(v, o, lane);
    return v;
}
__device__ __forceinline__ f32x4 mfma16(bf16x8 a, bf16x8 b, f32x4 c) { return __builtin_amdgcn_mfma_f32_16x16x32_bf16(a, b, c, 0, 0, 0); }

__device__ __forceinline__ float row_rs(const float* rsv, int row) { return rsv[row]; }
struct EpiSwiglu {
    static constexpr bool PERM = true, AFTER_DRAIN = false;
    bf16_t* G; const float* ss; const float* bias;
    __device__ __forceinline__ void operator()(const f32x4 (&acc)[2][2][4][2], const pg8::Unit& u, int wr, int wc, int fr, int fq) const {
        asm volatile("" : "+v"(fr), "+v"(fq));
        const int row0 = u.pm * 256 + wr * 64 + fr, col0 = u.pn * 128 + wc * 32 + 8 * fq;
        const float* bp = bias + (size_t)((u.pm * 256) >> 14) * 5632 + col0;
        const f32x4 c10 = *(const f32x4*)bp, c11 = *(const f32x4*)(bp + 4), c30 = *(const f32x4*)(bp + 2816), c31 = *(const f32x4*)(bp + 2816 + 4);
#pragma unroll
        for (int ai = 0; ai < 2; ++ai)
#pragma unroll
            for (int m = 0; m < 4; ++m) {
                const int row = row0 + ai * 128 + m * 16; const float rs = row_rs(ss, row);
                const f32x4 a0 = acc[ai][0][m][0] * rs + c10, a1 = acc[ai][0][m][1] * rs + c11, b0 = acc[ai][1][m][0] * rs + c30, b1 = acc[ai][1][m][1] * rs + c31;
                u32x4 w;
                w.x = pk2(silu_f(a0[0]) * b0[0], silu_f(a0[1]) * b0[1]); w.y = pk2(silu_f(a0[2]) * b0[2], silu_f(a0[3]) * b0[3]);
                w.z = pk2(silu_f(a1[0]) * b1[0], silu_f(a1[1]) * b1[1]); w.w = pk2(silu_f(a1[2]) * b1[2], silu_f(a1[3]) * b1[3]);
                *(u32x4*)(G + (size_t)row * PW + col0) = w;
            }
    }
};
struct EpiStore {
    static constexpr bool PERM = true, AFTER_DRAIN = false;
    bf16_t* O; int ldc; const float* ss; const float* bias; unsigned* cnt;
    __device__ __forceinline__ void operator()(const f32x4 (&acc)[2][2][4][2], const pg8::Unit& u, int wr, int wc, int fr, int fq) const {
        asm volatile("" : "+v"(fr), "+v"(fq));
        const int row0 = u.pm * 256 + wr * 64 + fr, col0 = u.pn * 256 + wc * 32 + 8 * fq;
        const float* bp = bias + (size_t)((u.pm * 256) >> 14) * 5632 + col0;
        f32x4 cb[2][2];
#pragma unroll
        for (int bj = 0; bj < 2; ++bj) { cb[bj][0] = *(const f32x4*)(bp + bj * 128); cb[bj][1] = *(const f32x4*)(bp + bj * 128 + 4); }
#pragma unroll
        for (int ai = 0; ai < 2; ++ai)
#pragma unroll
            for (int m = 0; m < 4; ++m) {
                const int row = row0 + ai * 128 + m * 16; const float rs = row_rs(ss, row);
#pragma unroll
                for (int bj = 0; bj < 2; ++bj) {
                    const f32x4 v0 = acc[ai][bj][m][0] * rs + cb[bj][0], v1 = acc[ai][bj][m][1] * rs + cb[bj][1];
                    u32x4 w; w.x = pk2(v0[0], v0[1]); w.y = pk2(v0[2], v0[3]); w.z = pk2(v1[0], v1[1]); w.w = pk2(v1[2], v1[3]);
                    *(u32x4*)(O + (size_t)row * ldc + col0 + bj * 128) = w;
                }
            }
        if (cnt && u.pm * 256 >= TL) {
            __builtin_amdgcn_fence(__ATOMIC_RELEASE, "agent");
            asm volatile("s_waitcnt vmcnt(0)" ::: "memory");
            if (fq == 0 && fr == 0) (void)__hip_atomic_fetch_add(cnt, 1u, __ATOMIC_RELAXED, __HIP_MEMORY_SCOPE_AGENT);
        }
    }
};
struct EpiResid {
    static constexpr bool PERM = true, AFTER_DRAIN = false;
    const float* hin_lat; float* hout_lat; unsigned char* wsb; const float* gate; const float* ngn; const float* scn; float coef; int emit;
    __device__ __forceinline__ void operator()(const f32x4 (&acc)[2][2][4][2], const pg8::Unit& u, int wr, int wc, int fr, int fq) const {
        asm volatile("" : "+v"(fr), "+v"(fq));
        float* const hout_ctx = (float*)(wsb + WS_HCTX); float* const part = (float*)(wsb + WS_PART); bf16_t* const Un = emit ? (bf16_t*)(wsb + WS_U) : (bf16_t*)nullptr; float* const ssn = (float*)(wsb + WS_SS);
        const int rowt = u.pm * 256; const int grp = rowt >> 14;
        const bool isctx = rowt >= TL;
        if (isctx) {
            const int row0 = rowt - TL + wr * 64 + fr, col0 = u.pn * 256 + wc * 32 + 8 * fq;
            const float* gp = gate + (size_t)2 * (NMOD * DM) + col0;
            float* pb = part + (size_t)(u.kb >> 8) * (TC * DM);
#pragma unroll
            for (int bj = 0; bj < 2; ++bj) {
                const f32x4 g0 = *(const f32x4*)(gp + bj * 128) * coef, g1 = *(const f32x4*)(gp + bj * 128 + 4) * coef;
#pragma unroll
                for (int ai = 0; ai < 2; ++ai)
#pragma unroll
                    for (int m = 0; m < 4; ++m) {
                        float* o = pb + (size_t)(row0 + ai * 128 + m * 16) * DM + col0 + bj * 128;
                        *(f32x4*)o = g0 * acc[ai][bj][m][0]; *(f32x4*)(o + 4) = g1 * acc[ai][bj][m][1];
                    }
            }
            return;
        }
        const float* hin = hin_lat; float* hout = hout_lat;
        const int row0 = rowt + wr * 64 + fr, col0 = u.pn * 256 + wc * 32 + 8 * fq;
        const float* gp = gate + (size_t)grp * (NMOD * DM) + col0;
        float sq[2][4];
#pragma unroll
        for (int ai = 0; ai < 2; ++ai)
#pragma unroll
            for (int m = 0; m < 4; ++m) sq[ai][m] = 0.f;
#pragma unroll
        for (int bj = 0; bj < 2; ++bj) {
            const f32x4 g0 = *(const f32x4*)(gp + bj * 128) * coef, g1 = *(const f32x4*)(gp + bj * 128 + 4) * coef;
            f32x4 s0 = {0.f, 0.f, 0.f, 0.f}, s1 = s0;
            if (Un) { const float* np_ = ngn + col0 + bj * 128; const float* sp_ = scn + (size_t)grp * (NMOD * DM) + col0 + bj * 128;
                s0 = *(const f32x4*)np_ * (*(const f32x4*)sp_ + 1.f); s1 = *(const f32x4*)(np_ + 4) * (*(const f32x4*)(sp_ + 4) + 1.f); }
#pragma unroll
            for (int ai = 0; ai < 2; ++ai)
#pragma unroll
                for (int m = 0; m < 4; ++m) {
                    const size_t off = (size_t)(row0 + ai * 128 + m * 16) * DM + col0 + bj * 128;
                    const f32x4 h0 = *(const f32x4*)(hin + off) + g0 * acc[ai][bj][m][0], h1 = *(const f32x4*)(hin + off + 4) + g1 * acc[ai][bj][m][1];
                    *(f32x4*)(hout + off) = h0;
                    *(f32x4*)(hout + off + 4) = h1;
                    if (Un) {
                        sq[ai][m] += ((h0[0] * h0[0] + h0[1] * h0[1]) + (h0[2] * h0[2] + h0[3] * h0[3])) + ((h1[0] * h1[0] + h1[1] * h1[1]) + (h1[2] * h1[2] + h1[3] * h1[3]));
                        const f32x4 u0 = h0 * s0, u1 = h1 * s1;
                        u32x4 w; w.x = pk2(u0[0], u0[1]); w.y = pk2(u0[2], u0[3]); w.z = pk2(u1[0], u1[1]); w.w = pk2(u1[2], u1[3]);
                        *(u32x4*)(Un + off) = w;
                    }
                }
        }
        if (Un) {
#pragma unroll
            for (int ai = 0; ai < 2; ++ai)
#pragma unroll
                for (int m = 0; m < 4; ++m) { float t = sq[ai][m]; t += shx(t, 16, fq * 16 + fr); t += shx(t, 32, fq * 16 + fr);
                    if (fq == 0) ssn[(size_t)(row0 + ai * 128 + m * 16) * 16 + u.pn * 4 + wc] = t; }
        }
    }
};

struct InpOrder {
    int G, c;
    __device__ bool next(int i, pg8::Unit& u) const {
        const int L = i * G + c; u.kb = 0; u.nk = 0;
        if (L < 22) { u.pm = TL / 256 + L / 11; u.pn = L % 11; return true; }
        int wgid = L - 22; const int nM = TL / 256, nN = 11, nwg = nM * nN; if (wgid >= nwg) return false;
        { const int q = nwg / pg8::NXCD, r = nwg % pg8::NXCD, xcd = wgid % pg8::NXCD, off = wgid / pg8::NXCD; wgid = (xcd < r ? xcd * (q + 1) : r * (q + 1) + (xcd - r) * q) + off; }
        const int nig = pg8::WGM * nN, gid = wgid / nig, fm = gid * pg8::WGM, gsz = (nM - fm) < pg8::WGM ? (nM - fm) : pg8::WGM;
        u.pm = fm + ((wgid % nig) % gsz); u.pn = (wgid % nig) / gsz; return true;
    }
    __device__ __forceinline__ void a_ready(const pg8::Unit&) const {}
    __device__ __forceinline__ void done(const pg8::Unit&) const {}
};
struct DownOrder {
    pg8::StaticOrder so; pg8::SplitKOrder sk; int nlat, nctx, inv;
    __device__ bool next(int i, pg8::Unit& u) const {
        const int L = i * so.G + so.c;
        if (L < nlat) return so.next(i, u);
        const int Lc = L - nlat; if (Lc >= nctx) return false;
        const int tile = (Lc * inv) >> 16, ks = Lc - tile * sk.nsplit;
        u.pm = sk.pm0 + (tile >> 2); u.pn = tile & 3; u.kb = ks * 256; u.nk = 4; return true;
    }
    __device__ __forceinline__ void a_ready(const pg8::Unit&) const {}
    __device__ __forceinline__ void done(const pg8::Unit&) const {}
};

__device__ __forceinline__ void transpose_item(const float* __restrict__ W, int K, int ldn, bf16_t* __restrict__ WT, int drow, int k0, int n0, LAS float* scr, int lane) {
    float wv[32];
#pragma unroll
    for (int i = 0; i < 32; ++i) { const int kk = 2 * i + (lane >> 5); wv[i] = W[(size_t)(k0 + kk) * ldn + n0 + (lane & 31)]; }
#pragma unroll
    for (int i = 0; i < 32; ++i) { const int kk = 2 * i + (lane >> 5); scr[kk * 33 + (lane & 31)] = wv[i]; }
    WAVE_SYNC();
    const int c = lane & 7;
#pragma unroll
    for (int j = 0; j < 4; ++j) { const int n = (lane >> 3) + 8 * j; const LAS float* s = scr + (8 * c) * 33 + n;
        u32x4 o; o.x = pk2(s[0 * 33], s[1 * 33]); o.y = pk2(s[2 * 33], s[3 * 33]); o.z = pk2(s[4 * 33], s[5 * 33]); o.w = pk2(s[6 * 33], s[7 * 33]);
        *(u32x4*)(WT + (size_t)(drow + n0 + n) * K + k0 + 8 * c) = o; }
    WAVE_SYNC();
}

__device__ __forceinline__ void convert_weights(PREF p, int l, LAS unsigned char* lds, int gw, int NGW, int wave, int lane) {
    LAS float* scr = (LAS float*)(lds + wave * 16384);
    unsigned char* ws = p.ws;
    bf16_t* W13 = (bf16_t*)(ws + WS_W13); bf16_t* W2 = (bf16_t*)(ws + WS_W2); bf16_t* WIN = (bf16_t*)(ws + WS_WIN); bf16_t* WOUT = (bf16_t*)(ws + WS_WOUT);
    constexpr int I_UP = 16 * 88, I_DN = 44 * 32, I_IN = 16 * 81, I_OUT = 16 * 32;
    constexpr int NIT = 4 * I_UP + 2 * I_DN + I_IN + I_OUT;
    for (int it = gw; it < NIT; it += NGW) {
        int r = it;
        if (r < 4 * I_UP) { const int seg = r / I_UP; r -= seg * I_UP; const int f = seg >> 1, is3 = seg & 1;
            const int kb = r / 88, nb = r % 88, n0 = nb * 32;
            const float* W = (is3 ? p.ffn_w3 : p.ffn_w1) + (size_t)(l * 2 + f) * DM * DFF;
            transpose_item(W, DM, DFF, W13 + (size_t)f * 5632 * DM, (n0 >> 7) * 256 + (n0 & 127) + is3 * 128 - n0, kb * 64, n0, scr, lane); continue; }
        r -= 4 * I_UP;
        if (r < 2 * I_DN) { const int f = r / I_DN; r -= f * I_DN; const int kb = r / 32, nb = r % 32;
            transpose_item(p.ffn_w2 + (size_t)(l * 2 + f) * DFF * DM, DFF, DM, W2 + (size_t)f * DM * DFF, 0, kb * 64, nb * 32, scr, lane); continue; }
        r -= 2 * I_DN;
        if (r < I_IN) { const int kb = r / 81, nb = r % 81;
            transpose_item(p.w_in + (size_t)l * DM * 2592, DM, 2592, WIN, 0, kb * 64, nb * 32, scr, lane); continue; }
        r -= I_IN;
        { const int kb = r / 32, nb = r % 32; transpose_item(p.w_out + (size_t)l * DM * DM, DM, DM, WOUT, 0, kb * 64, nb * 32, scr, lane); }
    }
}

__device__ __forceinline__ void phase_mods(PREF p, LAS unsigned char* lds, int tid, int wave, int lane) {
    LAS float* sS = (LAS float*)lds;
    LAS float* red = (LAS float*)(lds + 12288);
    float* mod = (float*)(p.ws + WS_MOD);
    for (int i = tid; i < 3072; i += NTHREADS) { const int g = i >> 10, k = i & 1023; const float xv = g < 2 ? p.c[g * 1024 + k] : p.c_ctx[k]; sS[i] = silu_f(xv); }
    __syncthreads();
    for (int item = blockIdx.x; item < NLAYER * 144; item += gridDim.x) {
        const int l = item / 144, nc = item % 144;
        const float* W = p.w_mod + (size_t)l * DM * (NMOD * DM) + nc * 64 + lane;
        float a0 = 0.f, a1 = 0.f, a2 = 0.f; const int k0 = wave * 128;
#pragma unroll 16
        for (int kk = 0; kk < 128; ++kk) { const int k = k0 + kk; const float w = W[(size_t)k * (NMOD * DM)]; a0 += sS[k] * w; a1 += sS[1024 + k] * w; a2 += sS[2048 + k] * w; }
        red[(wave * 3 + 0) * 64 + lane] = a0; red[(wave * 3 + 1) * 64 + lane] = a1; red[(wave * 3 + 2) * 64 + lane] = a2;
        __syncthreads();
        if (wave < 3) { float s = p.b_mod[l * (NMOD * DM) + nc * 64 + lane];
#pragma unroll
            for (int w = 0; w < 8; ++w) s += red[(w * 3 + wave) * 64 + lane];
            mod[(size_t)(l * 3 + wave) * (NMOD * DM) + nc * 64 + lane] = s; }
        __syncthreads();
    }
}

__device__ __forceinline__ void phase_gatew(PREF p, int gtid, int gthreads) {
    bf16_t* WgT = (bf16_t*)(p.ws + WS_WG);
    for (int e = gtid; e < NLAYER * 2 * 2 * 8 * 4096; e += gthreads) {
        const int i = e & 63, j = (e >> 6) & 63, h = (e >> 12) & 7, ty = (e >> 15) & 1, d = (e >> 16) & 1, l = e >> 17;
        const float* src = ty ? p.rg_wi : p.rg_wa;
        WgT[e] = (bf16_t)f2bf(src[(size_t)((l * 2 + d) * 8 + h) * 4096 + i * 64 + j]);
    }
}

__device__ __forceinline__ void phase_norm(PREF p, int l, int jn, int rbeg, int rend, bool first, int nsplit, int gw, int NGW, int lane) {
    const float* mod = (const float*)(p.ws + WS_MOD); const float* hctx = (const float*)(p.ws + WS_HCTX); bf16_t* U = (bf16_t*)(p.ws + WS_U); float* SS = (float*)(p.ws + WS_SS);
    const float* ng = p.norm_g + (size_t)(l * 3 + jn) * DM;
    for (int row = rbeg + gw; row < rend; row += NGW) {
        const float* src = row < TL ? ((first ? p.x : p.out) + (size_t)row * DM) : ((first ? p.ctx : hctx) + (size_t)(row - TL) * DM);
        const float* mb = mod + (size_t)(l * 3 + (row >> 14)) * (NMOD * DM);
        f32x4 v[4]; float ss = 0.f;
#pragma unroll
        for (int j = 0; j < 4; ++j) v[j] = *(const f32x4*)(src + 4 * lane + 256 * j);
        if (row >= TL && nsplit > 0) {
            const float* pr = (const float*)(p.ws + WS_PART) + (size_t)(row - TL) * DM + 4 * lane;
            for (int k = 0; k < nsplit; ++k)
#pragma unroll
                for (int j = 0; j < 4; ++j) v[j] += *(const f32x4*)(pr + (size_t)k * (TC * DM) + 256 * j);
            float* dst = (float*)(p.ws + WS_HCTX) + (size_t)(row - TL) * DM + 4 * lane;
#pragma unroll
            for (int j = 0; j < 4; ++j) *(f32x4*)(dst + 256 * j) = v[j];
        }
#pragma unroll
        for (int j = 0; j < 4; ++j) ss += (v[j][0] * v[j][0] + v[j][1] * v[j][1]) + (v[j][2] * v[j][2] + v[j][3] * v[j][3]);
        ss = wave_sum(ss, lane);
        if (lane == 0) ((float*)(p.ws + WS_RS))[row] = __builtin_amdgcn_rsqf(ss * (1.f / DM) + 1e-6f);
#pragma unroll
        for (int j = 0; j < 4; ++j) { const int col = 4 * lane + 256 * j;
            const f32x4 g = *(const f32x4*)(ng + col), sc = *(const f32x4*)(mb + (3 * jn + 1) * DM + col);
            const f32x4 o = v[j] * g * (sc + 1.f);
            u32x2 w; w.x = pk2(o[0], o[1]); w.y = pk2(o[2], o[3]);
            *(u32x2*)(U + (size_t)row * DM + col) = w; }
    }
}
__device__ __forceinline__ void phase_rs(PREF p, int gtid, int gthreads) {
    const float* SS = (const float*)(p.ws + WS_SS); float* RS = (float*)(p.ws + WS_RS);
    for (int row = gtid; row < TL; row += gthreads) {
        const f32x4 a = *(const f32x4*)(SS + (size_t)row * 16), b = *(const f32x4*)(SS + (size_t)row * 16 + 4), c = *(const f32x4*)(SS + (size_t)row * 16 + 8), d = *(const f32x4*)(SS + (size_t)row * 16 + 12);
        const float t = (((a[0] + a[1]) + (a[2] + a[3])) + ((b[0] + b[1]) + (b[2] + b[3]))) + (((c[0] + c[1]) + (c[2] + c[3])) + ((d[0] + d[1]) + (d[2] + d[3])));
        RS[row] = __builtin_amdgcn_rsqf(t * (1.f / DM) + 1e-6f);
    }
}
__device__ __forceinline__ void phase_bias(PREF p, int l, LAS unsigned char* lds, int tid, int wave, int lane) {
    LAS float* sS = (LAS float*)lds;
    LAS float* red = (LAS float*)(lds + 12288);
    const float* mod = (const float*)(p.ws + WS_MOD); float* BIAS = (float*)(p.ws + WS_BIAS);
    for (int item = blockIdx.x; item < 217; item += gridDim.x) {
        int mi, nc;
        if (item < 44) { mi = 0; nc = item; } else if (item < 88) { mi = 1; nc = item - 44; } else if (item < 129) { mi = 2; nc = item - 88; } else if (item < 173) { mi = 3; nc = item - 129; } else { mi = 4; nc = item - 173; }
        const int jn = mi < 2 ? 0 : (mi == 2 ? 1 : 2), slot = jn, boff = (mi == 1 || mi == 4) ? 2816 : 0, f = mi >= 3 ? 1 : 0;
        const int ldn = mi == 2 ? 2592 : DFF;
        const float* Wm = mi == 2 ? p.w_in + (size_t)l * DM * 2592 : ((mi == 1 || mi == 4) ? p.ffn_w3 : p.ffn_w1) + (size_t)(l * 2 + f) * DM * DFF;
        for (int i = tid; i < 3072; i += NTHREADS) { const int g = i >> 10, k = i & 1023; sS[i] = mod[(size_t)(l * 3 + g) * (NMOD * DM) + (3 * jn) * DM + k]; }
        __syncthreads();
        const int n = nc * 64 + lane; const bool nv = n < ldn;
        const float* W = Wm + (nv ? n : 0);
        float a0 = 0.f, a1 = 0.f, a2 = 0.f; const int k0 = wave * 128;
#pragma unroll 16
        for (int kk = 0; kk < 128; ++kk) { const int k = k0 + kk; const float w = W[(size_t)k * ldn]; a0 += sS[k] * w; a1 += sS[1024 + k] * w; a2 += sS[2048 + k] * w; }
        red[(wave * 3 + 0) * 64 + lane] = a0; red[(wave * 3 + 1) * 64 + lane] = a1; red[(wave * 3 + 2) * 64 + lane] = a2;
        __syncthreads();
        if (wave < 3 && nv) { float sum = 0.f;
#pragma unroll
            for (int w = 0; w < 8; ++w) sum += red[(w * 3 + wave) * 64 + lane];
            BIAS[(size_t)(slot * 3 + wave) * 5632 + boff + n] = sum; }
        __syncthreads();
    }
}
__device__ __forceinline__ void phase_final(PREF p, int gw, int NGW, int lane) {
    for (int row = gw; row < TL; row += NGW) {
        float* src = p.out + (size_t)row * DM;
        f32x4 v[4]; float ss = 0.f;
#pragma unroll
        for (int j = 0; j < 4; ++j) { v[j] = *(const f32x4*)(src + 4 * lane + 256 * j); ss += (v[j][0] * v[j][0] + v[j][1] * v[j][1]) + (v[j][2] * v[j][2] + v[j][3] * v[j][3]); }
        const float rs = __builtin_amdgcn_rsqf(wave_sum(ss, lane) * (1.f / DM) + 1e-6f);
#pragma unroll
        for (int j = 0; j < 4; ++j) { const int col = 4 * lane + 256 * j; const f32x4 g = *(const f32x4*)(p.final_g + col); *(f32x4*)(src + col) = v[j] * rs * g; }
    }
}

__device__ __forceinline__ int scan_order(int d, int step) { return d == 0 ? step : (step < 4 ? 3 - step : 263 - step); }

template <bool FINAL, int D>
__device__ __forceinline__ void rg_dir(PREF p, int l, int h, int ch, int sidx, int rowbase  , LAS bf16_t* sXc, LAS float* stg, int lane) {
    const bf16_t* __restrict__ P = (const bf16_t*)(p.ws + WS_GP); const bf16_t* __restrict__ WgT = (const bf16_t*)(p.ws + WS_WG);
    float* __restrict__ RGA = (float*)(p.ws + WS_RGA); float* __restrict__ RGH = (float*)(p.ws + WS_RGH); const float* __restrict__ RGC = (const float*)(p.ws + WS_RGC);
    bf16_t* __restrict__ MIX = (bf16_t*)(p.ws + WS_MIX);
    bf16_t* __restrict__ TMP = (bf16_t*)(p.ws + WS_U);
    const bf16_t* wr_ = WgT + (size_t)(((l * 2 + D) * 2 + 0) * 8 + h) * 4096; const bf16_t* wi_ = WgT + (size_t)(((l * 2 + D) * 2 + 1) * 8 + h) * 4096;
    const float ba = p.rg_ba[(l * 2 + D) * 512 + ch], bi = p.rg_bi[(l * 2 + D) * 512 + ch], lam = p.rg_lam[(l * 2 + D) * 512 + ch];
    const float e_ = __expf(-lam), u_ = 1.f + e_;
    const float l1p = (u_ == 1.f) ? e_ : __logf(u_) * e_ * rcpf_(u_ - 1.f);
    const float sp8 = -8.f * 1.4426950408889634f * l1p;
    float hc = FINAL ? RGC[sidx] : 0.f, Ap = 1.f;
    bf16x8 Br[4][2], Bi[4][2];
#pragma unroll
    for (int nt = 0; nt < 4; ++nt) { const int o0 = (nt * 16 + (lane & 15)) * 64 + (lane >> 4) * 8;
        Br[nt][0] = *(const bf16x8*)(wr_ + o0); Br[nt][1] = *(const bf16x8*)(wr_ + o0 + 32); Bi[nt][0] = *(const bf16x8*)(wi_ + o0); Bi[nt][1] = *(const bf16x8*)(wi_ + o0 + 32); }
    if (FINAL && D == 1) asm volatile("s_waitcnt vmcnt(0)" ::: "memory");
#pragma unroll 1
    for (int mi = 0; mi < 4; ++mi) { const int mt = D ? 3 - mi : mi;
        float grv[16], hfv[16];
        if (FINAL && D == 1) {
#pragma unroll
            for (int ti = 0; ti < 16; ++ti) { const size_t row = (size_t)(rowbase + mt * 16 + 15 - ti); grv[ti] = __builtin_bit_cast(float, (unsigned)P[row * PW + 512 + ch]); hfv[ti] = __builtin_bit_cast(float, (unsigned)TMP[row * 512 + ch]); }
            __builtin_amdgcn_sched_barrier(0);
#pragma unroll
            for (int ti = 0; ti < 16; ++ti) { grv[ti] = bf2f(__builtin_bit_cast(unsigned, grv[ti])); hfv[ti] = bf2f(__builtin_bit_cast(unsigned, hfv[ti])); }
        }
        const bf16x8 A0 = *(const LAS bf16x8*)(sXc + (mt * 16 + (lane & 15)) * 72 + (lane >> 4) * 8), A1 = *(const LAS bf16x8*)(sXc + (mt * 16 + (lane & 15)) * 72 + 32 + (lane >> 4) * 8);
        f32x4 ar[4], ai[4];
#pragma unroll
        for (int nt = 0; nt < 4; ++nt) { const f32x4 z = {0.f, 0.f, 0.f, 0.f};
            ar[nt] = mfma16(A0, Br[nt][0], z); ar[nt] = mfma16(A1, Br[nt][1], ar[nt]); ai[nt] = mfma16(A0, Bi[nt][0], z); ai[nt] = mfma16(A1, Bi[nt][1], ai[nt]); }
        WAVE_SYNC();
#pragma unroll
        for (int nt = 0; nt < 4; ++nt)
#pragma unroll
            for (int j = 0; j < 4; ++j) { const int o = ((lane >> 4) * 4 + j) * 64 + nt * 16 + (lane & 15); stg[o] = ar[nt][j]; stg[1024 + o] = ai[nt][j]; }
        WAVE_SYNC();
        float av[16], iv[16];
#pragma unroll
        for (int ti = 0; ti < 16; ++ti) { const int tk = D ? 15 - ti : ti;
            const float zr = stg[tk * 64 + lane] + ba, zi = stg[1024 + tk * 64 + lane] + bi;
            const float r = sigmoid_f(zr), ig = sigmoid_f(zi);
            const float a = __builtin_amdgcn_exp2f(r * sp8);
            const float xc = bf2f(sXc[(mt * 16 + tk) * 72 + lane]);
            av[ti] = a; iv[ti] = __builtin_amdgcn_sqrtf(fmaxf(1.f - a * a, 0.f)) * ig * xc;
            if (FINAL && D == 1) grv[ti] = gelu_tanh_f(grv[ti]);
        }
#pragma unroll
        for (int ti = 0; ti < 16; ++ti) { const int tk = D ? 15 - ti : ti;
            hc = av[ti] * hc + iv[ti]; Ap *= av[ti];
            if (FINAL) { const size_t row = (size_t)(rowbase + mt * 16 + tk);
                if (D == 0) TMP[row * 512 + ch] = (bf16_t)f2bf(hc);
                else MIX[row * DM + ch] = (bf16_t)f2bf(grv[ti] * (hfv[ti] + hc)); }
        }
    }
    if (!FINAL) { RGA[sidx] = Ap; RGH[sidx] = hc; }
}

template <bool FINAL>
__device__ __forceinline__ void rg_item(PREF p, int l, int item, LAS unsigned char* wl, int lane) {
    const bf16_t* __restrict__ P = (const bf16_t*)(p.ws + WS_GP);
    const int h = item & 7, rest = item >> 3;
    const int ci = rest < 512 ? 4 + (rest & 255) : ((rest - 512) & 3), b = rest < 512 ? (rest >> 8) : ((rest - 512) >> 2);
    const int seq_row0 = ci < 4 ? TL + b * 256 : b * 16384;
    const int t0 = ci < 4 ? ci * 64 : (ci - 4) * 64;
    const int seqlen = ci < 4 ? 256 : 16384;
    const int ch = h * 64 + lane;
    LAS bf16_t* sXc = (LAS bf16_t*)wl;
    LAS float* stg = (LAS float*)(wl + 9216);
    {
        const float cw0 = p.conv_w[(l * 4 + 0) * 512 + ch], cw1 = p.conv_w[(l * 4 + 1) * 512 + ch], cw2 = p.conv_w[(l * 4 + 2) * 512 + ch], cw3 = p.conv_w[(l * 4 + 3) * 512 + ch];
        const float cb = p.conv_b[l * 512 + ch];
        float xv[67]; unsigned xr_[67];
#pragma unroll
        for (int i = 0; i < 67; ++i) { const int t = t0 - 2 + i; const int tc = t < 0 ? 0 : (t >= seqlen ? seqlen - 1 : t);
            xr_[i] = P[(size_t)(seq_row0 + tc) * PW + ch]; }
        __builtin_amdgcn_sched_barrier(0);
#pragma unroll
        for (int i = 0; i < 67; ++i) { const int t = t0 - 2 + i; const int tc = t < 0 ? 0 : (t >= seqlen ? seqlen - 1 : t); xv[i] = (t == tc) ? bf2f(xr_[i]) : 0.f; }
#pragma unroll
        for (int tt = 0; tt < 64; ++tt) { const float xc = xv[tt] * cw0 + xv[tt + 1] * cw1 + xv[tt + 2] * cw2 + xv[tt + 3] * cw3 + cb; sXc[tt * 72 + lane] = (bf16_t)f2bf(xc); }
    }
    WAVE_SYNC();
    const int sidx0 = ((b * NCH + ci) * 2) * 512 + ch;
    rg_dir<FINAL, 0>(p, l, h, ch, sidx0, seq_row0 + t0, sXc, stg, lane);
    rg_dir<FINAL, 1>(p, l, h, ch, sidx0 + 512, seq_row0 + t0, sXc, stg, lane);
    WAVE_SYNC();
}

__device__ __forceinline__ void rg_carry(PREF p, int wave, int lane) {
    if (wave != 0 || blockIdx.x < 128 || blockIdx.x >= 160) return;
    const int gtid = ((int)blockIdx.x - 128) * 64 + lane;
    const float* __restrict__ RGA = (const float*)(p.ws + WS_RGA); const float* __restrict__ RGH = (const float*)(p.ws + WS_RGH); float* __restrict__ RGC = (float*)(p.ws + WS_RGC);
    const int b = gtid >> 10, d = (gtid >> 9) & 1, ch = gtid & 511;
    float h = 0.f;
    for (int s0 = 0; s0 < NCH; s0 += 26) {
        float av[26], hv[26];
#pragma unroll
        for (int k = 0; k < 26; ++k) { const int idx = ((b * NCH + scan_order(d, s0 + k)) * 2 + d) * 512 + ch; av[k] = RGA[idx]; hv[k] = RGH[idx]; }
#pragma unroll
        for (int k = 0; k < 26; ++k) { const int idx = ((b * NCH + scan_order(d, s0 + k)) * 2 + d) * 512 + ch; RGC[idx] = h; h = av[k] * h + hv[k]; }
    }
}

__device__ __forceinline__ void gla_rows(int b, int cj, int& row0, int& rstride) {
    if (cj < 4) { row0 = TL + b * 256 + cj * 64; rstride = 1; }
    else { const int q = cj - 4; row0 = b * 16384 + ((q & 3) * 64) * 64 + (q >> 2); rstride = 64; }
}

__device__ __forceinline__ void gl1_item(PREF p, int l, int item, bool valid, LAS unsigned char* pl, int sw, int lane) {
    const bf16_t* __restrict__ P = (const bf16_t*)(p.ws + WS_GP); bf16_t* __restrict__ QK = (bf16_t*)(p.ws + WS_QK);
    float* __restrict__ GLS = (float*)(p.ws + WS_GLS); float* __restrict__ GLD = (float*)(p.ws + WS_GLD);
    LAS bf16_t* sVt = (LAS bf16_t*)pl;
    LAS bf16_t* sKt = (LAS bf16_t*)(pl + 18432 + sw * 9216);
    LAS float* sD = (LAS float*)(pl + 36864 + sw * 256);
    const int d = sw;
    const int h = item & 3, rest = item >> 2;
    const int cj = rest < 512 ? 4 + (rest & 255) : ((rest - 512) & 3), b = rest < 512 ? (rest >> 8) : ((rest - 512) >> 2);
    int row0, rstride; gla_rows(b, cj, row0, rstride);
    const int seq = (b * 4 + h) * 2 + d;
    if (valid) {
        const bf16_t* prl = P + (size_t)(row0 + lane * rstride) * PW + 2560 + d * 16;
        const u32x4 lra = *(const u32x4*)prl, lrb = *(const u32x4*)(prl + 8);
        unsigned lrp[8] = {lra.x, lra.y, lra.z, lra.w, lrb.x, lrb.y, lrb.z, lrb.w};
        float qc[16], kc[16];
#pragma unroll
        for (int ss = 0; ss < 16; ++ss) { const int i = d ? 63 - ss : ss; const bf16_t* pr = P + (size_t)(row0 + i * rstride) * PW + h * 64 + lane;
            qc[ss] = __builtin_bit_cast(float, (unsigned)pr[1024]); kc[ss] = __builtin_bit_cast(float, (unsigned)pr[1280]); }
        __builtin_amdgcn_sched_barrier(0);
#pragma unroll
        for (int ss = 0; ss < 16; ++ss) { qc[ss] = bf2f(__builtin_bit_cast(unsigned, qc[ss])); kc[ss] = bf2f(__builtin_bit_cast(unsigned, kc[ss])); }
        unsigned wupp[8];
#pragma unroll
        for (int r2 = 0; r2 < 8; ++r2) wupp[r2] = pk2(p.gla_wup[(size_t)((l * 2 + d) * 16 + 2 * r2) * 256 + h * 64 + lane], p.gla_wup[(size_t)((l * 2 + d) * 16 + 2 * r2 + 1) * 256 + h * 64 + lane]);
        const float bup = p.gla_bup[(l * 2 + d) * 256 + h * 64 + lane];
#pragma unroll 1
        for (int g2 = 0; g2 < 2; ++g2) {
            unsigned vr[16];
#pragma unroll
            for (int ii = 0; ii < 16; ++ii) { const int i = 32 * sw + g2 * 16 + ii; vr[ii] = *(const unsigned*)(P + (size_t)(row0 + i * rstride) * PW + 1536 + h * 128 + 2 * lane); }
#pragma unroll
            for (int ii = 0; ii < 16; ++ii) { const int i = 32 * sw + g2 * 16 + ii; sVt[(2 * lane) * 72 + i] = (bf16_t)(vr[ii] & 0xffffu); sVt[(2 * lane + 1) * 72 + i] = (bf16_t)(vr[ii] >> 16); }
        }
        float bc = 0.f;
#pragma unroll 1
        for (int g4 = 0; g4 < 4; ++g4) {
            float qn[16], kn[16];
            if (g4 < 3) {
#pragma unroll
                for (int ss = 0; ss < 16; ++ss) { const int s = (g4 + 1) * 16 + ss; const int i = d ? 63 - s : s; const bf16_t* pr = P + (size_t)(row0 + i * rstride) * PW + h * 64 + lane;
                    qn[ss] = __builtin_bit_cast(float, (unsigned)pr[1024]); kn[ss] = __builtin_bit_cast(float, (unsigned)pr[1280]); }
                __builtin_amdgcn_sched_barrier(0);
            }
            float gv[16];
#pragma unroll
            for (int ss = 0; ss < 16; ++ss) { const int s = g4 * 16 + ss; const int i = d ? 63 - s : s;
                float z = bup;
#pragma unroll
                for (int r2 = 0; r2 < 8; ++r2) { const unsigned w = (unsigned)__builtin_amdgcn_readlane((int)lrp[r2], i);
                    z = __builtin_amdgcn_fdot2_f32_bf16(__builtin_bit_cast(bf16x2_t, w), __builtin_bit_cast(bf16x2_t, wupp[r2]), z, false); }
                gv[ss] = -(fmaxf(-z, 0.f) + __logf(1.f + __expf(-fabsf(z)))) * (1.f / 16.f);
                __builtin_amdgcn_sched_barrier(0);
            }
#pragma unroll
            for (int ss = 0; ss < 16; ++ss) { const int s = g4 * 16 + ss; const int i = d ? 63 - s : s; const size_t rowi = (size_t)(row0 + i * rstride);
                bc += gv[ss];
                const float en = __expf(-bc), ep = __expf(bc);
                const float kt = kc[ss] * en, qt = qc[ss] * 0.125f * ep;
                const unsigned ktb = f2bf(kt);
                sKt[lane * 72 + i] = (bf16_t)ktb;
                QK[rowi * 1024 + d * 512 + h * 64 + lane] = (bf16_t)f2bf(qt);
                QK[rowi * 1024 + d * 512 + 256 + h * 64 + lane] = (bf16_t)ktb;
            }
#pragma unroll
            for (int ss = 0; ss < 16; ++ss) { qc[ss] = bf2f(__builtin_bit_cast(unsigned, qn[ss])); kc[ss] = bf2f(__builtin_bit_cast(unsigned, kn[ss])); }
        }
        const float Dv = __expf(bc);
        sD[lane] = Dv; GLD[(size_t)(seq * NCH + cj) * 64 + lane] = Dv;
    }
    __syncthreads();
    if (valid) {
        bf16x8 Ak[4][2]; f32x4 Dm[4];
#pragma unroll
        for (int mt = 0; mt < 4; ++mt) { Dm[mt] = *(const LAS f32x4*)(sD + mt * 16 + (lane >> 4) * 4);
#pragma unroll
            for (int ks = 0; ks < 2; ++ks) Ak[mt][ks] = *(const LAS bf16x8*)(sKt + (mt * 16 + (lane & 15)) * 72 + ks * 32 + (lane >> 4) * 8); }
        bf16_t* So = (bf16_t*)GLS + (size_t)(seq * NCH + cj) * 8192;
#pragma unroll 2
        for (int nt = 0; nt < 8; ++nt) {
            const bf16x8 B0 = *(const LAS bf16x8*)(sVt + (nt * 16 + (lane & 15)) * 72 + (lane >> 4) * 8), B1 = *(const LAS bf16x8*)(sVt + (nt * 16 + (lane & 15)) * 72 + 32 + (lane >> 4) * 8);
#pragma unroll
            for (int mt = 0; mt < 4; ++mt) { f32x4 acc = {0.f, 0.f, 0.f, 0.f}; acc = mfma16(Ak[mt][0], B0, acc); acc = mfma16(Ak[mt][1], B1, acc);
                acc = acc * Dm[mt];
                u32x2 w; w.x = pk2(acc[0], acc[1]); w.y = pk2(acc[2], acc[3]);
                *(u32x2*)(So + (nt * 16 + (lane & 15)) * 64 + mt * 16 + (lane >> 4) * 4) = w; }
        }
    }
    __syncthreads();
}

__device__ __forceinline__ void gl2_scan(PREF p, int gtid, int gthreads) {
    unsigned* __restrict__ GLS = (unsigned*)(p.ws + WS_GLS); const float* __restrict__ GLD = (const float*)(p.ws + WS_GLD);
    for (int g = gtid; g < 16 * 4096; g += gthreads) {
        const int seq = g >> 12, e2 = g & 4095, kk = (e2 * 2) & 63, d = seq & 1;
        float S0 = 0.f, S1 = 0.f;
        for (int s0 = 0; s0 < NCH; s0 += 20) {
            unsigned dv[20]; float D0[20], D1[20];
#pragma unroll
            for (int k = 0; k < 20; ++k) { const int cj = scan_order(d, s0 + k); dv[k] = GLS[(size_t)(seq * NCH + cj) * 4096 + e2];
                const float* dp = GLD + (size_t)(seq * NCH + cj) * 64 + kk; D0[k] = dp[0]; D1[k] = dp[1]; }
#pragma unroll
            for (int k = 0; k < 20; ++k) { const int cj = scan_order(d, s0 + k); GLS[(size_t)(seq * NCH + cj) * 4096 + e2] = pk2(S0, S1);
                S0 = D0[k] * S0 + bf2f(dv[k] & 0xffffu); S1 = D1[k] * S1 + __builtin_bit_cast(float, dv[k] & 0xffff0000u); }
        }
    }
}

__device__ __forceinline__ void gl3_item(PREF p, int l, int item, bool valid, LAS unsigned char* sl, int w4, int t256, int lane) {
    const bf16_t* __restrict__ P = (const bf16_t*)(p.ws + WS_GP); const bf16_t* __restrict__ QK = (const bf16_t*)(p.ws + WS_QK);
    const float* __restrict__ GLS = (const float*)(p.ws + WS_GLS); bf16_t* __restrict__ MIX = (bf16_t*)(p.ws + WS_MIX);
    LAS bf16_t* sVt = (LAS bf16_t*)sl;
    LAS bf16_t* sS = (LAS bf16_t*)(sl + 18432);
    LAS bf16_t* sAtt = (LAS bf16_t*)(sl + 55296);
    const int h = item & 3, rest = item >> 2;
    const int cj = rest < 512 ? 4 + (rest & 255) : ((rest - 512) & 3), b = rest < 512 ? (rest >> 8) : ((rest - 512) >> 2);
    int row0, rstride; gla_rows(b, cj, row0, rstride);
    f32x4 o[8];
#pragma unroll
    for (int nt = 0; nt < 8; ++nt) o[nt] = (f32x4){0.f, 0.f, 0.f, 0.f};
    bf16x8 Aq[2][2], Bk[4][2];
    const size_t rowi_a = (size_t)(row0 + (16 * w4 + (lane & 15)) * rstride);
    if (valid) {
        unsigned vr[16]; u32x4 sv[2][4];
#pragma unroll
        for (int ii = 0; ii < 16; ++ii) { const int i = 16 * w4 + ii; vr[ii] = *(const unsigned*)(P + (size_t)(row0 + i * rstride) * PW + 1536 + h * 128 + 2 * lane); }
#pragma unroll
        for (int d = 0; d < 2; ++d) { const bf16_t* Sg = (const bf16_t*)GLS + (size_t)(((b * 4 + h) * 2 + d) * NCH + cj) * 8192;
#pragma unroll
            for (int r = 0; r < 4; ++r) sv[d][r] = *(const u32x4*)(Sg + (r * 256 + t256) * 8); }
#pragma unroll
        for (int d = 0; d < 2; ++d)
#pragma unroll
            for (int ks = 0; ks < 2; ++ks) Aq[d][ks] = *(const bf16x8*)(QK + rowi_a * 1024 + d * 512 + h * 64 + ks * 32 + (lane >> 4) * 8);
#pragma unroll
        for (int nt = 0; nt < 4; ++nt) { const size_t rows = (size_t)(row0 + (nt * 16 + (lane & 15)) * rstride);
#pragma unroll
            for (int ks = 0; ks < 2; ++ks) Bk[nt][ks] = *(const bf16x8*)(QK + rows * 1024 + 256 + h * 64 + ks * 32 + (lane >> 4) * 8); }
#pragma unroll
        for (int ii = 0; ii < 16; ++ii) { const int i = 16 * w4 + ii; sVt[(2 * lane) * 72 + i] = (bf16_t)(vr[ii] & 0xffffu); sVt[(2 * lane + 1) * 72 + i] = (bf16_t)(vr[ii] >> 16); }
#pragma unroll
        for (int d = 0; d < 2; ++d)
#pragma unroll
            for (int r = 0; r < 4; ++r) { const int e = (r * 256 + t256) * 8; *(LAS u32x4*)(sS + d * 9216 + (e >> 6) * 72 + (e & 63)) = sv[d][r]; }
    }
    __syncthreads();
    if (valid) {
#pragma unroll
        for (int d = 0; d < 2; ++d) {
            f32x4 att[4];
#pragma unroll
            for (int nt = 0; nt < 4; ++nt) { att[nt] = (f32x4){0.f, 0.f, 0.f, 0.f};
#pragma unroll
                for (int ks = 0; ks < 2; ++ks) att[nt] = mfma16(Aq[d][ks], Bk[nt][ks], att[nt]); }
            if (d == 0) {
#pragma unroll
                for (int nt = 0; nt < 4; ++nt) { const size_t rows = (size_t)(row0 + (nt * 16 + (lane & 15)) * rstride);
#pragma unroll
                    for (int ks = 0; ks < 2; ++ks) Bk[nt][ks] = *(const bf16x8*)(QK + rows * 1024 + 512 + 256 + h * 64 + ks * 32 + (lane >> 4) * 8); }
            }
            WAVE_SYNC();
#pragma unroll
            for (int nt = 0; nt < 4; ++nt)
#pragma unroll
                for (int j = 0; j < 4; ++j) { const int i_ = 16 * w4 + (lane >> 4) * 4 + j, s_ = nt * 16 + (lane & 15); const bool keep = d == 0 ? (s_ <= i_) : (s_ >= i_);
                    sAtt[i_ * 72 + s_] = keep ? (bf16_t)f2bf(att[nt][j]) : (bf16_t)0; }
            WAVE_SYNC();
            bf16x8 Aa[2];
#pragma unroll
            for (int ks = 0; ks < 2; ++ks) Aa[ks] = *(const LAS bf16x8*)(sAtt + (16 * w4 + (lane & 15)) * 72 + ks * 32 + (lane >> 4) * 8);
#pragma unroll
            for (int nt = 0; nt < 8; ++nt)
#pragma unroll
                for (int ks = 0; ks < 2; ++ks) { const int bo = (nt * 16 + (lane & 15)) * 72 + ks * 32 + (lane >> 4) * 8;
                    o[nt] = mfma16(Aa[ks], *(const LAS bf16x8*)(sVt + bo), o[nt]); o[nt] = mfma16(Aq[d][ks], *(const LAS bf16x8*)(sS + d * 9216 + bo), o[nt]); }
        }
        const float* gn = p.gla_norm_g + l * 512 + h * 128;
        unsigned ogr[4][8];
#pragma unroll
        for (int j = 0; j < 4; ++j) { const size_t rowi = (size_t)(row0 + (16 * w4 + (lane >> 4) * 4 + j) * rstride);
#pragma unroll
            for (int nt = 0; nt < 8; ++nt) ogr[j][nt] = P[rowi * PW + 2048 + h * 128 + nt * 16 + (lane & 15)]; }
        __builtin_amdgcn_sched_barrier(0);
#pragma unroll
        for (int j = 0; j < 4; ++j) {
            float ss = 0.f;
#pragma unroll
            for (int nt = 0; nt < 8; ++nt) ss += o[nt][j] * o[nt][j];
            ss += shx(ss, 1, lane); ss += shx(ss, 2, lane); ss += shx(ss, 4, lane); ss += shx(ss, 8, lane);
            const float rs = __builtin_amdgcn_rsqf(ss * (1.f / 128.f) + 1e-6f);
            const size_t rowi = (size_t)(row0 + (16 * w4 + (lane >> 4) * 4 + j) * rstride);
            float ogv[8];
#pragma unroll
            for (int nt = 0; nt < 8; ++nt) ogv[nt] = bf2f(ogr[j][nt]);
#pragma unroll
            for (int nt = 0; nt < 8; ++nt) { const int vv = nt * 16 + (lane & 15);
                MIX[rowi * DM + 512 + h * 128 + vv] = (bf16_t)f2bf(o[nt][j] * rs * gn[vv] * silu_f(ogv[nt])); }
        }
    }
    __syncthreads();
}

#define XB_TMO      128
#define XB_XCNT(j)  (256  + 64 * (j))
#define XB_XSUB(j)  (1280 + 64 * (j))
#define XB_XGEN(j)  (2304 + 64 * (j))
#define XB_TOP      3328
#define XB_TOPGEN   3392
#define XCD_BAR_WORDS 3456
#define XB_SPIN_CAP (1u << 18)

__device__ __forceinline__ unsigned xb_ld(unsigned* p)              { return __hip_atomic_load(p, __ATOMIC_RELAXED, __HIP_MEMORY_SCOPE_AGENT); }
__device__ __forceinline__ unsigned xb_add(unsigned* p, unsigned v) { return __hip_atomic_fetch_add(p, v, __ATOMIC_RELAXED, __HIP_MEMORY_SCOPE_AGENT); }
__device__ __forceinline__ unsigned xb_xcc_id() { return (unsigned)__builtin_amdgcn_s_getreg((3 << 11) | 20) & 0xFu; }
#define XB_SPIN(cond, bar) do { unsigned _sp = 0; while (cond) { __builtin_amdgcn_s_sleep(1); \
    if ((++_sp & 255u) == 0u) { if (xb_ld(&(bar)[XB_TMO])) break; if (_sp > XB_SPIN_CAP) { atomicAdd(&(bar)[XB_TMO], 1u); break; } } } } while (0)

struct XcdBarrier {
    unsigned* bar; unsigned x;
    volatile LAS unsigned* st;
};

__device__ __forceinline__ XcdBarrier xcd_barrier_post(unsigned* bar, volatile LAS unsigned* st) {
    XcdBarrier b; b.bar = bar; b.x = xb_xcc_id(); b.st = st;
    if (threadIdx.x == 0) (void)xb_add(&bar[XB_XCNT(b.x)], 1u);
    return b;
}
__device__ __forceinline__ void xcd_barrier_complete(unsigned* bar, unsigned x, unsigned& nloc, unsigned& nx) {
    const unsigned G = gridDim.x * gridDim.y * gridDim.z;
    unsigned sum, cnt, mine, sp = 0u;
    for (;;) {
        sum = 0u; cnt = 0u; mine = 0u;
#pragma unroll
        for (unsigned j = 0; j < 16; ++j) { const unsigned c = xb_ld(&bar[XB_XCNT(j)]); sum += c; cnt += (c > 0u) ? 1u : 0u; mine = (j == x) ? c : mine; }
        if (sum == G) break;
        __builtin_amdgcn_s_sleep(1);
        if ((++sp & 255u) == 0u) { if (xb_ld(&bar[XB_TMO])) break; if (sp > XB_SPIN_CAP) { atomicAdd(&bar[XB_TMO], 1u); break; } }
    }
    nloc = mine > 0u ? mine : 1u; nx = cnt > 0u ? cnt : 1u;
}

__device__ __forceinline__ void xcd_barrier(const XcdBarrier& b, int xb_tid) {
    asm volatile("s_waitcnt vmcnt(0)" ::: "memory");
    __syncthreads();
    if (xb_tid == 0) {
        unsigned* bar = b.bar;
        __builtin_amdgcn_s_waitcnt(0);
        unsigned nloc = b.st[0], nx = b.st[1];
        if (nloc == 0u) { xcd_barrier_complete(bar, b.x, nloc, nx); b.st[0] = nloc; b.st[1] = nx; }
        const unsigned old = xb_add(&bar[XB_XSUB(b.x)], 1u);
        const unsigned gen = old / nloc;
        if (old + 1u == (gen + 1u) * nloc) {
            __builtin_amdgcn_fence(__ATOMIC_RELEASE, "agent");
            asm volatile("s_waitcnt vmcnt(0)" ::: "memory");
            const unsigned og = xb_add(&bar[XB_TOP], 1u);
            const unsigned tg = og / nx;
            if (og + 1u == (tg + 1u) * nx) xb_add(&bar[XB_TOPGEN], 1u);
            else XB_SPIN(xb_ld(&bar[XB_TOPGEN]) == tg, bar);
            __builtin_amdgcn_fence(__ATOMIC_ACQUIRE, "agent");
            xb_add(&bar[XB_XGEN(b.x)], 1u);
            asm volatile("s_waitcnt vmcnt(0)" ::: "memory");
        } else {
            XB_SPIN(xb_ld(&bar[XB_XGEN(b.x)]) == gen, bar);
            __builtin_amdgcn_fence(__ATOMIC_ACQUIRE, "agent");
            asm volatile("s_waitcnt vmcnt(0)" ::: "memory");
        }
    }
    __syncthreads();
}

__device__ __forceinline__ int lane_id_volatile() { int l; asm volatile("v_mbcnt_lo_u32_b32 %0, -1, 0\n\tv_mbcnt_hi_u32_b32 %0, -1, %0" : "=v"(l)); return l; }
__global__ void __launch_bounds__(NTHREADS, 2) mega_fwd(Params p_arg) {
    extern __shared__ __attribute__((aligned(16))) unsigned char lds_raw[];
    LAS unsigned char* lds = (LAS unsigned char*)lds_raw;
    cg::grid_group grid = cg::this_grid();
    const int G = gridDim.x, NGW = G * 8, gthreads = G * NTHREADS;
    const int wave_s = __builtin_amdgcn_readfirstlane((int)threadIdx.x >> 6);
#define MYTID() (wave_s * 64 + lane_id_volatile())
    volatile LAS unsigned* bst = (volatile LAS unsigned*)(lds + LDS_BYTES - 64);
    if (threadIdx.x < 2) bst[threadIdx.x] = 0u;
    if (blockIdx.x == 0) { unsigned* bw = (unsigned*)(p_arg.ws + WS_BAR); for (int i = threadIdx.x; i < 4096; i += NTHREADS) bw[i] = 0u; }
#define KARGS() const __attribute__((address_space(4))) Params* pk_ = (const __attribute__((address_space(4))) Params*)__builtin_amdgcn_kernarg_segment_ptr(); asm volatile("" : "+s"(pk_)); PREF p = *pk_;

    {
    KARGS();
    const int tid = threadIdx.x, lane = tid & 63, wave = __builtin_amdgcn_readfirstlane(tid >> 6);
    const int gw = blockIdx.x * 8 + wave, gtid = blockIdx.x * NTHREADS + tid;
    phase_mods(p, lds, tid, wave, lane);
    phase_gatew(p, gtid, gthreads);
    { float* hc_ = (float*)(p.ws + WS_HCTX); for (int i = gtid; i < TC * DM / 4; i += gthreads) ((f32x4*)hc_)[i] = ((const f32x4*)p.ctx)[i]; }
    __syncthreads();
    convert_weights(p, 0, lds, gw, NGW, wave, lane);
    }
    grid.sync();
    (void)xcd_barrier_post((unsigned*)(p_arg.ws + WS_BAR), bst);

    for (int st = 0; st < NLAYER * 12; ++st) {
#ifndef DUP_MASK
#define DUP_MASK 0
#endif
        const int s_ = st % 12;
        const int sbit = (s_ == 0 || s_ == 3 || s_ == 9) ? 1 : (s_ == 1 || s_ == 10) ? 2 : (s_ == 4) ? 4 : (s_ == 5) ? 8 : (s_ == 7) ? 16 : 0;
        const int nrep = (DUP_MASK & sbit) ? 2 : 1;
        for (int rep = 0; rep < nrep; ++rep) {
        KARGS();
        unsigned char* ws = p.ws;
        bf16_t* U = (bf16_t*)(ws + WS_U); bf16_t* MIX = (bf16_t*)(ws + WS_MIX); bf16_t* GP = (bf16_t*)(ws + WS_GP);
        float* hctx = (float*)(ws + WS_HCTX); const float* mod = (const float*)(ws + WS_MOD);
#define PHASE_IDS() const int tid = MYTID(); const int lane = tid & 63, wave = __builtin_amdgcn_readfirstlane(tid >> 6); const int gw = blockIdx.x * 8 + wave, gtid = blockIdx.x * NTHREADS + tid; (void)gw; (void)gtid; (void)lane;
        const int l = st / 12, s = st % 12;
        const bool lastl = (l == NLAYER - 1);
        const int rows = (lastl && s >= 8) ? TL : TT;
        switch (s) {
        case 0: case 3: case 9: {
            PHASE_IDS();
            const int jn = s == 0 ? 0 : (s == 3 ? 1 : 2);
            if (s == 0) { phase_bias(p, l, lds, tid, wave, lane); if (l > 0) convert_weights(p, l, lds, gw, NGW, wave, lane); }
            if (st != 0) phase_rs(p, gtid, gthreads);
            phase_norm(p, l, jn, st == 0 ? 0 : TL, rows, st == 0, s == 0 ? (l > 0 ? DFF / 256 : 0) : (s == 3 ? DFF / 256 : DM / 256), gw, NGW, lane);
        } break;
        case 1: case 10: {
            PHASE_IDS();
            const int f = s == 1 ? 0 : 1;
            pg8::Gemm g{U, (const bf16_t*)(ws + WS_W13) + (size_t)f * 5632 * DM, rows, 5632, DM, DM};
            pg8::StaticOrder S; S.init(rows, 5632, G, (int)blockIdx.x);
            EpiSwiglu E{GP, (const float*)(ws + WS_RS), (const float*)(ws + WS_BIAS) + (size_t)(f ? 2 : 0) * 3 * 5632};
            pg8::gemm_phase<EpiSwiglu, pg8::StaticOrder, true, true>(lds, g, S, E, tid);
        } break;
        case 2: case 8: case 11: {
            PHASE_IDS();
            const bool isout = (s == 8);
            const int f = s == 2 ? 0 : 1;
            const int Kd = isout ? DM : DFF;
            const bf16_t* Ad = isout ? MIX : GP; const bf16_t* Bd = isout ? (const bf16_t*)(ws + WS_WOUT) : (const bf16_t*)(ws + WS_W2) + (size_t)f * DM * DFF;
            const int gidx = s == 2 ? 2 : (s == 8 ? 5 : 8);
            const bool first = (st == 2);
            const float* gate = mod + (size_t)l * 3 * (NMOD * DM) + gidx * DM; const float coef = isout ? 1.f : 0.5f;
            pg8::Gemm g{Ad, Bd, rows, DM, Kd, Kd};
            DownOrder S; S.so.init(TL, DM, G, (int)blockIdx.x); S.sk.init(TL / 256, TC / 256, DM / 256, Kd / 256, 256, G, (int)blockIdx.x); S.nlat = (TL / 256) * (DM / 256); S.nctx = rows == TT ? S.sk.nun : 0; S.inv = isout ? 16384 : 5958;
            const int ln = s == 11 ? l + 1 : l, jnn = s == 2 ? 1 : (s == 8 ? 2 : 0);
            const bool emit = ln < NLAYER;
            EpiResid E{first ? p.x : p.out, p.out, ws, gate, p.norm_g + (size_t)((emit ? ln : 0) * 3 + jnn) * DM, mod + (size_t)(emit ? ln : 0) * 3 * (NMOD * DM) + (3 * jnn + 1) * DM, coef, emit ? 1 : 0};
            pg8::gemm_phase<EpiResid, DownOrder, true, true>(lds, g, S, E, tid);
        } break;
        case 4: {
            PHASE_IDS();
            pg8::Gemm g{U, (const bf16_t*)(ws + WS_WIN), rows, PW, DM, DM};
            InpOrder S; S.G = G; S.c = (int)blockIdx.x;
            unsigned* cnt = (unsigned*)(ws + WS_BAR) + 3584 + 64 * l;
            EpiStore E{GP, PW, (const float*)(ws + WS_RS), (const float*)(ws + WS_BIAS) + (size_t)1 * 3 * 5632, G == 256 ? cnt : (unsigned*)nullptr};
            pg8::gemm_phase<EpiStore, InpOrder, true, true>(lds, g, S, E, tid);
            if (G == 256 && blockIdx.x >= 150 && blockIdx.x < 166) {
                unsigned spins = 0;
                while (__hip_atomic_load(cnt, __ATOMIC_RELAXED, __HIP_MEMORY_SCOPE_AGENT) < 22u * 8u) { __builtin_amdgcn_s_sleep(8); if (++spins > (1u << 22)) break; }
                __builtin_amdgcn_fence(__ATOMIC_ACQUIRE, "agent");
                asm volatile("s_waitcnt vmcnt(0)" ::: "memory");
                __syncthreads();
                if (blockIdx.x < 158) rg_item<false>(p, l, 2 * 256 * 8 + ((int)blockIdx.x - 150) * 8 + wave, lds + wave * 18432, lane);
                else gl1_item(p, l, 2 * 256 * 4 + ((int)blockIdx.x - 158) * 4 + (wave >> 1), true, lds + (wave >> 1) * 37376, wave & 1, lane);
            }
        } break;
        case 5: {
            PHASE_IDS();
            const int nrg1 = G == 256 ? 2 * 256 * 8 : 2 * NCH * 8, ngl1 = G == 256 ? 2 * 256 * 4 : 2 * NCH * 4;
            for (int item = gw; item < nrg1; item += NGW) rg_item<false>(p, l, item, lds + wave * 18432, lane);
            __syncthreads();
            const int NP = G * 4, pgid = NP - 1 - (blockIdx.x * 4 + (wave >> 1));
            for (int it = 0; it * NP < ngl1; ++it) { const int item = it * NP + pgid; gl1_item(p, l, item, item < ngl1, lds + (wave >> 1) * 37376, wave & 1, lane); }
        } break;
        case 6: {
            PHASE_IDS();
            rg_carry(p, wave, lane);
            gl2_scan(p, gtid, gthreads);
        } break;
        case 7: {
            PHASE_IDS();
            const int nrg = lastl ? 2 * 256 * 8 : 2 * NCH * 8, ngl = lastl ? 2 * 256 * 4 : 2 * NCH * 4;
            for (int item = gw; item < nrg; item += NGW) rg_item<true>(p, l, item, lds + wave * 18432, lane);
            __syncthreads();
            const int NS = G * 2, sgid = NS - 1 - (blockIdx.x * 2 + (wave >> 2));
            for (int r2 = 0; r2 < ((DUP_MASK & (64 | 256)) ? 2 : 1); ++r2)
            for (int it = 0; it * NS < ngl; ++it) { const int item = it * NS + sgid; gl3_item(p, l, item, item < ngl, lds + (wave >> 2) * 64512, wave & 3, tid & 255, lane); }
        } break;
        }
        { XcdBarrier xb_; xb_.bar = (unsigned*)(p.ws + WS_BAR); xb_.x = xb_xcc_id(); xb_.st = (volatile LAS unsigned*)(lds + LDS_BYTES - 64); xcd_barrier(xb_, MYTID()); }
        }
    }
    { KARGS(); const int tid = MYTID(), lane = tid & 63, wave = __builtin_amdgcn_readfirstlane(tid >> 6); phase_final(p, blockIdx.x * 8 + wave, NGW, lane); }
}

extern "C" void kernel_launch(void* const* d_in, const int* in_sizes, int n_in, void* d_out, int out_size, void* d_ws, size_t ws_size, hipStream_t stream) {
    static int grid_blocks = 0;
    if (grid_blocks == 0) {
        if (n_in != 23 || ws_size < WS_END) { fprintf(stderr, "kernel_launch: unexpected n_in %d or ws_size %zu (< %zu)\n", n_in, ws_size, (size_t)WS_END); grid_blocks = -1; return; }
        int dev = 0, cus = 0, per_cu = 0;
        hipGetDevice(&dev);
        hipDeviceGetAttribute(&cus, hipDeviceAttributeMultiprocessorCount, dev);
        if (hipFuncSetAttribute((const void*)mega_fwd, hipFuncAttributeMaxDynamicSharedMemorySize, LDS_BYTES) != hipSuccess) { fprintf(stderr, "kernel_launch: hipFuncSetAttribute failed\n"); grid_blocks = -1; return; }
        if (hipOccupancyMaxActiveBlocksPerMultiprocessor(&per_cu, (const void*)mega_fwd, NTHREADS, LDS_BYTES) != hipSuccess || per_cu < 1) { fprintf(stderr, "kernel_launch: occupancy query says %d\n", per_cu); per_cu = 1; }
        (void)hipGetLastError();
        grid_blocks = cus;
    }
    if (grid_blocks < 0) return;
    Params p{};
    const float** pp = (const float**)&p;
    for (int i = 0; i < 23; ++i) pp[i] = (const float*)d_in[i];
    p.out = (float*)d_out; p.ws = (unsigned char*)d_ws;
    void* args[] = {&p};
    hipError_t e = hipLaunchCooperativeKernel((const void*)mega_fwd, dim3(grid_blocks), dim3(NTHREADS), args, LDS_BYTES, stream);
    if (e != hipSuccess) fprintf(stderr, "cooperative launch failed: %s (grid %d)\n", hipGetErrorString(e), grid_blocks);
}
```

```cpp
#include <hip/hip_runtime.h>
#include <hip/hip_cooperative_groups.h>
#include <cstdio>
#include <cstdint>
namespace cg = cooperative_groups;
namespace pg8 {
#define PG8_LAS __attribute__((address_space(3)))
typedef unsigned short bf16_t;
typedef short bf16x8 __attribute__((ext_vector_type(8)));
typedef float f32x4 __attribute__((ext_vector_type(4)));
typedef unsigned u32x4 __attribute__((ext_vector_type(4)));
constexpr int BM = 256, BK = 64, HALF = 128, HTB = HALF * BK * 2  , STAGE_BYTES = 8 * HTB, NXCD = 8, WGM = 8;

__host__ __device__ __forceinline__ int lds_byte(int r, int c) { const int st = (r >> 4) * 2 + (c >> 5), rr = r & 15, cc = c & 31, ob = rr * 64 + cc * 2; return st * 1024 + (ob ^ (((ob >> 9) & 1) << 5)); }
__host__ __device__ __forceinline__ void stage_rc(int b, int& R, int& C) { const int st = b / 1024, sb = b % 1024, swz = sb ^ (((sb >> 9) & 1) << 5); R = (st >> 1) * 16 + swz / 64; C = (st & 1) * 32 + (swz % 64) / 2; }
__host__ __device__ __forceinline__ int perm32(int rho) { const int n = rho >> 4, i = rho & 15; return 8 * (i >> 2) + 4 * n + (i & 3); }

struct Unit { int pm, pn, kb, nk; };
struct Gemm { const bf16_t* A; const bf16_t* Bt; int M, N, K, ldk; };

struct StaticOrder {
    int nM, nN, nwg, G, c;
    __host__ __device__ void init(int M, int N, int G_, int c_) { nM = M / BM; nN = N / BM; nwg = nM * nN; G = G_; c = c_; }
    __host__ __device__ bool next(int i, Unit& u) const {
        const long L = (long)i * G + c; if (L >= nwg) return false;
        int wgid = (int)L; { const int q = nwg / NXCD, r = nwg % NXCD, xcd = wgid % NXCD, off = wgid / NXCD; wgid = (xcd < r ? xcd * (q + 1) : r * (q + 1) + (xcd - r) * q) + off; }
        const int nig = WGM * nN, gid = wgid / nig, fm = gid * WGM, gsz = (nM - fm) < WGM ? (nM - fm) : WGM;
        u.pm = fm + ((wgid % nig) % gsz); u.pn = (wgid % nig) / gsz; u.kb = 0; u.nk = 0; return true;
    }
    __device__ __forceinline__ void a_ready(const Unit&) const {}
    __device__ __forceinline__ void done(const Unit&) const {}
};
struct SplitKOrder {
    int pm0, nN, nsplit, kc, nun, G, c;
    __host__ __device__ void init(int pm0_, int nM_, int nN_, int nsplit_, int kc_, int G_, int c_) { pm0 = pm0_; nN = nN_; nsplit = nsplit_; kc = kc_; nun = nM_ * nN_ * nsplit_; G = G_; c = c_; }
    __host__ __device__ bool next(int i, Unit& u) const {
        const int L = i * G + c; if (L >= nun) return false;
        const int tile = L / nsplit, ks = L - tile * nsplit;
        u.pm = pm0 + tile / nN; u.pn = tile % nN; u.kb = ks * kc; u.nk = kc / BK; return true;
    }
    __device__ __forceinline__ void a_ready(const Unit&) const {}
    __device__ __forceinline__ void done(const Unit&) const {}
};
__device__ __forceinline__ unsigned cvt_pk_bf16(float lo, float hi) { unsigned r; asm volatile("v_cvt_pk_bf16_f32 %0, %1, %2" : "=v"(r) : "v"(lo), "v"(hi)); return r; }
template <class Epi, class Sched, bool ALIGN_EPI = false, bool SP2 = false>
__device__ __forceinline__ void gemm_phase(PG8_LAS unsigned char* lds, const Gemm g, const Sched& S, const Epi& E, int tid_in) {
    int tid = tid_in; asm volatile("" : "+v"(tid));
    const int wid = __builtin_amdgcn_readfirstlane(tid >> 6), lane = tid & 63, wr = wid >> 2, wc = wid & 3, fr = lane & 15, fq = lane >> 4;
    const int K = g.ldk, nt_all = g.K / BK;
    unsigned voffA[2], voffB[2];
#pragma unroll
    for (int i = 0; i < 2; ++i) { int R, C; stage_rc(tid * 16 + i * 8192, R, C); const int Rb = Epi::PERM ? ((R & ~31) + perm32(R & 31)) : R;
        voffA[i] = (unsigned)(R * K + C) * 2u; voffB[i] = (unsigned)(Rb * K + C) * 2u; }
    const size_t kstep = (size_t)(BK * 2);
    const size_t hstep = (size_t)HALF * K * 2;
    const size_t tstep = 2 * hstep;
    const unsigned ldsw = (unsigned)wid * 1024u;
    const int aoff = lds_byte(wr * 64 + fr, fq * 8), boff = lds_byte(wc * 32 + fr, fq * 8);
#define PG8_SA(b, h) (((b) * 2 + (h)) * HTB)
#define PG8_SB(b, h) ((4 + (b) * 2 + (h)) * HTB)
#define PG8_STAGE(bufoff, gbase, voff) do { _Pragma("unroll") for (int _i = 0; _i < 2; ++_i) \
        __builtin_amdgcn_global_load_lds((const unsigned*)((const char*)(gbase) + (voff)[_i]), (PG8_LAS unsigned*)(lds + (bufoff) + ldsw + _i * 8192), 16, 0, 0); } while (0)
#define PG8_LDA(dst, b, h) do { _Pragma("unroll") for (int m = 0; m < 4; ++m) _Pragma("unroll") for (int k = 0; k < 2; ++k) dst[m][k] = *(const PG8_LAS bf16x8*)(lds + PG8_SA(b, h) + aoff + m * 2048 + k * 1024); } while (0)
#define PG8_LDB(dst, b, h) do { _Pragma("unroll") for (int n = 0; n < 2; ++n) _Pragma("unroll") for (int k = 0; k < 2; ++k) dst[n][k] = *(const PG8_LAS bf16x8*)(lds + PG8_SB(b, h) + boff + n * 2048 + k * 1024); } while (0)
#define PG8_MMA(ai, bj, At, Bt) do { __builtin_amdgcn_s_setprio(1); _Pragma("unroll") for (int m = 0; m < 4; ++m) _Pragma("unroll") for (int n = 0; n < 2; ++n) _Pragma("unroll") for (int k = 0; k < 2; ++k) \
        acc[ai][bj][m][n] = __builtin_amdgcn_mfma_f32_16x16x32_bf16(Bt[n][k], At[m][k], acc[ai][bj][m][n], 0, 0, 0); __builtin_amdgcn_s_setprio(0); } while (0)
#define PG8_WAIT_V(n) asm volatile("s_waitcnt vmcnt(" #n ")" ::: "memory")
#define PG8_WAIT_L(n) asm volatile("s_waitcnt lgkmcnt(" #n ")" ::: "memory")
#define PG8_BAR __builtin_amdgcn_s_barrier()
#define PG8_SCHED __builtin_amdgcn_sched_barrier(0)
    Unit cur, nxt; int ui = 0;
    if (!S.next(0, cur)) return;
    f32x4 acc[2][2][4][2];
#pragma unroll
    for (int a = 0; a < 2; ++a)
#pragma unroll
        for (int b = 0; b < 2; ++b)
#pragma unroll
            for (int m = 0; m < 4; ++m)
#pragma unroll
                for (int n = 0; n < 2; ++n) acc[a][b][m][n] = (f32x4){0.f, 0.f, 0.f, 0.f};
    bf16x8 At[4][2], B0[2][2], B1[2][2];
    const char* cA = (const char*)g.A + (size_t)cur.pm * tstep + (size_t)cur.kb * 2; const char* cB = (const char*)g.Bt + (size_t)cur.pn * tstep + (size_t)cur.kb * 2;
    S.a_ready(cur);
    if constexpr (SP2) {
        PG8_STAGE(PG8_SB(0, 0), cB, voffB); PG8_STAGE(PG8_SB(0, 1), cB + hstep, voffB); PG8_STAGE(PG8_SA(0, 0), cA, voffA); PG8_STAGE(PG8_SA(0, 1), cA + hstep, voffA);
        if (wr == 1) PG8_BAR;
        PG8_WAIT_V(2); PG8_BAR;
        PG8_STAGE(PG8_SB(1, 0), cB + kstep, voffB); PG8_STAGE(PG8_SA(1, 0), cA + kstep, voffA); PG8_STAGE(PG8_SB(1, 1), cB + hstep + kstep, voffB);
        PG8_WAIT_V(6); PG8_BAR;
    } else {
        PG8_STAGE(PG8_SB(0, 0), cB, voffB); PG8_STAGE(PG8_SA(0, 0), cA, voffA); PG8_STAGE(PG8_SB(0, 1), cB + hstep, voffB); PG8_STAGE(PG8_SA(0, 1), cA + hstep, voffA);
        if (wr == 1) PG8_BAR;
        PG8_WAIT_V(4); PG8_BAR;
        PG8_STAGE(PG8_SB(1, 0), cB + kstep, voffB); PG8_STAGE(PG8_SA(1, 0), cA + kstep, voffA); PG8_STAGE(PG8_SB(1, 1), cB + hstep + kstep, voffB);
        PG8_WAIT_V(6); PG8_BAR;
    }
    for (;;) {
        const bool has_next = S.next(ui + 1, nxt);
        const char* nA = has_next ? (const char*)g.A + (size_t)nxt.pm * tstep + (size_t)nxt.kb * 2 : cA; const char* nB = has_next ? (const char*)g.Bt + (size_t)nxt.pn * tstep + (size_t)nxt.kb * 2 : cB;
        const int nt = cur.nk ? cur.nk : nt_all;
        for (int t = 0; t < nt; t += 2) {
            const bool last = (t == nt - 2);
            const char* a1 = cA + (size_t)(t + 1) * kstep;
            const char* a2 = last ? nA : cA + (size_t)(t + 2) * kstep; const char* b2 = last ? nB : cB + (size_t)(t + 2) * kstep;
            const char* a3 = a2 + kstep; const char* b3 = b2 + kstep;
            if (last && has_next) S.a_ready(nxt);
            if constexpr (SP2) {
            PG8_LDB(B0, 0, 0); PG8_LDB(B1, 0, 1); PG8_SCHED; PG8_LDA(At, 0, 0); PG8_STAGE(PG8_SA(1, 1), a1 + hstep, voffA);
            PG8_WAIT_V(8); PG8_WAIT_L(0); PG8_BAR; PG8_MMA(0, 0, At, B0); PG8_MMA(0, 1, At, B1); PG8_BAR; PG8_SCHED;
            PG8_LDA(At, 0, 1); PG8_STAGE(PG8_SB(0, 0), b2, voffB); PG8_STAGE(PG8_SB(0, 1), b2 + hstep, voffB); PG8_STAGE(PG8_SA(0, 0), a2, voffA);
            PG8_WAIT_V(8); PG8_WAIT_L(0); PG8_BAR; PG8_MMA(1, 0, At, B0); PG8_MMA(1, 1, At, B1); PG8_BAR; PG8_SCHED;
            PG8_LDB(B0, 1, 0); PG8_LDB(B1, 1, 1); PG8_SCHED; PG8_LDA(At, 1, 0); PG8_STAGE(PG8_SA(0, 1), a2 + hstep, voffA);
            PG8_WAIT_V(8); PG8_WAIT_L(0); PG8_BAR; PG8_MMA(0, 0, At, B0); PG8_MMA(0, 1, At, B1); PG8_BAR; PG8_SCHED;
            PG8_LDA(At, 1, 1); PG8_STAGE(PG8_SB(1, 0), b3, voffB); PG8_STAGE(PG8_SB(1, 1), b3 + hstep, voffB); PG8_STAGE(PG8_SA(1, 0), a3, voffA);
            PG8_WAIT_V(8); PG8_WAIT_L(0); PG8_BAR; PG8_MMA(1, 0, At, B0); PG8_MMA(1, 1, At, B1); PG8_BAR; PG8_SCHED;
            } else {
            PG8_LDB(B0, 0, 0); PG8_SCHED; PG8_LDA(At, 0, 0); PG8_STAGE(PG8_SA(1, 1), a1 + hstep, voffA);
            PG8_WAIT_L(8); PG8_BAR; PG8_WAIT_L(0); PG8_MMA(0, 0, At, B0); PG8_BAR; PG8_SCHED;
            PG8_LDB(B1, 0, 1); PG8_STAGE(PG8_SB(0, 0), b2, voffB);
            PG8_BAR; PG8_WAIT_L(0); PG8_MMA(0, 1, At, B1); PG8_BAR;
            PG8_LDA(At, 0, 1); PG8_STAGE(PG8_SA(0, 0), a2, voffA);
            PG8_BAR; PG8_WAIT_L(0); PG8_MMA(1, 0, At, B0); PG8_BAR; PG8_SCHED;
            PG8_STAGE(PG8_SB(0, 1), b2 + hstep, voffB);
            PG8_WAIT_V(6); PG8_BAR; PG8_MMA(1, 1, At, B1); PG8_BAR;
            PG8_LDB(B0, 1, 0); PG8_SCHED; PG8_LDA(At, 1, 0); PG8_STAGE(PG8_SA(0, 1), a2 + hstep, voffA);
            PG8_WAIT_L(8); PG8_BAR; PG8_WAIT_L(0); PG8_MMA(0, 0, At, B0); PG8_BAR; PG8_SCHED;
            PG8_LDB(B1, 1, 1); PG8_STAGE(PG8_SB(1, 0), b3, voffB);
            PG8_BAR; PG8_WAIT_L(0); PG8_MMA(0, 1, At, B1); PG8_BAR;
            PG8_LDA(At, 1, 1); PG8_STAGE(PG8_SA(1, 0), a3, voffA);
            PG8_BAR; PG8_WAIT_L(0); PG8_MMA(1, 0, At, B0); PG8_BAR; PG8_SCHED;
            PG8_STAGE(PG8_SB(1, 1), b3 + hstep, voffB);
            PG8_WAIT_V(6); PG8_BAR; PG8_MMA(1, 1, At, B1); PG8_BAR;
            }
        }
        if constexpr (ALIGN_EPI) { if (wr == 0) PG8_BAR; }
        if constexpr (!Epi::AFTER_DRAIN) { E(acc, cur, wr, wc, fr, fq); S.done(cur); }
        if (!has_next) break;
#pragma unroll
        for (int a = 0; a < 2; ++a)
#pragma unroll
            for (int b = 0; b < 2; ++b)
#pragma unroll
                for (int m = 0; m < 4; ++m)
#pragma unroll
                    for (int n = 0; n < 2; ++n) acc[a][b][m][n] = (f32x4){0.f, 0.f, 0.f, 0.f};
        cur = nxt; cA = nA; cB = nB; ++ui;
        if constexpr (ALIGN_EPI) { if (wr == 1) PG8_BAR; }
    }
    PG8_WAIT_V(0);
    if constexpr (!ALIGN_EPI) { if (wr == 0) PG8_BAR; }
    PG8_BAR;
    if constexpr (Epi::AFTER_DRAIN) { E.fused(acc, cur, wr, wc, fr, fq, lds, wid, lane); S.done(cur); }
#undef PG8_SA
#undef PG8_SB
#undef PG8_STAGE
#undef PG8_LDA
#undef PG8_LDB
#undef PG8_MMA
#undef PG8_WAIT_V
#undef PG8_WAIT_L
#undef PG8_BAR
#undef PG8_SCHED
}
}

#define LAS __attribute__((address_space(3)))
typedef unsigned short bf16_t;
typedef short bf16x8 __attribute__((ext_vector_type(8)));
typedef float f32x4 __attribute__((ext_vector_type(4)));
typedef unsigned u32x4 __attribute__((ext_vector_type(4)));
typedef unsigned u32x2 __attribute__((ext_vector_type(2)));
typedef __bf16 bf16x2_t __attribute__((ext_vector_type(2)));

constexpr int DM = 1024, DFF = 2816, NLAYER = 4, NMOD = 9;
constexpr int TL = 32768, TC = 512, TT = TL + TC;
constexpr int PW = 2816;
constexpr int NCH = 260;
constexpr int LDS_BYTES = 155648;
constexpr int NTHREADS = 512;

constexpr size_t MiB = 1u << 20;
constexpr size_t WS_MOD = 0, WS_HCTX = 1 * MiB, WS_WG = 3 * MiB, WS_RGA = 4 * MiB, WS_RGH = 7 * MiB, WS_RGC = 10 * MiB, WS_GLD = 13 * MiB,
                 WS_BAR = 15 * MiB, WS_W13 = 16 * MiB, WS_W2 = 38 * MiB, WS_WIN = 49 * MiB, WS_WOUT = 55 * MiB, WS_U = 58 * MiB, WS_MIX = 123 * MiB,
                 WS_GP = 188 * MiB, WS_QK = 367 * MiB, WS_GLS = 432 * MiB, WS_HB = 497 * MiB  , WS_PART = 562 * MiB, WS_SS = 585 * MiB, WS_BIAS = 588 * MiB, WS_RS = 588 * MiB + 512 * 1024, WS_END = 589 * MiB;

struct Params {
    const float *x, *c, *ctx, *c_ctx, *w_mod, *b_mod, *norm_g, *ffn_w1, *ffn_w3, *ffn_w2, *w_in, *conv_w, *conv_b, *rg_lam, *rg_wa, *rg_ba, *rg_wi, *rg_bi,
        *gla_wup, *gla_bup, *gla_norm_g, *w_out, *final_g;
    float* out; unsigned char* ws;
};

typedef const __attribute__((address_space(4))) Params& PREF;
#define WAVE_SYNC() asm volatile("s_waitcnt lgkmcnt(0)" ::: "memory")

__device__ __forceinline__ unsigned f2bf(float f) { unsigned r; asm("v_cvt_pk_bf16_f32 %0, %1, %1" : "=v"(r) : "v"(f)); return r & 0xffffu; }
__device__ __forceinline__ unsigned pk2(float lo, float hi) { unsigned r; asm("v_cvt_pk_bf16_f32 %0, %1, %2" : "=v"(r) : "v"(lo), "v"(hi)); return r; }
__device__ __forceinline__ float bf2f(unsigned h) { return __builtin_bit_cast(float, h << 16); }
__device__ __forceinline__ float rcpf_(float x) { return __builtin_amdgcn_rcpf(x); }
__device__ __forceinline__ float sigmoid_f(float x) { return rcpf_(1.f + __expf(-x)); }
__device__ __forceinline__ float silu_f(float x) { return x * sigmoid_f(x); }
__device__ __forceinline__ float gelu_tanh_f(float x) { const float y = 0.7978845608028654f * (x + 0.044715f * x * x * x); return x * sigmoid_f(2.f * y); }
__device__ __forceinline__ float shx(float v, int m, int lane) { return __builtin_bit_cast(float, __builtin_amdgcn_ds_bpermute((lane ^ m) << 2, __builtin_bit_cast(int, v))); }
__device__ __forceinline__ float wave_sum(float v, int lane) {
#pragma unroll
    for (int o = 1; o < 64; o <<= 1) v += shx(v, o, lane);
    return v;
}
__device__ __forceinline__ f32x4 mfma16(bf16x8 a, bf16x8 b, f32x4 c) { return __builtin_amdgcn_mfma_f32_16x16x32_bf16(a, b, c, 0, 0, 0); }

__device__ __forceinline__ float row_rs(const float* rsv, int row) { return rsv[row]; }
struct EpiSwiglu {
    static constexpr bool PERM = true, AFTER_DRAIN = false;
    bf16_t* G; const float* ss; const float* bias;
    __device__ __forceinline__ void operator()(const f32x4 (&acc)[2][2][4][2], const pg8::Unit& u, int wr, int wc, int fr, int fq) const {
        asm volatile("" : "+v"(fr), "+v"(fq));
        const int row0 = u.pm * 256 + wr * 64 + fr, col0 = u.pn * 128 + wc * 32 + 8 * fq;
        const float* bp = bias + (size_t)((u.pm * 256) >> 14) * 5632 + col0;
        const f32x4 c10 = *(const f32x4*)bp, c11 = *(const f32x4*)(bp + 4), c30 = *(const f32x4*)(bp + 2816), c31 = *(const f32x4*)(bp + 2816 + 4);
#pragma unroll
        for (int ai = 0; ai < 2; ++ai)
#pragma unroll
            for (int m = 0; m < 4; ++m) {
                const int row = row0 + ai * 128 + m * 16; const float rs = row_rs(ss, row);
                const f32x4 a0 = acc[ai][0][m][0] * rs + c10, a1 = acc[ai][0][m][1] * rs + c11, b0 = acc[ai][1][m][0] * rs + c30, b1 = acc[ai][1][m][1] * rs + c31;
                u32x4 w;
                w.x = pk2(silu_f(a0[0]) * b0[0], silu_f(a0[1]) * b0[1]); w.y = pk2(silu_f(a0[2]) * b0[2], silu_f(a0[3]) * b0[3]);
                w.z = pk2(silu_f(a1[0]) * b1[0], silu_f(a1[1]) * b1[1]); w.w = pk2(silu_f(a1[2]) * b1[2], silu_f(a1[3]) * b1[3]);
                *(u32x4*)(G + (size_t)row * PW + col0) = w;
            }
    }
};
struct EpiStore {
    static constexpr bool PERM = true, AFTER_DRAIN = false;
    bf16_t* O; int ldc; const float* ss; const float* bias;
    __device__ __forceinline__ void operator()(const f32x4 (&acc)[2][2][4][2], const pg8::Unit& u, int wr, int wc, int fr, int fq) const {
        asm volatile("" : "+v"(fr), "+v"(fq));
        const int row0 = u.pm * 256 + wr * 64 + fr, col0 = u.pn * 256 + wc * 32 + 8 * fq;
        const float* bp = bias + (size_t)((u.pm * 256) >> 14) * 5632 + col0;
        f32x4 cb[2][2];
#pragma unroll
        for (int bj = 0; bj < 2; ++bj) { cb[bj][0] = *(const f32x4*)(bp + bj * 128); cb[bj][1] = *(const f32x4*)(bp + bj * 128 + 4); }
#pragma unroll
        for (int ai = 0; ai < 2; ++ai)
#pragma unroll
            for (int m = 0; m < 4; ++m) {
                const int row = row0 + ai * 128 + m * 16; const float rs = row_rs(ss, row);
#pragma unroll
                for (int bj = 0; bj < 2; ++bj) {
                    const f32x4 v0 = acc[ai][bj][m][0] * rs + cb[bj][0], v1 = acc[ai][bj][m][1] * rs + cb[bj][1];
                    u32x4 w; w.x = pk2(v0[0], v0[1]); w.y = pk2(v0[2], v0[3]); w.z = pk2(v1[0], v1[1]); w.w = pk2(v1[2], v1[3]);
                    *(u32x4*)(O + (size_t)row * ldc + col0 + bj * 128) = w;
                }
            }
    }
};
struct EpiResid {
    static constexpr bool PERM = true, AFTER_DRAIN = false;
    unsigned char* wsb; const float* gate; const float* ngn; const float* scn; float coef; int emit;
    __device__ __forceinline__ void operator()(const f32x4 (&acc)[2][2][4][2], const pg8::Unit& u, int wr, int wc, int fr, int fq) const {
        asm volatile("" : "+v"(fr), "+v"(fq));
        float* const hout_ctx = (float*)(wsb + WS_HCTX); float* const part = (float*)(wsb + WS_PART); bf16_t* const Un = emit ? (bf16_t*)(wsb + WS_U) : (bf16_t*)nullptr; float* const ssn = (float*)(wsb + WS_SS);
        const int rowt = u.pm * 256; const int grp = rowt >> 14;
        const bool isctx = rowt >= TL;
        if (isctx) {
            const int row0 = rowt - TL + wr * 64 + fr, col0 = u.pn * 256 + wc * 32 + 8 * fq;
            const float* gp = gate + (size_t)2 * (NMOD * DM) + col0;
            float* pb = part + (size_t)(u.kb >> 8) * (TC * DM);
#pragma unroll
            for (int bj = 0; bj < 2; ++bj) {
                const f32x4 g0 = *(const f32x4*)(gp + bj * 128) * coef, g1 = *(const f32x4*)(gp + bj * 128 + 4) * coef;
#pragma unroll
                for (int ai = 0; ai < 2; ++ai)
#pragma unroll
                    for (int m = 0; m < 4; ++m) {
                        float* o = pb + (size_t)(row0 + ai * 128 + m * 16) * DM + col0 + bj * 128;
                        *(f32x4*)o = g0 * acc[ai][bj][m][0]; *(f32x4*)(o + 4) = g1 * acc[ai][bj][m][1];
                    }
            }
            return;
        }
        bf16_t* const hb = (bf16_t*)(wsb + WS_HB);
        const int row0 = rowt + wr * 64 + fr, col0 = u.pn * 256 + wc * 32 + 8 * fq;
        const float* gp = gate + (size_t)grp * (NMOD * DM) + col0;
        float sq[2][4];
#pragma unroll
        for (int ai = 0; ai < 2; ++ai)
#pragma unroll
            for (int m = 0; m < 4; ++m) sq[ai][m] = 0.f;
#pragma unroll
        for (int bj = 0; bj < 2; ++bj) {
            const f32x4 g0 = *(const f32x4*)(gp + bj * 128) * coef, g1 = *(const f32x4*)(gp + bj * 128 + 4) * coef;
            f32x4 s0 = {0.f, 0.f, 0.f, 0.f}, s1 = s0;
            if (Un) { const float* np_ = ngn + col0 + bj * 128; const float* sp_ = scn + (size_t)grp * (NMOD * DM) + col0 + bj * 128;
                s0 = *(const f32x4*)np_ * (*(const f32x4*)sp_ + 1.f); s1 = *(const f32x4*)(np_ + 4) * (*(const f32x4*)(sp_ + 4) + 1.f); }
#pragma unroll
            for (int ai = 0; ai < 2; ++ai)
#pragma unroll
                for (int m = 0; m < 4; ++m) {
                    const size_t off = (size_t)(row0 + ai * 128 + m * 16) * DM + col0 + bj * 128;
                    f32x4 h0, h1;
                    { const u32x4 r = *(const u32x4*)(hb + off);
                        h0 = (f32x4){bf2f(r.x & 0xffffu), __builtin_bit_cast(float, r.x & 0xffff0000u), bf2f(r.y & 0xffffu), __builtin_bit_cast(float, r.y & 0xffff0000u)};
                        h1 = (f32x4){bf2f(r.z & 0xffffu), __builtin_bit_cast(float, r.z & 0xffff0000u), bf2f(r.w & 0xffffu), __builtin_bit_cast(float, r.w & 0xffff0000u)}; }
                    h0 = h0 + g0 * acc[ai][bj][m][0]; h1 = h1 + g1 * acc[ai][bj][m][1];
                    { u32x4 wq; wq.x = pk2(h0[0], h0[1]); wq.y = pk2(h0[2], h0[3]); wq.z = pk2(h1[0], h1[1]); wq.w = pk2(h1[2], h1[3]); *(u32x4*)(hb + off) = wq; }
                    if (Un) {
                        sq[ai][m] += ((h0[0] * h0[0] + h0[1] * h0[1]) + (h0[2] * h0[2] + h0[3] * h0[3])) + ((h1[0] * h1[0] + h1[1] * h1[1]) + (h1[2] * h1[2] + h1[3] * h1[3]));
                        const f32x4 u0 = h0 * s0, u1 = h1 * s1;
                        u32x4 w; w.x = pk2(u0[0], u0[1]); w.y = pk2(u0[2], u0[3]); w.z = pk2(u1[0], u1[1]); w.w = pk2(u1[2], u1[3]);
                        *(u32x4*)(Un + off) = w;
                    }
                }
        }
        if (Un) {
#pragma unroll
            for (int ai = 0; ai < 2; ++ai)
#pragma unroll
                for (int m = 0; m < 4; ++m) { float t = sq[ai][m]; t += shx(t, 16, fq * 16 + fr); t += shx(t, 32, fq * 16 + fr);
                    if (fq == 0) ssn[(size_t)(row0 + ai * 128 + m * 16) * 16 + u.pn * 4 + wc] = t; }
        }
    }
};

struct DownOrder {
    pg8::StaticOrder so; pg8::SplitKOrder sk; int nlat, nctx, inv;
    __device__ bool next(int i, pg8::Unit& u) const {
        const int L = i * so.G + so.c;
        if (L < nlat) return so.next(i, u);
        const int Lc = L - nlat; if (Lc >= nctx) return false;
        const int tile = (Lc * inv) >> 16, ks = Lc - tile * sk.nsplit;
        u.pm = sk.pm0 + (tile >> 2); u.pn = tile & 3; u.kb = ks * 256; u.nk = 4; return true;
    }
    __device__ __forceinline__ void a_ready(const pg8::Unit&) const {}
    __device__ __forceinline__ void done(const pg8::Unit&) const {}
};

__device__ __forceinline__ void transpose_item(const float* __restrict__ W, int K, int ldn, bf16_t* __restrict__ WT, int drow, int k0, int n0, LAS float* scr, int lane) {
    float wv[32];
#pragma unroll
    for (int i = 0; i < 32; ++i) { const int kk = 2 * i + (lane >> 5); wv[i] = W[(size_t)(k0 + kk) * ldn + n0 + (lane & 31)]; }
#pragma unroll
    for (int i = 0; i < 32; ++i) { const int kk = 2 * i + (lane >> 5); scr[kk * 33 + (lane & 31)] = wv[i]; }
    WAVE_SYNC();
    const int c = lane & 7;
#pragma unroll
    for (int j = 0; j < 4; ++j) { const int n = (lane >> 3) + 8 * j; const LAS float* s = scr + (8 * c) * 33 + n;
        u32x4 o; o.x = pk2(s[0 * 33], s[1 * 33]); o.y = pk2(s[2 * 33], s[3 * 33]); o.z = pk2(s[4 * 33], s[5 * 33]); o.w = pk2(s[6 * 33], s[7 * 33]);
        *(u32x4*)(WT + (size_t)(drow + n0 + n) * K + k0 + 8 * c) = o; }
    WAVE_SYNC();
}

__device__ __forceinline__ void convert_weights(PREF p, int l, LAS unsigned char* lds, int gw, int NGW, int wave, int lane) {
    LAS float* scr = (LAS float*)(lds + wave * 16384);
    unsigned char* ws = p.ws;
    bf16_t* W13 = (bf16_t*)(ws + WS_W13); bf16_t* W2 = (bf16_t*)(ws + WS_W2); bf16_t* WIN = (bf16_t*)(ws + WS_WIN); bf16_t* WOUT = (bf16_t*)(ws + WS_WOUT);
    constexpr int I_UP = 16 * 88, I_DN = 44 * 32, I_IN = 16 * 81, I_OUT = 16 * 32;
    constexpr int NIT = 4 * I_UP + 2 * I_DN + I_IN + I_OUT;
    for (int it = gw; it < NIT; it += NGW) {
        int r = it;
        if (r < 4 * I_UP) { const int seg = r / I_UP; r -= seg * I_UP; const int f = seg >> 1, is3 = seg & 1;
            const int kb = r / 88, nb = r % 88, n0 = nb * 32;
            const float* W = (is3 ? p.ffn_w3 : p.ffn_w1) + (size_t)(l * 2 + f) * DM * DFF;
            transpose_item(W, DM, DFF, W13 + (size_t)f * 5632 * DM, (n0 >> 7) * 256 + (n0 & 127) + is3 * 128 - n0, kb * 64, n0, scr, lane); continue; }
        r -= 4 * I_UP;
        if (r < 2 * I_DN) { const int f = r / I_DN; r -= f * I_DN; const int kb = r / 32, nb = r % 32;
            transpose_item(p.ffn_w2 + (size_t)(l * 2 + f) * DFF * DM, DFF, DM, W2 + (size_t)f * DM * DFF, 0, kb * 64, nb * 32, scr, lane); continue; }
        r -= 2 * I_DN;
        if (r < I_IN) { const int kb = r / 81, nb = r % 81;
            transpose_item(p.w_in + (size_t)l * DM * 2592, DM, 2592, WIN, 0, kb * 64, nb * 32, scr, lane); continue; }
        r -= I_IN;
        { const int kb = r / 32, nb = r % 32; transpose_item(p.w_out + (size_t)l * DM * DM, DM, DM, WOUT, 0, kb * 64, nb * 32, scr, lane); }
    }
}

__device__ __forceinline__ void phase_mods(PREF p, LAS unsigned char* lds, int tid, int wave, int lane) {
    LAS float* sS = (LAS float*)lds;
    LAS float* red = (LAS float*)(lds + 12288);
    float* mod = (float*)(p.ws + WS_MOD);
    for (int i = tid; i < 3072; i += NTHREADS) { const int g = i >> 10, k = i & 1023; const float xv = g < 2 ? p.c[g * 1024 + k] : p.c_ctx[k]; sS[i] = silu_f(xv); }
    __syncthreads();
    for (int item = blockIdx.x; item < NLAYER * 144; item += gridDim.x) {
        const int l = item / 144, nc = item % 144;
        const float* W = p.w_mod + (size_t)l * DM * (NMOD * DM) + nc * 64 + lane;
        float a0 = 0.f, a1 = 0.f, a2 = 0.f; const int k0 = wave * 128;
#pragma unroll 16
        for (int kk = 0; kk < 128; ++kk) { const int k = k0 + kk; const float w = W[(size_t)k * (NMOD * DM)]; a0 += sS[k] * w; a1 += sS[1024 + k] * w; a2 += sS[2048 + k] * w; }
        red[(wave * 3 + 0) * 64 + lane] = a0; red[(wave * 3 + 1) * 64 + lane] = a1; red[(wave * 3 + 2) * 64 + lane] = a2;
        __syncthreads();
        if (wave < 3) { float s = p.b_mod[l * (NMOD * DM) + nc * 64 + lane];
#pragma unroll
            for (int w = 0; w < 8; ++w) s += red[(w * 3 + wave) * 64 + lane];
            mod[(size_t)(l * 3 + wave) * (NMOD * DM) + nc * 64 + lane] = s; }
        __syncthreads();
    }
}

__device__ __forceinline__ void phase_gatew(PREF p, int gtid, int gthreads) {
    bf16_t* WgT = (bf16_t*)(p.ws + WS_WG);
    for (int e = gtid; e < NLAYER * 2 * 2 * 8 * 4096; e += gthreads) {
        const int i = e & 63, j = (e >> 6) & 63, h = (e >> 12) & 7, ty = (e >> 15) & 1, d = (e >> 16) & 1, l = e >> 17;
        const float* src = ty ? p.rg_wi : p.rg_wa;
        WgT[e] = (bf16_t)f2bf(src[(size_t)((l * 2 + d) * 8 + h) * 4096 + i * 64 + j]);
    }
}

__device__ __forceinline__ void phase_norm(PREF p, int l, int jn, int rbeg, int rend, bool first, int nsplit, int gw, int NGW, int lane) {
    const float* mod = (const float*)(p.ws + WS_MOD); const float* hctx = (const float*)(p.ws + WS_HCTX); bf16_t* U = (bf16_t*)(p.ws + WS_U); float* SS = (float*)(p.ws + WS_SS);
    const float* ng = p.norm_g + (size_t)(l * 3 + jn) * DM;
    for (int row = rbeg + gw; row < rend; row += NGW) {
        const float* src = row < TL ? ((first ? p.x : p.out) + (size_t)row * DM) : ((first ? p.ctx : hctx) + (size_t)(row - TL) * DM);
        const float* mb = mod + (size_t)(l * 3 + (row >> 14)) * (NMOD * DM);
        f32x4 v[4]; float ss = 0.f;
#pragma unroll
        for (int j = 0; j < 4; ++j) v[j] = *(const f32x4*)(src + 4 * lane + 256 * j);
        if (row >= TL && nsplit > 0) {
            const float* pr = (const float*)(p.ws + WS_PART) + (size_t)(row - TL) * DM + 4 * lane;
            for (int k = 0; k < nsplit; ++k)
#pragma unroll
                for (int j = 0; j < 4; ++j) v[j] += *(const f32x4*)(pr + (size_t)k * (TC * DM) + 256 * j);
            float* dst = (float*)(p.ws + WS_HCTX) + (size_t)(row - TL) * DM + 4 * lane;
#pragma unroll
            for (int j = 0; j < 4; ++j) *(f32x4*)(dst + 256 * j) = v[j];
        }
#pragma unroll
        for (int j = 0; j < 4; ++j) ss += (v[j][0] * v[j][0] + v[j][1] * v[j][1]) + (v[j][2] * v[j][2] + v[j][3] * v[j][3]);
        ss = wave_sum(ss, lane);
        if (lane == 0) ((float*)(p.ws + WS_RS))[row] = __builtin_amdgcn_rsqf(ss * (1.f / DM) + 1e-6f);
        if (first && row < TL) {
#pragma unroll
            for (int j = 0; j < 4; ++j) { u32x2 w; w.x = pk2(v[j][0], v[j][1]); w.y = pk2(v[j][2], v[j][3]); *(u32x2*)((bf16_t*)(p.ws + WS_HB) + (size_t)row * DM + 4 * lane + 256 * j) = w; }
        }
#pragma unroll
        for (int j = 0; j < 4; ++j) { const int col = 4 * lane + 256 * j;
            const f32x4 g = *(const f32x4*)(ng + col), sc = *(const f32x4*)(mb + (3 * jn + 1) * DM + col);
            const f32x4 o = v[j] * g * (sc + 1.f);
            u32x2 w; w.x = pk2(o[0], o[1]); w.y = pk2(o[2], o[3]);
            *(u32x2*)(U + (size_t)row * DM + col) = w; }
    }
}
__device__ __forceinline__ void phase_rs(PREF p, int gtid, int gthreads) {
    const float* SS = (const float*)(p.ws + WS_SS); float* RS = (float*)(p.ws + WS_RS);
    for (int row = gtid; row < TL; row += gthreads) {
        const f32x4 a = *(const f32x4*)(SS + (size_t)row * 16), b = *(const f32x4*)(SS + (size_t)row * 16 + 4), c = *(const f32x4*)(SS + (size_t)row * 16 + 8), d = *(const f32x4*)(SS + (size_t)row * 16 + 12);
        const float t = (((a[0] + a[1]) + (a[2] + a[3])) + ((b[0] + b[1]) + (b[2] + b[3]))) + (((c[0] + c[1]) + (c[2] + c[3])) + ((d[0] + d[1]) + (d[2] + d[3])));
        RS[row] = __builtin_amdgcn_rsqf(t * (1.f / DM) + 1e-6f);
    }
}
__device__ __forceinline__ void phase_bias(PREF p, int l, LAS unsigned char* lds, int tid, int wave, int lane) {
    LAS float* sS = (LAS float*)lds;
    LAS float* red = (LAS float*)(lds + 12288);
    const float* mod = (const float*)(p.ws + WS_MOD); float* BIAS = (float*)(p.ws + WS_BIAS);
    for (int item = blockIdx.x; item < 217; item += gridDim.x) {
        int mi, nc;
        if (item < 44) { mi = 0; nc = item; } else if (item < 88) { mi = 1; nc = item - 44; } else if (item < 129) { mi = 2; nc = item - 88; } else if (item < 173) { mi = 3; nc = item - 129; } else { mi = 4; nc = item - 173; }
        const int jn = mi < 2 ? 0 : (mi == 2 ? 1 : 2), slot = jn, boff = (mi == 1 || mi == 4) ? 2816 : 0, f = mi >= 3 ? 1 : 0;
        const int ldn = mi == 2 ? 2592 : DFF;
        const float* Wm = mi == 2 ? p.w_in + (size_t)l * DM * 2592 : ((mi == 1 || mi == 4) ? p.ffn_w3 : p.ffn_w1) + (size_t)(l * 2 + f) * DM * DFF;
        for (int i = tid; i < 3072; i += NTHREADS) { const int g = i >> 10, k = i & 1023; sS[i] = mod[(size_t)(l * 3 + g) * (NMOD * DM) + (3 * jn) * DM + k]; }
        __syncthreads();
        const int n = nc * 64 + lane; const bool nv = n < ldn;
        const float* W = Wm + (nv ? n : 0);
        float a0 = 0.f, a1 = 0.f, a2 = 0.f; const int k0 = wave * 128;
#pragma unroll 16
        for (int kk = 0; kk < 128; ++kk) { const int k = k0 + kk; const float w = W[(size_t)k * ldn]; a0 += sS[k] * w; a1 += sS[1024 + k] * w; a2 += sS[2048 + k] * w; }
        red[(wave * 3 + 0) * 64 + lane] = a0; red[(wave * 3 + 1) * 64 + lane] = a1; red[(wave * 3 + 2) * 64 + lane] = a2;
        __syncthreads();
        if (wave < 3 && nv) { float sum = 0.f;
#pragma unroll
            for (int w = 0; w < 8; ++w) sum += red[(w * 3 + wave) * 64 + lane];
            BIAS[(size_t)(slot * 3 + wave) * 5632 + boff + n] = sum; }
        __syncthreads();
    }
}
__device__ __forceinline__ void phase_final(PREF p, int gw, int NGW, int lane) {
    const bf16_t* HBp = (const bf16_t*)(p.ws + WS_HB);
    for (int row = gw; row < TL; row += NGW) {
        u32x2 w[4]; f32x4 v[4]; float ss = 0.f;
#pragma unroll
        for (int j = 0; j < 4; ++j) w[j] = *(const u32x2*)(HBp + (size_t)row * DM + 4 * lane + 256 * j);
#pragma unroll
        for (int j = 0; j < 4; ++j) { v[j] = (f32x4){bf2f(w[j].x & 0xffffu), __builtin_bit_cast(float, w[j].x & 0xffff0000u), bf2f(w[j].y & 0xffffu), __builtin_bit_cast(float, w[j].y & 0xffff0000u)};
            ss += (v[j][0] * v[j][0] + v[j][1] * v[j][1]) + (v[j][2] * v[j][2] + v[j][3] * v[j][3]); }
        const float rs = __builtin_amdgcn_rsqf(wave_sum(ss, lane) * (1.f / DM) + 1e-6f);
#pragma unroll
        for (int j = 0; j < 4; ++j) { const int col = 4 * lane + 256 * j; const f32x4 g = *(const f32x4*)(p.final_g + col); *(f32x4*)(p.out + (size_t)row * DM + col) = v[j] * rs * g; }
    }
}

__device__ __forceinline__ int scan_order(int d, int step) { return d == 0 ? step : (step < 4 ? 3 - step : 263 - step); }

template <bool FINAL, int D>
__device__ __forceinline__ void rg_dir(PREF p, int l, int h, int ch, int sidx, int rowbase  , LAS bf16_t* sXc, LAS float* stg, int lane) {
    const bf16_t* __restrict__ P = (const bf16_t*)(p.ws + WS_GP); const bf16_t* __restrict__ WgT = (const bf16_t*)(p.ws + WS_WG);
    float* __restrict__ RGA = (float*)(p.ws + WS_RGA); float* __restrict__ RGH = (float*)(p.ws + WS_RGH); const float* __restrict__ RGC = (const float*)(p.ws + WS_RGC);
    bf16_t* __restrict__ MIX = (bf16_t*)(p.ws + WS_MIX);
    bf16_t* __restrict__ TMP = (bf16_t*)(p.ws + WS_U);
    const bf16_t* wr_ = WgT + (size_t)(((l * 2 + D) * 2 + 0) * 8 + h) * 4096; const bf16_t* wi_ = WgT + (size_t)(((l * 2 + D) * 2 + 1) * 8 + h) * 4096;
    const float ba = p.rg_ba[(l * 2 + D) * 512 + ch], bi = p.rg_bi[(l * 2 + D) * 512 + ch], lam = p.rg_lam[(l * 2 + D) * 512 + ch];
    const float e_ = __expf(-lam), u_ = 1.f + e_;
    const float l1p = (u_ == 1.f) ? e_ : __logf(u_) * e_ * rcpf_(u_ - 1.f);
    const float sp8 = -8.f * 1.4426950408889634f * l1p;
    float hc = FINAL ? RGC[sidx] : 0.f, Ap = 1.f;
    bf16x8 Br[4][2], Bi[4][2];
#pragma unroll
    for (int nt = 0; nt < 4; ++nt) { const int o0 = (nt * 16 + (lane & 15)) * 64 + (lane >> 4) * 8;
        Br[nt][0] = *(const bf16x8*)(wr_ + o0); Br[nt][1] = *(const bf16x8*)(wr_ + o0 + 32); Bi[nt][0] = *(const bf16x8*)(wi_ + o0); Bi[nt][1] = *(const bf16x8*)(wi_ + o0 + 32); }
    if (FINAL && D == 1) asm volatile("s_waitcnt vmcnt(0)" ::: "memory");
#pragma unroll 1
    for (int mi = 0; mi < 4; ++mi) { const int mt = D ? 3 - mi : mi;
        float grv[16], hfv[16];
        if (FINAL && D == 1) {
#pragma unroll
            for (int ti = 0; ti < 16; ++ti) { const size_t row = (size_t)(rowbase + mt * 16 + 15 - ti); grv[ti] = __builtin_bit_cast(float, (unsigned)P[row * PW + 512 + ch]); hfv[ti] = __builtin_bit_cast(float, (unsigned)TMP[row * 512 + ch]); }
            __builtin_amdgcn_sched_barrier(0);
#pragma unroll
            for (int ti = 0; ti < 16; ++ti) { grv[ti] = bf2f(__builtin_bit_cast(unsigned, grv[ti])); hfv[ti] = bf2f(__builtin_bit_cast(unsigned, hfv[ti])); }
        }
        const bf16x8 A0 = *(const LAS bf16x8*)(sXc + (mt * 16 + (lane & 15)) * 72 + (lane >> 4) * 8), A1 = *(const LAS bf16x8*)(sXc + (mt * 16 + (lane & 15)) * 72 + 32 + (lane >> 4) * 8);
        f32x4 ar[4], ai[4];
#pragma unroll
        for (int nt = 0; nt < 4; ++nt) { const f32x4 z = {0.f, 0.f, 0.f, 0.f};
            ar[nt] = mfma16(A0, Br[nt][0], z); ar[nt] = mfma16(A1, Br[nt][1], ar[nt]); ai[nt] = mfma16(A0, Bi[nt][0], z); ai[nt] = mfma16(A1, Bi[nt][1], ai[nt]); }
        WAVE_SYNC();
#pragma unroll
        for (int nt = 0; nt < 4; ++nt)
#pragma unroll
            for (int j = 0; j < 4; ++j) { const int o = ((lane >> 4) * 4 + j) * 64 + nt * 16 + (lane & 15); stg[o] = ar[nt][j]; stg[1024 + o] = ai[nt][j]; }
        WAVE_SYNC();
        float av[16], iv[16];
#pragma unroll
        for (int ti = 0; ti < 16; ++ti) { const int tk = D ? 15 - ti : ti;
            const float zr = stg[tk * 64 + lane] + ba, zi = stg[1024 + tk * 64 + lane] + bi;
            const float r = sigmoid_f(zr), ig = sigmoid_f(zi);
            const float a = __builtin_amdgcn_exp2f(r * sp8);
            const float xc = bf2f(sXc[(mt * 16 + tk) * 72 + lane]);
            av[ti] = a; iv[ti] = __builtin_amdgcn_sqrtf(fmaxf(1.f - a * a, 0.f)) * ig * xc;
            if (FINAL && D == 1) grv[ti] = gelu_tanh_f(grv[ti]);
        }
#pragma unroll
        for (int ti = 0; ti < 16; ++ti) { const int tk = D ? 15 - ti : ti;
            hc = av[ti] * hc + iv[ti]; Ap *= av[ti];
            if (FINAL) { const size_t row = (size_t)(rowbase + mt * 16 + tk);
                if (D == 0) TMP[row * 512 + ch] = (bf16_t)f2bf(hc);
                else MIX[row * DM + ch] = (bf16_t)f2bf(grv[ti] * (hfv[ti] + hc)); }
        }
    }
    if (!FINAL) { RGA[sidx] = Ap; RGH[sidx] = hc; }
}

template <bool FINAL>
__device__ __forceinline__ void rg_item(PREF p, int l, int item, LAS unsigned char* wl, int lane) {
    const bf16_t* __restrict__ P = (const bf16_t*)(p.ws + WS_GP);
    const int h = item & 7, rest = item >> 3;
    const int ci = rest < 512 ? 4 + (rest & 255) : ((rest - 512) & 3), b = rest < 512 ? (rest >> 8) : ((rest - 512) >> 2);
    const int seq_row0 = ci < 4 ? TL + b * 256 : b * 16384;
    const int t0 = ci < 4 ? ci * 64 : (ci - 4) * 64;
    const int seqlen = ci < 4 ? 256 : 16384;
    const int ch = h * 64 + lane;
    LAS bf16_t* sXc = (LAS bf16_t*)wl;
    LAS float* stg = (LAS float*)(wl + 9216);
    {
        const float cw0 = p.conv_w[(l * 4 + 0) * 512 + ch], cw1 = p.conv_w[(l * 4 + 1) * 512 + ch], cw2 = p.conv_w[(l * 4 + 2) * 512 + ch], cw3 = p.conv_w[(l * 4 + 3) * 512 + ch];
        const float cb = p.conv_b[l * 512 + ch];
        float xv[67]; unsigned xr_[67];
#pragma unroll
        for (int i = 0; i < 67; ++i) { const int t = t0 - 2 + i; const int tc = t < 0 ? 0 : (t >= seqlen ? seqlen - 1 : t);
            xr_[i] = P[(size_t)(seq_row0 + tc) * PW + ch]; }
        __builtin_amdgcn_sched_barrier(0);
#pragma unroll
        for (int i = 0; i < 67; ++i) { const int t = t0 - 2 + i; const int tc = t < 0 ? 0 : (t >= seqlen ? seqlen - 1 : t); xv[i] = (t == tc) ? bf2f(xr_[i]) : 0.f; }
#pragma unroll
        for (int tt = 0; tt < 64; ++tt) { const float xc = xv[tt] * cw0 + xv[tt + 1] * cw1 + xv[tt + 2] * cw2 + xv[tt + 3] * cw3 + cb; sXc[tt * 72 + lane] = (bf16_t)f2bf(xc); }
    }
    WAVE_SYNC();
    const int sidx0 = ((b * NCH + ci) * 2) * 512 + ch;
    rg_dir<FINAL, 0>(p, l, h, ch, sidx0, seq_row0 + t0, sXc, stg, lane);
    rg_dir<FINAL, 1>(p, l, h, ch, sidx0 + 512, seq_row0 + t0, sXc, stg, lane);
    WAVE_SYNC();
}

__device__ __forceinline__ void rg_carry(PREF p, int wave, int lane) {
    if (wave != 0 || blockIdx.x < 128 || blockIdx.x >= 160) return;
    const int gtid = ((int)blockIdx.x - 128) * 64 + lane;
    const float* __restrict__ RGA = (const float*)(p.ws + WS_RGA); const float* __restrict__ RGH = (const float*)(p.ws + WS_RGH); float* __restrict__ RGC = (float*)(p.ws + WS_RGC);
    const int b = gtid >> 10, d = (gtid >> 9) & 1, ch = gtid & 511;
    float h = 0.f;
    for (int s0 = 0; s0 < NCH; s0 += 26) {
        float av[26], hv[26];
#pragma unroll
        for (int k = 0; k < 26; ++k) { const int idx = ((b * NCH + scan_order(d, s0 + k)) * 2 + d) * 512 + ch; av[k] = RGA[idx]; hv[k] = RGH[idx]; }
#pragma unroll
        for (int k = 0; k < 26; ++k) { const int idx = ((b * NCH + scan_order(d, s0 + k)) * 2 + d) * 512 + ch; RGC[idx] = h; h = av[k] * h + hv[k]; }
    }
}

__device__ __forceinline__ void gla_rows(int b, int cj, int& row0, int& rstride) {
    if (cj < 4) { row0 = TL + b * 256 + cj * 64; rstride = 1; }
    else { const int q = cj - 4; row0 = b * 16384 + ((q & 3) * 64) * 64 + (q >> 2); rstride = 64; }
}

__device__ __forceinline__ void gl1_item(PREF p, int l, int item, bool valid, LAS unsigned char* pl, int sw, int lane) {
    const bf16_t* __restrict__ P = (const bf16_t*)(p.ws + WS_GP); bf16_t* __restrict__ QK = (bf16_t*)(p.ws + WS_QK);
    float* __restrict__ GLS = (float*)(p.ws + WS_GLS); float* __restrict__ GLD = (float*)(p.ws + WS_GLD);
    LAS bf16_t* sVt = (LAS bf16_t*)pl;
    LAS bf16_t* sKt = (LAS bf16_t*)(pl + 18432 + sw * 9216);
    LAS float* sD = (LAS float*)(pl + 36864 + sw * 256);
    const int d = sw;
    const int h = item & 3, rest = item >> 2;
    const int cj = rest < 512 ? 4 + (rest & 255) : ((rest - 512) & 3), b = rest < 512 ? (rest >> 8) : ((rest - 512) >> 2);
    int row0, rstride; gla_rows(b, cj, row0, rstride);
    const int seq = (b * 4 + h) * 2 + d;
    if (valid) {
        const bf16_t* prl = P + (size_t)(row0 + lane * rstride) * PW + 2560 + d * 16;
        const u32x4 lra = *(const u32x4*)prl, lrb = *(const u32x4*)(prl + 8);
        unsigned lrp[8] = {lra.x, lra.y, lra.z, lra.w, lrb.x, lrb.y, lrb.z, lrb.w};
        float qc[16], kc[16];
#pragma unroll
        for (int ss = 0; ss < 16; ++ss) { const int i = d ? 63 - ss : ss; const bf16_t* pr = P + (size_t)(row0 + i * rstride) * PW + h * 64 + lane;
            qc[ss] = __builtin_bit_cast(float, (unsigned)pr[1024]); kc[ss] = __builtin_bit_cast(float, (unsigned)pr[1280]); }
        __builtin_amdgcn_sched_barrier(0);
#pragma unroll
        for (int ss = 0; ss < 16; ++ss) { qc[ss] = bf2f(__builtin_bit_cast(unsigned, qc[ss])); kc[ss] = bf2f(__builtin_bit_cast(unsigned, kc[ss])); }
        unsigned wupp[8];
#pragma unroll
        for (int r2 = 0; r2 < 8; ++r2) wupp[r2] = pk2(p.gla_wup[(size_t)((l * 2 + d) * 16 + 2 * r2) * 256 + h * 64 + lane], p.gla_wup[(size_t)((l * 2 + d) * 16 + 2 * r2 + 1) * 256 + h * 64 + lane]);
        const float bup = p.gla_bup[(l * 2 + d) * 256 + h * 64 + lane];
#pragma unroll 1
        for (int g2 = 0; g2 < 2; ++g2) {
            unsigned vr[16];
#pragma unroll
            for (int ii = 0; ii < 16; ++ii) { const int i = 32 * sw + g2 * 16 + ii; vr[ii] = *(const unsigned*)(P + (size_t)(row0 + i * rstride) * PW + 1536 + h * 128 + 2 * lane); }
#pragma unroll
            for (int ii = 0; ii < 16; ++ii) { const int i = 32 * sw + g2 * 16 + ii; sVt[(2 * lane) * 72 + i] = (bf16_t)(vr[ii] & 0xffffu); sVt[(2 * lane + 1) * 72 + i] = (bf16_t)(vr[ii] >> 16); }
        }
        float bc = 0.f;
#pragma unroll 1
        for (int g4 = 0; g4 < 4; ++g4) {
            float qn[16], kn[16];
            if (g4 < 3) {
#pragma unroll
                for (int ss = 0; ss < 16; ++ss) { const int s = (g4 + 1) * 16 + ss; const int i = d ? 63 - s : s; const bf16_t* pr = P + (size_t)(row0 + i * rstride) * PW + h * 64 + lane;
                    qn[ss] = __builtin_bit_cast(float, (unsigned)pr[1024]); kn[ss] = __builtin_bit_cast(float, (unsigned)pr[1280]); }
                __builtin_amdgcn_sched_barrier(0);
            }
            float gv[16];
#pragma unroll
            for (int ss = 0; ss < 16; ++ss) { const int s = g4 * 16 + ss; const int i = d ? 63 - s : s;
                float z = bup;
#pragma unroll
                for (int r2 = 0; r2 < 8; ++r2) { const unsigned w = (unsigned)__builtin_amdgcn_readlane((int)lrp[r2], i);
                    z = __builtin_amdgcn_fdot2_f32_bf16(__builtin_bit_cast(bf16x2_t, w), __builtin_bit_cast(bf16x2_t, wupp[r2]), z, false); }
                gv[ss] = -(fmaxf(-z, 0.f) + __logf(1.f + __expf(-fabsf(z)))) * (1.f / 16.f);
                __builtin_amdgcn_sched_barrier(0);
            }
#pragma unroll
            for (int ss = 0; ss < 16; ++ss) { const int s = g4 * 16 + ss; const int i = d ? 63 - s : s; const size_t rowi = (size_t)(row0 + i * rstride);
                bc += gv[ss];
                const float en = __expf(-bc), ep = __expf(bc);
                const float kt = kc[ss] * en, qt = qc[ss] * 0.125f * ep;
                const unsigned ktb = f2bf(kt);
                sKt[lane * 72 + i] = (bf16_t)ktb;
                QK[rowi * 1024 + d * 512 + h * 64 + lane] = (bf16_t)f2bf(qt);
                QK[rowi * 1024 + d * 512 + 256 + h * 64 + lane] = (bf16_t)ktb;
            }
#pragma unroll
            for (int ss = 0; ss < 16; ++ss) { qc[ss] = bf2f(__builtin_bit_cast(unsigned, qn[ss])); kc[ss] = bf2f(__builtin_bit_cast(unsigned, kn[ss])); }
        }
        const float Dv = __expf(bc);
        sD[lane] = Dv; GLD[(size_t)(seq * NCH + cj) * 64 + lane] = Dv;
    }
    __syncthreads();
    if (valid) {
        bf16x8 Ak[4][2]; f32x4 Dm[4];
#pragma unroll
        for (int mt = 0; mt < 4; ++mt) { Dm[mt] = *(const LAS f32x4*)(sD + mt * 16 + (lane >> 4) * 4);
#pragma unroll
            for (int ks = 0; ks < 2; ++ks) Ak[mt][ks] = *(const LAS bf16x8*)(sKt + (mt * 16 + (lane & 15)) * 72 + ks * 32 + (lane >> 4) * 8); }
        bf16_t* So = (bf16_t*)GLS + (size_t)(seq * NCH + cj) * 8192;
#pragma unroll 2
        for (int nt = 0; nt < 8; ++nt) {
            const bf16x8 B0 = *(const LAS bf16x8*)(sVt + (nt * 16 + (lane & 15)) * 72 + (lane >> 4) * 8), B1 = *(const LAS bf16x8*)(sVt + (nt * 16 + (lane & 15)) * 72 + 32 + (lane >> 4) * 8);
#pragma unroll
            for (int mt = 0; mt < 4; ++mt) { f32x4 acc = {0.f, 0.f, 0.f, 0.f}; acc = mfma16(Ak[mt][0], B0, acc); acc = mfma16(Ak[mt][1], B1, acc);
                acc = acc * Dm[mt];
                u32x2 w; w.x = pk2(acc[0], acc[1]); w.y = pk2(acc[2], acc[3]);
                *(u32x2*)(So + (nt * 16 + (lane & 15)) * 64 + mt * 16 + (lane >> 4) * 4) = w; }
        }
    }
    __syncthreads();
}

__device__ __forceinline__ void gl2_scan(PREF p, int gtid, int gthreads) {
    unsigned* __restrict__ GLS = (unsigned*)(p.ws + WS_GLS); const float* __restrict__ GLD = (const float*)(p.ws + WS_GLD);
    for (int g = gtid; g < 16 * 4096; g += gthreads) {
        const int seq = g >> 12, e2 = g & 4095, kk = (e2 * 2) & 63, d = seq & 1;
        float S0 = 0.f, S1 = 0.f;
        for (int s0 = 0; s0 < NCH; s0 += 20) {
            unsigned dv[20]; float D0[20], D1[20];
#pragma unroll
            for (int k = 0; k < 20; ++k) { const int cj = scan_order(d, s0 + k); dv[k] = GLS[(size_t)(seq * NCH + cj) * 4096 + e2];
                const float* dp = GLD + (size_t)(seq * NCH + cj) * 64 + kk; D0[k] = dp[0]; D1[k] = dp[1]; }
#pragma unroll
            for (int k = 0; k < 20; ++k) { const int cj = scan_order(d, s0 + k); GLS[(size_t)(seq * NCH + cj) * 4096 + e2] = pk2(S0, S1);
                S0 = D0[k] * S0 + bf2f(dv[k] & 0xffffu); S1 = D1[k] * S1 + __builtin_bit_cast(float, dv[k] & 0xffff0000u); }
        }
    }
}

__device__ __forceinline__ void gl3_item(PREF p, int l, int item, bool valid, LAS unsigned char* sl, int w4, int t256, int lane) {
    const bf16_t* __restrict__ P = (const bf16_t*)(p.ws + WS_GP); const bf16_t* __restrict__ QK = (const bf16_t*)(p.ws + WS_QK);
    const float* __restrict__ GLS = (const float*)(p.ws + WS_GLS); bf16_t* __restrict__ MIX = (bf16_t*)(p.ws + WS_MIX);
    LAS bf16_t* sVt = (LAS bf16_t*)sl;
    LAS bf16_t* sS = (LAS bf16_t*)(sl + 18432);
    LAS bf16_t* sAtt = (LAS bf16_t*)(sl + 55296);
    const int h = item & 3, rest = item >> 2;
    const int cj = rest < 512 ? 4 + (rest & 255) : ((rest - 512) & 3), b = rest < 512 ? (rest >> 8) : ((rest - 512) >> 2);
    int row0, rstride; gla_rows(b, cj, row0, rstride);
    f32x4 o[8];
#pragma unroll
    for (int nt = 0; nt < 8; ++nt) o[nt] = (f32x4){0.f, 0.f, 0.f, 0.f};
    bf16x8 Aq[2][2], Bk[4][2];
    const size_t rowi_a = (size_t)(row0 + (16 * w4 + (lane & 15)) * rstride);
    if (valid) {
        unsigned vr[16]; u32x4 sv[2][4];
#pragma unroll
        for (int ii = 0; ii < 16; ++ii) { const int i = 16 * w4 + ii; vr[ii] = *(const unsigned*)(P + (size_t)(row0 + i * rstride) * PW + 1536 + h * 128 + 2 * lane); }
#pragma unroll
        for (int d = 0; d < 2; ++d) { const bf16_t* Sg = (const bf16_t*)GLS + (size_t)(((b * 4 + h) * 2 + d) * NCH + cj) * 8192;
#pragma unroll
            for (int r = 0; r < 4; ++r) sv[d][r] = *(const u32x4*)(Sg + (r * 256 + t256) * 8); }
#pragma unroll
        for (int d = 0; d < 2; ++d)
#pragma unroll
            for (int ks = 0; ks < 2; ++ks) Aq[d][ks] = *(const bf16x8*)(QK + rowi_a * 1024 + d * 512 + h * 64 + ks * 32 + (lane >> 4) * 8);
#pragma unroll
        for (int nt = 0; nt < 4; ++nt) { const size_t rows = (size_t)(row0 + (nt * 16 + (lane & 15)) * rstride);
#pragma unroll
            for (int ks = 0; ks < 2; ++ks) Bk[nt][ks] = *(const bf16x8*)(QK + rows * 1024 + 256 + h * 64 + ks * 32 + (lane >> 4) * 8); }
#pragma unroll
        for (int ii = 0; ii < 16; ++ii) { const int i = 16 * w4 + ii; sVt[(2 * lane) * 72 + i] = (bf16_t)(vr[ii] & 0xffffu); sVt[(2 * lane + 1) * 72 + i] = (bf16_t)(vr[ii] >> 16); }
#pragma unroll
        for (int d = 0; d < 2; ++d)
#pragma unroll
            for (int r = 0; r < 4; ++r) { const int e = (r * 256 + t256) * 8; *(LAS u32x4*)(sS + d * 9216 + (e >> 6) * 72 + (e & 63)) = sv[d][r]; }
    }
    __syncthreads();
    if (valid) {
#pragma unroll
        for (int d = 0; d < 2; ++d) {
            f32x4 att[4];
#pragma unroll
            for (int nt = 0; nt < 4; ++nt) { att[nt] = (f32x4){0.f, 0.f, 0.f, 0.f};
#pragma unroll
                for (int ks = 0; ks < 2; ++ks) att[nt] = mfma16(Aq[d][ks], Bk[nt][ks], att[nt]); }
            if (d == 0) {
#pragma unroll
                for (int nt = 0; nt < 4; ++nt) { const size_t rows = (size_t)(row0 + (nt * 16 + (lane & 15)) * rstride);
#pragma unroll
                    for (int ks = 0; ks < 2; ++ks) Bk[nt][ks] = *(const bf16x8*)(QK + rows * 1024 + 512 + 256 + h * 64 + ks * 32 + (lane >> 4) * 8); }
            }
            WAVE_SYNC();
#pragma unroll
            for (int nt = 0; nt < 4; ++nt)
#pragma unroll
                for (int j = 0; j < 4; ++j) { const int i_ = 16 * w4 + (lane >> 4) * 4 + j, s_ = nt * 16 + (lane & 15); const bool keep = d == 0 ? (s_ <= i_) : (s_ >= i_);
                    sAtt[i_ * 72 + s_] = keep ? (bf16_t)f2bf(att[nt][j]) : (bf16_t)0; }
            WAVE_SYNC();
            bf16x8 Aa[2];
#pragma unroll
            for (int ks = 0; ks < 2; ++ks) Aa[ks] = *(const LAS bf16x8*)(sAtt + (16 * w4 + (lane & 15)) * 72 + ks * 32 + (lane >> 4) * 8);
#pragma unroll
            for (int nt = 0; nt < 8; ++nt)
#pragma unroll
                for (int ks = 0; ks < 2; ++ks) { const int bo = (nt * 16 + (lane & 15)) * 72 + ks * 32 + (lane >> 4) * 8;
                    o[nt] = mfma16(Aa[ks], *(const LAS bf16x8*)(sVt + bo), o[nt]); o[nt] = mfma16(Aq[d][ks], *(const LAS bf16x8*)(sS + d * 9216 + bo), o[nt]); }
        }
        const float* gn = p.gla_norm_g + l * 512 + h * 128;
        unsigned ogr[4][8];
#pragma unroll
        for (int j = 0; j < 4; ++j) { const size_t rowi = (size_t)(row0 + (16 * w4 + (lane >> 4) * 4 + j) * rstride);
#pragma unroll
            for (int nt = 0; nt < 8; ++nt) ogr[j][nt] = P[rowi * PW + 2048 + h * 128 + nt * 16 + (lane & 15)]; }
        __builtin_amdgcn_sched_barrier(0);
#pragma unroll
        for (int j = 0; j < 4; ++j) {
            float ss = 0.f;
#pragma unroll
            for (int nt = 0; nt < 8; ++nt) ss += o[nt][j] * o[nt][j];
            ss += shx(ss, 1, lane); ss += shx(ss, 2, lane); ss += shx(ss, 4, lane); ss += shx(ss, 8, lane);
            const float rs = __builtin_amdgcn_rsqf(ss * (1.f / 128.f) + 1e-6f);
            const size_t rowi = (size_t)(row0 + (16 * w4 + (lane >> 4) * 4 + j) * rstride);
            float ogv[8];
#pragma unroll
            for (int nt = 0; nt < 8; ++nt) ogv[nt] = bf2f(ogr[j][nt]);
#pragma unroll
            for (int nt = 0; nt < 8; ++nt) { const int vv = nt * 16 + (lane & 15);
                MIX[rowi * DM + 512 + h * 128 + vv] = (bf16_t)f2bf(o[nt][j] * rs * gn[vv] * silu_f(ogv[nt])); }
        }
    }
    __syncthreads();
}

#define XB_TMO      128
#define XB_XCNT(j)  (256  + 64 * (j))
#define XB_XSUB(j)  (1280 + 64 * (j))
#define XB_XGEN(j)  (2304 + 64 * (j))
#define XB_TOP      3328
#define XB_TOPGEN   3392
#define XCD_BAR_WORDS 3456
#define XB_SPIN_CAP (1u << 18)

__device__ __forceinline__ unsigned xb_ld(unsigned* p)              { return __hip_atomic_load(p, __ATOMIC_RELAXED, __HIP_MEMORY_SCOPE_AGENT); }
__device__ __forceinline__ unsigned xb_add(unsigned* p, unsigned v) { return __hip_atomic_fetch_add(p, v, __ATOMIC_RELAXED, __HIP_MEMORY_SCOPE_AGENT); }
__device__ __forceinline__ unsigned xb_xcc_id() { return (unsigned)__builtin_amdgcn_s_getreg((3 << 11) | 20) & 0xFu; }
#define XB_SPIN(cond, bar) do { unsigned _sp = 0; while (cond) { __builtin_amdgcn_s_sleep(1); \
    if ((++_sp & 255u) == 0u) { if (xb_ld(&(bar)[XB_TMO])) break; if (_sp > XB_SPIN_CAP) { atomicAdd(&(bar)[XB_TMO], 1u); break; } } } } while (0)

struct XcdBarrier {
    unsigned* bar; unsigned x;
    volatile LAS unsigned* st;
};

__device__ __forceinline__ XcdBarrier xcd_barrier_post(unsigned* bar, volatile LAS unsigned* st) {
    XcdBarrier b; b.bar = bar; b.x = xb_xcc_id(); b.st = st;
    if (threadIdx.x == 0) (void)xb_add(&bar[XB_XCNT(b.x)], 1u);
    return b;
}
__device__ __forceinline__ void xcd_barrier_complete(unsigned* bar, unsigned x, unsigned& nloc, unsigned& nx) {
    const unsigned G = gridDim.x * gridDim.y * gridDim.z;
    unsigned sum, cnt, mine, sp = 0u;
    for (;;) {
        sum = 0u; cnt = 0u; mine = 0u;
#pragma unroll
        for (unsigned j = 0; j < 16; ++j) { const unsigned c = xb_ld(&bar[XB_XCNT(j)]); sum += c; cnt += (c > 0u) ? 1u : 0u; mine = (j == x) ? c : mine; }
        if (sum == G) break;
        __builtin_amdgcn_s_sleep(1);
        if ((++sp & 255u) == 0u) { if (xb_ld(&bar[XB_TMO])) break; if (sp > XB_SPIN_CAP) { atomicAdd(&bar[XB_TMO], 1u); break; } }
    }
    nloc = mine > 0u ? mine : 1u; nx = cnt > 0u ? cnt : 1u;
}

__device__ __forceinline__ void xcd_barrier(const XcdBarrier& b, int xb_tid) {
    asm volatile("s_waitcnt vmcnt(0)" ::: "memory");
    __syncthreads();
    if (xb_tid == 0) {
        unsigned* bar = b.bar;
        __builtin_amdgcn_s_waitcnt(0);
        unsigned nloc = b.st[0], nx = b.st[1];
        if (nloc == 0u) { xcd_barrier_complete(bar, b.x, nloc, nx); b.st[0] = nloc; b.st[1] = nx; }
        const unsigned old = xb_add(&bar[XB_XSUB(b.x)], 1u);
        const unsigned gen = old / nloc;
        if (old + 1u == (gen + 1u) * nloc) {
            __builtin_amdgcn_fence(__ATOMIC_RELEASE, "agent");
            asm volatile("s_waitcnt vmcnt(0)" ::: "memory");
            const unsigned og = xb_add(&bar[XB_TOP], 1u);
            const unsigned tg = og / nx;
            if (og + 1u == (tg + 1u) * nx) xb_add(&bar[XB_TOPGEN], 1u);
            else XB_SPIN(xb_ld(&bar[XB_TOPGEN]) == tg, bar);
            __builtin_amdgcn_fence(__ATOMIC_ACQUIRE, "agent");
            xb_add(&bar[XB_XGEN(b.x)], 1u);
            asm volatile("s_waitcnt vmcnt(0)" ::: "memory");
        } else {
            XB_SPIN(xb_ld(&bar[XB_XGEN(b.x)]) == gen, bar);
            __builtin_amdgcn_fence(__ATOMIC_ACQUIRE, "agent");
            asm volatile("s_waitcnt vmcnt(0)" ::: "memory");
        }
    }
    __syncthreads();
}

__device__ __forceinline__ int lane_id_volatile() { int l; asm volatile("v_mbcnt_lo_u32_b32 %0, -1, 0\n\tv_mbcnt_hi_u32_b32 %0, -1, %0" : "=v"(l)); return l; }
__global__ void __launch_bounds__(NTHREADS, 2) mega_fwd(Params p_arg) {
    extern __shared__ __attribute__((aligned(16))) unsigned char lds_raw[];
    LAS unsigned char* lds = (LAS unsigned char*)lds_raw;
    cg::grid_group grid = cg::this_grid();
    const int G = gridDim.x, NGW = G * 8, gthreads = G * NTHREADS;
    const int wave_s = __builtin_amdgcn_readfirstlane((int)threadIdx.x >> 6);
#define MYTID() (wave_s * 64 + lane_id_volatile())
    volatile LAS unsigned* bst = (volatile LAS unsigned*)(lds + LDS_BYTES - 64);
    if (threadIdx.x < 2) bst[threadIdx.x] = 0u;
    if (blockIdx.x == 0) { unsigned* bw = (unsigned*)(p_arg.ws + WS_BAR); for (int i = threadIdx.x; i < XCD_BAR_WORDS; i += NTHREADS) bw[i] = 0u; }
#define KARGS() const __attribute__((address_space(4))) Params* pk_ = (const __attribute__((address_space(4))) Params*)__builtin_amdgcn_kernarg_segment_ptr(); asm volatile("" : "+s"(pk_)); PREF p = *pk_;

    {
    KARGS();
    const int tid = threadIdx.x, lane = tid & 63, wave = __builtin_amdgcn_readfirstlane(tid >> 6);
    const int gw = blockIdx.x * 8 + wave, gtid = blockIdx.x * NTHREADS + tid;
    phase_mods(p, lds, tid, wave, lane);
    phase_gatew(p, gtid, gthreads);
    { float* hc_ = (float*)(p.ws + WS_HCTX); for (int i = gtid; i < TC * DM / 4; i += gthreads) ((f32x4*)hc_)[i] = ((const f32x4*)p.ctx)[i]; }
    __syncthreads();
    convert_weights(p, 0, lds, gw, NGW, wave, lane);
    }
    grid.sync();
    (void)xcd_barrier_post((unsigned*)(p_arg.ws + WS_BAR), bst);

    for (int st = 0; st < NLAYER * 12; ++st) {
#ifndef DUP_MASK
#define DUP_MASK 0
#endif
        const int s_ = st % 12;
        const int sbit = (s_ == 0 || s_ == 3 || s_ == 9) ? 1 : (s_ == 1 || s_ == 10) ? 2 : (s_ == 4) ? 4 : (s_ == 5) ? 8 : (s_ == 7) ? 16 : 0;
        const int nrep = (DUP_MASK & sbit) ? 2 : 1;
        for (int rep = 0; rep < nrep; ++rep) {
        KARGS();
        unsigned char* ws = p.ws;
        bf16_t* U = (bf16_t*)(ws + WS_U); bf16_t* MIX = (bf16_t*)(ws + WS_MIX); bf16_t* GP = (bf16_t*)(ws + WS_GP);
        float* hctx = (float*)(ws + WS_HCTX); const float* mod = (const float*)(ws + WS_MOD);
#define PHASE_IDS() const int tid = MYTID(); const int lane = tid & 63, wave = __builtin_amdgcn_readfirstlane(tid >> 6); const int gw = blockIdx.x * 8 + wave, gtid = blockIdx.x * NTHREADS + tid; (void)gw; (void)gtid; (void)lane;
        const int l = st / 12, s = st % 12;
        const bool lastl = (l == NLAYER - 1);
        const int rows = (lastl && s >= 8) ? TL : TT;
        switch (s) {
        case 0: case 3: case 9: {
            PHASE_IDS();
            const int jn = s == 0 ? 0 : (s == 3 ? 1 : 2);
            if (s == 0) { phase_bias(p, l, lds, tid, wave, lane); if (l > 0) convert_weights(p, l, lds, gw, NGW, wave, lane); }
            if (st != 0) phase_rs(p, gtid, gthreads);
            phase_norm(p, l, jn, st == 0 ? 0 : TL, rows, st == 0, s == 0 ? (l > 0 ? DFF / 256 : 0) : (s == 3 ? DFF / 256 : DM / 256), gw, NGW, lane);
        } break;
        case 1: case 10: {
            PHASE_IDS();
            const int f = s == 1 ? 0 : 1;
            pg8::Gemm g{U, (const bf16_t*)(ws + WS_W13) + (size_t)f * 5632 * DM, rows, 5632, DM, DM};
            pg8::StaticOrder S; S.init(rows, 5632, G, (int)blockIdx.x);
            EpiSwiglu E{GP, (const float*)(ws + WS_RS), (const float*)(ws + WS_BIAS) + (size_t)(f ? 2 : 0) * 3 * 5632};
            pg8::gemm_phase<EpiSwiglu, pg8::StaticOrder, true, true>(lds, g, S, E, tid);
        } break;
        case 2: case 8: case 11: {
            PHASE_IDS();
            const bool isout = (s == 8);
            const int f = s == 2 ? 0 : 1;
            const int Kd = isout ? DM : DFF;
            const bf16_t* Ad = isout ? MIX : GP; const bf16_t* Bd = isout ? (const bf16_t*)(ws + WS_WOUT) : (const bf16_t*)(ws + WS_W2) + (size_t)f * DM * DFF;
            const int gidx = s == 2 ? 2 : (s == 8 ? 5 : 8);
            const bool first = (st == 2);
            const float* gate = mod + (size_t)l * 3 * (NMOD * DM) + gidx * DM; const float coef = isout ? 1.f : 0.5f;
            pg8::Gemm g{Ad, Bd, rows, DM, Kd, Kd};
            DownOrder S; S.so.init(TL, DM, G, (int)blockIdx.x); S.sk.init(TL / 256, TC / 256, DM / 256, Kd / 256, 256, G, (int)blockIdx.x); S.nlat = (TL / 256) * (DM / 256); S.nctx = rows == TT ? S.sk.nun : 0; S.inv = isout ? 16384 : 5958;
            const int ln = s == 11 ? l + 1 : l, jnn = s == 2 ? 1 : (s == 8 ? 2 : 0);
            const bool emit = ln < NLAYER;
            EpiResid E{ws, gate, p.norm_g + (size_t)((emit ? ln : 0) * 3 + jnn) * DM, mod + (size_t)(emit ? ln : 0) * 3 * (NMOD * DM) + (3 * jnn + 1) * DM, coef, emit ? 1 : 0};
            pg8::gemm_phase<EpiResid, DownOrder, true, true>(lds, g, S, E, tid);
        } break;
        case 4: {
            PHASE_IDS();
            pg8::Gemm g{U, (const bf16_t*)(ws + WS_WIN), rows, PW, DM, DM};
            pg8::StaticOrder S; S.init(rows, PW, G, (int)blockIdx.x);
            EpiStore E{GP, PW, (const float*)(ws + WS_RS), (const float*)(ws + WS_BIAS) + (size_t)1 * 3 * 5632};
            pg8::gemm_phase<EpiStore, pg8::StaticOrder, true, true>(lds, g, S, E, tid);
        } break;
        case 5: {
            PHASE_IDS();
            for (int r2 = 0; r2 < ((DUP_MASK & 32) ? 2 : 1); ++r2)
            for (int item = gw; item < 2 * NCH * 8; item += NGW) rg_item<false>(p, l, item, lds + wave * 18432, lane);
            __syncthreads();
            const int NP = G * 4, pgid = NP - 1 - (blockIdx.x * 4 + (wave >> 1));
            for (int r2 = 0; r2 < ((DUP_MASK & (64 | 128)) ? 2 : 1); ++r2)
            for (int it = 0; it * NP < 2 * NCH * 4; ++it) { const int item = it * NP + pgid; gl1_item(p, l, item, item < 2 * NCH * 4, lds + (wave >> 1) * 37376, wave & 1, lane); }
        } break;
        case 6: {
            PHASE_IDS();
            rg_carry(p, wave, lane);
            gl2_scan(p, gtid, gthreads);
        } break;
        case 7: {
            PHASE_IDS();
            const int nrg = lastl ? 2 * 256 * 8 : 2 * NCH * 8, ngl = lastl ? 2 * 256 * 4 : 2 * NCH * 4;
            for (int item = gw; item < nrg; item += NGW) rg_item<true>(p, l, item, lds + wave * 18432, lane);
            __syncthreads();
            const int NS = G * 2, sgid = NS - 1 - (blockIdx.x * 2 + (wave >> 2));
            for (int r2 = 0; r2 < ((DUP_MASK & (64 | 256)) ? 2 : 1); ++r2)
            for (int it = 0; it * NS < ngl; ++it) { const int item = it * NS + sgid; gl3_item(p, l, item, item < ngl, lds + (wave >> 2) * 64512, wave & 3, tid & 255, lane); }
        } break;
        }
        { XcdBarrier xb_; xb_.bar = (unsigned*)(p.ws + WS_BAR); xb_.x = xb_xcc_id(); xb_.st = (volatile LAS unsigned*)(lds + LDS_BYTES - 64); xcd_barrier(xb_, MYTID()); }
        }
    }
    { KARGS(); const int tid = MYTID(), lane = tid & 63, wave = __builtin_amdgcn_readfirstlane(tid >> 6); phase_final(p, blockIdx.x * 8 + wave, NGW, lane); }
}

extern "C" void kernel_launch(void* const* d_in, const int* in_sizes, int n_in, void* d_out, int out_size, void* d_ws, size_t ws_size, hipStream_t stream) {
    static int grid_blocks = 0;
    if (grid_blocks == 0) {
        if (n_in != 23 || ws_size < WS_END) { fprintf(stderr, "kernel_launch: unexpected n_in %d or ws_size %zu (< %zu)\n", n_in, ws_size, (size_t)WS_END); grid_blocks = -1; return; }
        int dev = 0, cus = 0, per_cu = 0;
        hipGetDevice(&dev);
        hipDeviceGetAttribute(&cus, hipDeviceAttributeMultiprocessorCount, dev);
        if (hipFuncSetAttribute((const void*)mega_fwd, hipFuncAttributeMaxDynamicSharedMemorySize, LDS_BYTES) != hipSuccess) { fprintf(stderr, "kernel_launch: hipFuncSetAttribute failed\n"); grid_blocks = -1; return; }
        if (hipOccupancyMaxActiveBlocksPerMultiprocessor(&per_cu, (const void*)mega_fwd, NTHREADS, LDS_BYTES) != hipSuccess || per_cu < 1) { fprintf(stderr, "kernel_launch: occupancy query says %d\n", per_cu); per_cu = 1; }
        (void)hipGetLastError();
        grid_blocks = cus;
    }
    if (grid_blocks < 0) return;
    Params p{};
    const float** pp = (const float**)&p;
    for (int i = 0; i < 23; ++i) pp[i] = (const float*)d_in[i];
    p.out = (float*)d_out; p.ws = (unsigned char*)d_ws;
    void* args[] = {&p};
    hipError_t e = hipLaunchCooperativeKernel((const void*)mega_fwd, dim3(grid_blocks), dim3(NTHREADS), args, LDS_BYTES, stream);
    if (e != hipSuccess) fprintf(stderr, "cooperative launch failed: %s (grid %d)\n", hipGetErrorString(e), grid_blocks);
}
```

```cpp
#include <hip/hip_runtime.h>
#include <hip/hip_cooperative_groups.h>
#include <cstdio>
#include <cstdint>
namespace cg = cooperative_groups;
namespace pg8 {
#define PG8_LAS __attribute__((address_space(3)))
typedef unsigned short bf16_t;
typedef short bf16x8 __attribute__((ext_vector_type(8)));
typedef float f32x4 __attribute__((ext_vector_type(4)));
typedef unsigned u32x4 __attribute__((ext_vector_type(4)));
constexpr int BM = 256, BK = 64, HALF = 128, HTB = HALF * BK * 2  , STAGE_BYTES = 8 * HTB, NXCD = 8, WGM = 8;

__host__ __device__ __forceinline__ int lds_byte(int r, int c) { const int st = (r >> 4) * 2 + (c >> 5), rr = r & 15, cc = c & 31, ob = rr * 64 + cc * 2; return st * 1024 + (ob ^ (((ob >> 9) & 1) << 5)); }
__host__ __device__ __forceinline__ void stage_rc(int b, int& R, int& C) { const int st = b / 1024, sb = b % 1024, swz = sb ^ (((sb >> 9) & 1) << 5); R = (st >> 1) * 16 + swz / 64; C = (st & 1) * 32 + (swz % 64) / 2; }
__host__ __device__ __forceinline__ int perm32(int rho) { const int n = rho >> 4, i = rho & 15; return 8 * (i >> 2) + 4 * n + (i & 3); }

struct Unit { int pm, pn, kb, nk; };
struct Gemm { const bf16_t* A; const bf16_t* Bt; int M, N, K, ldk; };

struct StaticOrder {
    int nM, nN, nwg, G, c;
    __host__ __device__ void init(int M, int N, int G_, int c_) { nM = M / BM; nN = N / BM; nwg = nM * nN; G = G_; c = c_; }
    __host__ __device__ bool next(int i, Unit& u) const {
        const long L = (long)i * G + c; if (L >= nwg) return false;
        int wgid = (int)L; { const int q = nwg / NXCD, r = nwg % NXCD, xcd = wgid % NXCD, off = wgid / NXCD; wgid = (xcd < r ? xcd * (q + 1) : r * (q + 1) + (xcd - r) * q) + off; }
        const int nig = WGM * nN, gid = wgid / nig, fm = gid * WGM, gsz = (nM - fm) < WGM ? (nM - fm) : WGM;
        u.pm = fm + ((wgid % nig) % gsz); u.pn = (wgid % nig) / gsz; u.kb = 0; u.nk = 0; return true;
    }
    __device__ __forceinline__ void a_ready(const Unit&) const {}
    __device__ __forceinline__ void done(const Unit&) const {}
};
struct SplitKOrder {
    int pm0, nN, nsplit, kc, nun, G, c;
    __host__ __device__ void init(int pm0_, int nM_, int nN_, int nsplit_, int kc_, int G_, int c_) { pm0 = pm0_; nN = nN_; nsplit = nsplit_; kc = kc_; nun = nM_ * nN_ * nsplit_; G = G_; c = c_; }
    __host__ __device__ bool next(int i, Unit& u) const {
        const int L = i * G + c; if (L >= nun) return false;
        const int tile = L / nsplit, ks = L - tile * nsplit;
        u.pm = pm0 + tile / nN; u.pn = tile % nN; u.kb = ks * kc; u.nk = kc / BK; return true;
    }
    __device__ __forceinline__ void a_ready(const Unit&) const {}
    __device__ __forceinline__ void done(const Unit&) const {}
};
__device__ __forceinline__ unsigned cvt_pk_bf16(float lo, float hi) { unsigned r; asm volatile("v_cvt_pk_bf16_f32 %0, %1, %2" : "=v"(r) : "v"(lo), "v"(hi)); return r; }
template <class Epi, class Sched, bool ALIGN_EPI = false, bool SP2 = false>
__device__ __forceinline__ void gemm_phase(PG8_LAS unsigned char* lds, const Gemm g, const Sched& S, const Epi& E, int tid_in) {
    int tid = tid_in; asm volatile("" : "+v"(tid));
    const int wid = __builtin_amdgcn_readfirstlane(tid >> 6), lane = tid & 63, wr = wid >> 2, wc = wid & 3, fr = lane & 15, fq = lane >> 4;
    const int K = g.ldk, nt_all = g.K / BK;
    unsigned voffA[2], voffB[2];
#pragma unroll
    for (int i = 0; i < 2; ++i) { int R, C; stage_rc(tid * 16 + i * 8192, R, C); const int Rb = Epi::PERM ? ((R & ~31) + perm32(R & 31)) : R;
        voffA[i] = (unsigned)(R * K + C) * 2u; voffB[i] = (unsigned)(Rb * K + C) * 2u; }
    const size_t kstep = (size_t)(BK * 2);
    const size_t hstep = (size_t)HALF * K * 2;
    const size_t tstep = 2 * hstep;
    const unsigned ldsw = (unsigned)wid * 1024u;
    const int aoff = lds_byte(wr * 64 + fr, fq * 8), boff = lds_byte(wc * 32 + fr, fq * 8);
#define PG8_SA(b, h) (((b) * 2 + (h)) * HTB)
#define PG8_SB(b, h) ((4 + (b) * 2 + (h)) * HTB)
#define PG8_STAGE(bufoff, gbase, voff) do { _Pragma("unroll") for (int _i = 0; _i < 2; ++_i) \
        __builtin_amdgcn_global_load_lds((const unsigned*)((const char*)(gbase) + (voff)[_i]), (PG8_LAS unsigned*)(lds + (bufoff) + ldsw + _i * 8192), 16, 0, 0); } while (0)
#define PG8_LDA(dst, b, h) do { _Pragma("unroll") for (int m = 0; m < 4; ++m) _Pragma("unroll") for (int k = 0; k < 2; ++k) dst[m][k] = *(const PG8_LAS bf16x8*)(lds + PG8_SA(b, h) + aoff + m * 2048 + k * 1024); } while (0)
#define PG8_LDB(dst, b, h) do { _Pragma("unroll") for (int n = 0; n < 2; ++n) _Pragma("unroll") for (int k = 0; k < 2; ++k) dst[n][k] = *(const PG8_LAS bf16x8*)(lds + PG8_SB(b, h) + boff + n * 2048 + k * 1024); } while (0)
#define PG8_MMA(ai, bj, At, Bt) do { __builtin_amdgcn_s_setprio(1); _Pragma("unroll") for (int m = 0; m < 4; ++m) _Pragma("unroll") for (int n = 0; n < 2; ++n) _Pragma("unroll") for (int k = 0; k < 2; ++k) \
        acc[ai][bj][m][n] = __builtin_amdgcn_mfma_f32_16x16x32_bf16(Bt[n][k], At[m][k], acc[ai][bj][m][n], 0, 0, 0); __builtin_amdgcn_s_setprio(0); } while (0)
#define PG8_WAIT_V(n) asm volatile("s_waitcnt vmcnt(" #n ")" ::: "memory")
#define PG8_WAIT_L(n) asm volatile("s_waitcnt lgkmcnt(" #n ")" ::: "memory")
#define PG8_BAR __builtin_amdgcn_s_barrier()
#define PG8_SCHED __builtin_amdgcn_sched_barrier(0)
    Unit cur, nxt; int ui = 0;
    if (!S.next(0, cur)) return;
    f32x4 acc[2][2][4][2];
#pragma unroll
    for (int a = 0; a < 2; ++a)
#pragma unroll
        for (int b = 0; b < 2; ++b)
#pragma unroll
            for (int m = 0; m < 4; ++m)
#pragma unroll
                for (int n = 0; n < 2; ++n) acc[a][b][m][n] = (f32x4){0.f, 0.f, 0.f, 0.f};
    bf16x8 At[4][2], B0[2][2], B1[2][2];
    const char* cA = (const char*)g.A + (size_t)cur.pm * tstep + (size_t)cur.kb * 2; const char* cB = (const char*)g.Bt + (size_t)cur.pn * tstep + (size_t)cur.kb * 2;
    S.a_ready(cur);
    if constexpr (SP2) {
        PG8_STAGE(PG8_SB(0, 0), cB, voffB); PG8_STAGE(PG8_SB(0, 1), cB + hstep, voffB); PG8_STAGE(PG8_SA(0, 0), cA, voffA); PG8_STAGE(PG8_SA(0, 1), cA + hstep, voffA);
        if (wr == 1) PG8_BAR;
        PG8_WAIT_V(2); PG8_BAR;
        PG8_STAGE(PG8_SB(1, 0), cB + kstep, voffB); PG8_STAGE(PG8_SA(1, 0), cA + kstep, voffA); PG8_STAGE(PG8_SB(1, 1), cB + hstep + kstep, voffB);
        PG8_WAIT_V(6); PG8_BAR;
    } else {
        PG8_STAGE(PG8_SB(0, 0), cB, voffB); PG8_STAGE(PG8_SA(0, 0), cA, voffA); PG8_STAGE(PG8_SB(0, 1), cB + hstep, voffB); PG8_STAGE(PG8_SA(0, 1), cA + hstep, voffA);
        if (wr == 1) PG8_BAR;
        PG8_WAIT_V(4); PG8_BAR;
        PG8_STAGE(PG8_SB(1, 0), cB + kstep, voffB); PG8_STAGE(PG8_SA(1, 0), cA + kstep, voffA); PG8_STAGE(PG8_SB(1, 1), cB + hstep + kstep, voffB);
        PG8_WAIT_V(6); PG8_BAR;
    }
    for (;;) {
        const bool has_next = S.next(ui + 1, nxt);
        const char* nA = has_next ? (const char*)g.A + (size_t)nxt.pm * tstep + (size_t)nxt.kb * 2 : cA; const char* nB = has_next ? (const char*)g.Bt + (size_t)nxt.pn * tstep + (size_t)nxt.kb * 2 : cB;
        const int nt = cur.nk ? cur.nk : nt_all;
        for (int t = 0; t < nt; t += 2) {
            const bool last = (t == nt - 2);
            const char* a1 = cA + (size_t)(t + 1) * kstep;
            const char* a2 = last ? nA : cA + (size_t)(t + 2) * kstep; const char* b2 = last ? nB : cB + (size_t)(t + 2) * kstep;
            const char* a3 = a2 + kstep; const char* b3 = b2 + kstep;
            if (last && has_next) S.a_ready(nxt);
            if constexpr (SP2) {
            PG8_LDB(B0, 0, 0); PG8_LDB(B1, 0, 1); PG8_SCHED; PG8_LDA(At, 0, 0); PG8_STAGE(PG8_SA(1, 1), a1 + hstep, voffA);
            PG8_WAIT_V(8); PG8_WAIT_L(0); PG8_BAR; PG8_MMA(0, 0, At, B0); PG8_MMA(0, 1, At, B1); PG8_BAR; PG8_SCHED;
            PG8_LDA(At, 0, 1); PG8_STAGE(PG8_SB(0, 0), b2, voffB); PG8_STAGE(PG8_SB(0, 1), b2 + hstep, voffB); PG8_STAGE(PG8_SA(0, 0), a2, voffA);
            PG8_WAIT_V(8); PG8_WAIT_L(0); PG8_BAR; PG8_MMA(1, 0, At, B0); PG8_MMA(1, 1, At, B1); PG8_BAR; PG8_SCHED;
            PG8_LDB(B0, 1, 0); PG8_LDB(B1, 1, 1); PG8_SCHED; PG8_LDA(At, 1, 0); PG8_STAGE(PG8_SA(0, 1), a2 + hstep, voffA);
            PG8_WAIT_V(8); PG8_WAIT_L(0); PG8_BAR; PG8_MMA(0, 0, At, B0); PG8_MMA(0, 1, At, B1); PG8_BAR; PG8_SCHED;
            PG8_LDA(At, 1, 1); PG8_STAGE(PG8_SB(1, 0), b3, voffB); PG8_STAGE(PG8_SB(1, 1), b3 + hstep, voffB); PG8_STAGE(PG8_SA(1, 0), a3, voffA);
            PG8_WAIT_V(8); PG8_WAIT_L(0); PG8_BAR; PG8_MMA(1, 0, At, B0); PG8_MMA(1, 1, At, B1); PG8_BAR; PG8_SCHED;
            } else {
            PG8_LDB(B0, 0, 0); PG8_SCHED; PG8_LDA(At, 0, 0); PG8_STAGE(PG8_SA(1, 1), a1 + hstep, voffA);
            PG8_WAIT_L(8); PG8_BAR; PG8_WAIT_L(0); PG8_MMA(0, 0, At, B0); PG8_BAR; PG8_SCHED;
            PG8_LDB(B1, 0, 1); PG8_STAGE(PG8_SB(0, 0), b2, voffB);
            PG8_BAR; PG8_WAIT_L(0); PG8_MMA(0, 1, At, B1); PG8_BAR;
            PG8_LDA(At, 0, 1); PG8_STAGE(PG8_SA(0, 0), a2, voffA);
            PG8_BAR; PG8_WAIT_L(0); PG8_MMA(1, 0, At, B0); PG8_BAR; PG8_SCHED;
            PG8_STAGE(PG8_SB(0, 1), b2 + hstep, voffB);
            PG8_WAIT_V(6); PG8_BAR; PG8_MMA(1, 1, At, B1); PG8_BAR;
            PG8_LDB(B0, 1, 0); PG8_SCHED; PG8_LDA(At, 1, 0); PG8_STAGE(PG8_SA(0, 1), a2 + hstep, voffA);
            PG8_WAIT_L(8); PG8_BAR; PG8_WAIT_L(0); PG8_MMA(0, 0, At, B0); PG8_BAR; PG8_SCHED;
            PG8_LDB(B1, 1, 1); PG8_STAGE(PG8_SB(1, 0), b3, voffB);
            PG8_BAR; PG8_WAIT_L(0); PG8_MMA(0, 1, At, B1); PG8_BAR;
            PG8_LDA(At, 1, 1); PG8_STAGE(PG8_SA(1, 0), a3, voffA);
            PG8_BAR; PG8_WAIT_L(0); PG8_MMA(1, 0, At, B0); PG8_BAR; PG8_SCHED;
            PG8_STAGE(PG8_SB(1, 1), b3 + hstep, voffB);
            PG8_WAIT_V(6); PG8_BAR; PG8_MMA(1, 1, At, B1); PG8_BAR;
            }
        }
        if constexpr (ALIGN_EPI) { if (wr == 0) PG8_BAR; }
        if constexpr (!Epi::AFTER_DRAIN) { E(acc, cur, wr, wc, fr, fq); S.done(cur); }
        if (!has_next) break;
#pragma unroll
        for (int a = 0; a < 2; ++a)
#pragma unroll
            for (int b = 0; b < 2; ++b)
#pragma unroll
                for (int m = 0; m < 4; ++m)
#pragma unroll
                    for (int n = 0; n < 2; ++n) acc[a][b][m][n] = (f32x4){0.f, 0.f, 0.f, 0.f};
        cur = nxt; cA = nA; cB = nB; ++ui;
        if constexpr (ALIGN_EPI) { if (wr == 1) PG8_BAR; }
    }
    PG8_WAIT_V(0);
    if constexpr (!ALIGN_EPI) { if (wr == 0) PG8_BAR; }
    PG8_BAR;
    if constexpr (Epi::AFTER_DRAIN) { E.fused(acc, cur, wr, wc, fr, fq, lds, wid, lane); S.done(cur); }
#undef PG8_SA
#undef PG8_SB
#undef PG8_STAGE
#undef PG8_LDA
#undef PG8_LDB
#undef PG8_MMA
#undef PG8_WAIT_V
#undef PG8_WAIT_L
#undef PG8_BAR
#undef PG8_SCHED
}
}

#define LAS __attribute__((address_space(3)))
typedef unsigned short bf16_t;
typedef short bf16x8 __attribute__((ext_vector_type(8)));
typedef float f32x4 __attribute__((ext_vector_type(4)));
typedef unsigned u32x4 __attribute__((ext_vector_type(4)));
typedef unsigned u32x2 __attribute__((ext_vector_type(2)));
typedef __bf16 bf16x2_t __attribute__((ext_vector_type(2)));

constexpr int DM = 1024, DFF = 2816, NLAYER = 4, NMOD = 9;
constexpr int TL = 32768, TC = 512, TT = TL + TC;
constexpr int PW = 2816;
constexpr int NCH = 260;
constexpr int LDS_BYTES = 155648;
constexpr int NTHREADS = 512;

constexpr size_t MiB = 1u << 20;
constexpr size_t WS_MOD = 0, WS_HCTX = 1 * MiB, WS_WG = 3 * MiB, WS_RGA = 4 * MiB, WS_RGH = 7 * MiB, WS_RGC = 10 * MiB, WS_GLD = 13 * MiB,
                 WS_BAR = 15 * MiB, WS_W13 = 16 * MiB, WS_W2 = 38 * MiB, WS_WIN = 49 * MiB, WS_WOUT = 55 * MiB, WS_U = 58 * MiB, WS_MIX = 123 * MiB,
                 WS_GP = 188 * MiB, WS_QK = 367 * MiB, WS_GLS = 432 * MiB, WS_HB = 497 * MiB  , WS_PART = 562 * MiB, WS_SS = 585 * MiB, WS_BIAS = 588 * MiB, WS_RS = 588 * MiB + 512 * 1024, WS_END = 589 * MiB;

struct Params {
    const float *x, *c, *ctx, *c_ctx, *w_mod, *b_mod, *norm_g, *ffn_w1, *ffn_w3, *ffn_w2, *w_in, *conv_w, *conv_b, *rg_lam, *rg_wa, *rg_ba, *rg_wi, *rg_bi,
        *gla_wup, *gla_bup, *gla_norm_g, *w_out, *final_g;
    float* out; unsigned char* ws;
};

typedef const __attribute__((address_space(4))) Params& PREF;
#define WAVE_SYNC() asm volatile("s_waitcnt lgkmcnt(0)" ::: "memory")

__device__ __forceinline__ unsigned f2bf(float f) { unsigned r; asm("v_cvt_pk_bf16_f32 %0, %1, %1" : "=v"(r) : "v"(f)); return r & 0xffffu; }
__device__ __forceinline__ unsigned pk2(float lo, float hi) { unsigned r; asm("v_cvt_pk_bf16_f32 %0, %1, %2" : "=v"(r) : "v"(lo), "v"(hi)); return r; }
__device__ __forceinline__ float bf2f(unsigned h) { return __builtin_bit_cast(float, h << 16); }
__device__ __forceinline__ float rcpf_(float x) { return __builtin_amdgcn_rcpf(x); }
__device__ __forceinline__ float sigmoid_f(float x) { return rcpf_(1.f + __expf(-x)); }
__device__ __forceinline__ float silu_f(float x) { return x * sigmoid_f(x); }
__device__ __forceinline__ float gelu_tanh_f(float x) { const float y = 0.7978845608028654f * (x + 0.044715f * x * x * x); return x * sigmoid_f(2.f * y); }
__device__ __forceinline__ float shx(float v, int m, int lane) { return __builtin_bit_cast(float, __builtin_amdgcn_ds_bpermute((lane ^ m) << 2, __builtin_bit_cast(int, v))); }
__device__ __forceinline__ float wave_sum(float v, int lane) {
#pragma unroll
    for (int o = 1; o < 64; o <<= 1) v += shx(v, o, lane);
    return v;
}
__device__ __forceinline__ f32x4 mfma16(bf16x8 a, bf16x8 b, f32x4 c) { return __builtin_amdgcn_mfma_f32_16x16x32_bf16(a, b, c, 0, 0, 0); }

__device__ __forceinline__ float row_rs(const float* rsv, int row) { return rsv[row]; }
struct EpiSwiglu {
    static constexpr bool PERM = true, AFTER_DRAIN = false;
    bf16_t* G; const float* ss; const float* bias;
    __device__ __forceinline__ void operator()(const f32x4 (&acc)[2][2][4][2], const pg8::Unit& u, int wr, int wc, int fr, int fq) const {
        asm volatile("" : "+v"(fr), "+v"(fq));
        const int row0 = u.pm * 256 + wr * 64 + fr, col0 = u.pn * 128 + wc * 32 + 8 * fq;
        const float* bp = bias + (size_t)((u.pm * 256) >> 14) * 5632 + col0;
        const f32x4 c10 = *(const f32x4*)bp, c11 = *(const f32x4*)(bp + 4), c30 = *(const f32x4*)(bp + 2816), c31 = *(const f32x4*)(bp + 2816 + 4);
#pragma unroll
        for (int ai = 0; ai < 2; ++ai)
#pragma unroll
            for (int m = 0; m < 4; ++m) {
                const int row = row0 + ai * 128 + m * 16; const float rs = row_rs(ss, row);
                const f32x4 a0 = acc[ai][0][m][0] * rs + c10, a1 = acc[ai][0][m][1] * rs + c11, b0 = acc[ai][1][m][0] * rs + c30, b1 = acc[ai][1][m][1] * rs + c31;
                u32x4 w;
                w.x = pk2(silu_f(a0[0]) * b0[0], silu_f(a0[1]) * b0[1]); w.y = pk2(silu_f(a0[2]) * b0[2], silu_f(a0[3]) * b0[3]);
                w.z = pk2(silu_f(a1[0]) * b1[0], silu_f(a1[1]) * b1[1]); w.w = pk2(silu_f(a1[2]) * b1[2], silu_f(a1[3]) * b1[3]);
                *(u32x4*)(G + (size_t)row * PW + col0) = w;
            }
    }
};
struct EpiStore {
    static constexpr bool PERM = true, AFTER_DRAIN = false;
    bf16_t* O; int ldc; const float* ss; const float* bias;
    __device__ __forceinline__ void operator()(const f32x4 (&acc)[2][2][4][2], const pg8::Unit& u, int wr, int wc, int fr, int fq) const {
        asm volatile("" : "+v"(fr), "+v"(fq));
        const int row0 = u.pm * 256 + wr * 64 + fr, col0 = u.pn * 256 + wc * 32 + 8 * fq;
        const float* bp = bias + (size_t)((u.pm * 256) >> 14) * 5632 + col0;
        f32x4 cb[2][2];
#pragma unroll
        for (int bj = 0; bj < 2; ++bj) { cb[bj][0] = *(const f32x4*)(bp + bj * 128); cb[bj][1] = *(const f32x4*)(bp + bj * 128 + 4); }
#pragma unroll
        for (int ai = 0; ai < 2; ++ai)
#pragma unroll
            for (int m = 0; m < 4; ++m) {
                const int row = row0 + ai * 128 + m * 16; const float rs = row_rs(ss, row);
#pragma unroll
                for (int bj = 0; bj < 2; ++bj) {
                    const f32x4 v0 = acc[ai][bj][m][0] * rs + cb[bj][0], v1 = acc[ai][bj][m][1] * rs + cb[bj][1];
                    u32x4 w; w.x = pk2(v0[0], v0[1]); w.y = pk2(v0[2], v0[3]); w.z = pk2(v1[0], v1[1]); w.w = pk2(v1[2], v1[3]);
                    *(u32x4*)(O + (size_t)row * ldc + col0 + bj * 128) = w;
                }
            }
    }
};
struct EpiResid {
    static constexpr bool PERM = true, AFTER_DRAIN = false;
    unsigned char* wsb; const float* gate; const float* ngp; const float* scp; const float* ngn; const float* scn; float coef; int emit;
    __device__ __forceinline__ void operator()(const f32x4 (&acc)[2][2][4][2], const pg8::Unit& u, int wr, int wc, int fr, int fq) const {
        asm volatile("" : "+v"(fr), "+v"(fq));
        float* const hout_ctx = (float*)(wsb + WS_HCTX); float* const part = (float*)(wsb + WS_PART); int em_ = __builtin_amdgcn_readfirstlane(emit); asm volatile("" : "+s"(em_)); bf16_t* const Un = em_ ? (bf16_t*)(wsb + WS_U) : (bf16_t*)nullptr; float* const ssn = (float*)(wsb + WS_SS);
        const int rowt = u.pm * 256; const int grp = rowt >> 14;
        const bool isctx = rowt >= TL;
        if (isctx) {
            const int row0 = rowt - TL + wr * 64 + fr, col0 = u.pn * 256 + wc * 32 + 8 * fq;
            const float* gp = gate + (size_t)2 * (NMOD * DM) + col0;
            float* pb = part + (size_t)(u.kb >> 8) * (TC * DM);
#pragma unroll
            for (int bj = 0; bj < 2; ++bj) {
                const f32x4 g0 = *(const f32x4*)(gp + bj * 128) * coef, g1 = *(const f32x4*)(gp + bj * 128 + 4) * coef;
#pragma unroll
                for (int ai = 0; ai < 2; ++ai)
#pragma unroll
                    for (int m = 0; m < 4; ++m) {
                        float* o = pb + (size_t)(row0 + ai * 128 + m * 16) * DM + col0 + bj * 128;
                        *(f32x4*)o = g0 * acc[ai][bj][m][0]; *(f32x4*)(o + 4) = g1 * acc[ai][bj][m][1];
                    }
            }
            return;
        }
        const int row0 = rowt + wr * 64 + fr, col0 = u.pn * 256 + wc * 32 + 8 * fq;
        const float* gp = gate + (size_t)grp * (NMOD * DM) + col0;
        float sq[2][4];
#pragma unroll
        for (int ai = 0; ai < 2; ++ai)
#pragma unroll
            for (int m = 0; m < 4; ++m) sq[ai][m] = 0.f;
#pragma unroll
        for (int bj = 0; bj < 2; ++bj) {
            const f32x4 g0 = *(const f32x4*)(gp + bj * 128) * coef, g1 = *(const f32x4*)(gp + bj * 128 + 4) * coef;
            f32x4 s0, s1, i0, i1;
            { const float* np_ = ngn + col0 + bj * 128; const float* sp_ = scn + (size_t)grp * (NMOD * DM) + col0 + bj * 128;
                s0 = *(const f32x4*)np_ * (*(const f32x4*)sp_ + 1.f); s1 = *(const f32x4*)(np_ + 4) * (*(const f32x4*)(sp_ + 4) + 1.f);
                const float* pp_ = ngp + col0 + bj * 128; const float* qp_ = scp + (size_t)grp * (NMOD * DM) + col0 + bj * 128;
                const f32x4 p0 = *(const f32x4*)pp_ * (*(const f32x4*)qp_ + 1.f), p1 = *(const f32x4*)(pp_ + 4) * (*(const f32x4*)(qp_ + 4) + 1.f);
                i0 = (f32x4){rcpf_(p0[0]), rcpf_(p0[1]), rcpf_(p0[2]), rcpf_(p0[3])}; i1 = (f32x4){rcpf_(p1[0]), rcpf_(p1[1]), rcpf_(p1[2]), rcpf_(p1[3])}; }
#pragma unroll
            for (int ai = 0; ai < 2; ++ai) {
                u32x4 rr[4];
#pragma unroll
                for (int m = 0; m < 4; ++m) rr[m] = *(const u32x4*)(Un + (size_t)(row0 + ai * 128 + m * 16) * DM + col0 + bj * 128);
                __builtin_amdgcn_sched_barrier(0);
#pragma unroll
                for (int m = 0; m < 4; ++m) {
                    const size_t off = (size_t)(row0 + ai * 128 + m * 16) * DM + col0 + bj * 128;
                    const u32x4 r = rr[m];
                    f32x4 h0 = (f32x4){bf2f(r.x & 0xffffu), __builtin_bit_cast(float, r.x & 0xffff0000u), bf2f(r.y & 0xffffu), __builtin_bit_cast(float, r.y & 0xffff0000u)};
                    f32x4 h1 = (f32x4){bf2f(r.z & 0xffffu), __builtin_bit_cast(float, r.z & 0xffff0000u), bf2f(r.w & 0xffffu), __builtin_bit_cast(float, r.w & 0xffff0000u)};
                    h0 = h0 * i0 + g0 * acc[ai][bj][m][0]; h1 = h1 * i1 + g1 * acc[ai][bj][m][1];
                    sq[ai][m] += ((h0[0] * h0[0] + h0[1] * h0[1]) + (h0[2] * h0[2] + h0[3] * h0[3])) + ((h1[0] * h1[0] + h1[1] * h1[1]) + (h1[2] * h1[2] + h1[3] * h1[3]));
                    asm volatile("" : "+v"(sq[ai][m]));
                    const f32x4 u0 = h0 * s0, u1 = h1 * s1;
                    u32x4 w; w.x = pk2(u0[0], u0[1]); w.y = pk2(u0[2], u0[3]); w.z = pk2(u1[0], u1[1]); w.w = pk2(u1[2], u1[3]);
                    *(u32x4*)(Un + off) = w;
                }
                __builtin_amdgcn_sched_barrier(0);
            }
        }
        if (Un) {
#pragma unroll
            for (int ai = 0; ai < 2; ++ai)
#pragma unroll
                for (int m = 0; m < 4; ++m) { float t = sq[ai][m]; t += shx(t, 16, fq * 16 + fr); t += shx(t, 32, fq * 16 + fr);
                    if (fq == 0) ssn[(size_t)(row0 + ai * 128 + m * 16) * 16 + u.pn * 4 + wc] = t; }
        }
    }
};

struct DownOrder {
    pg8::StaticOrder so; pg8::SplitKOrder sk; int nlat, nctx, inv;
    __device__ bool next(int i, pg8::Unit& u) const {
        const int L = i * so.G + so.c;
        if (L < nlat) return so.next(i, u);
        const int Lc = L - nlat; if (Lc >= nctx) return false;
        const int tile = (Lc * inv) >> 16, ks = Lc - tile * sk.nsplit;
        u.pm = sk.pm0 + (tile >> 2); u.pn = tile & 3; u.kb = ks * 256; u.nk = 4; return true;
    }
    __device__ __forceinline__ void a_ready(const pg8::Unit&) const {}
    __device__ __forceinline__ void done(const pg8::Unit&) const {}
};

__device__ __forceinline__ void transpose_item(const float* __restrict__ W, int K, int ldn, bf16_t* __restrict__ WT, int drow, int k0, int n0, LAS float* scr, int lane) {
    float wv[32];
#pragma unroll
    for (int i = 0; i < 32; ++i) { const int kk = 2 * i + (lane >> 5); wv[i] = W[(size_t)(k0 + kk) * ldn + n0 + (lane & 31)]; }
#pragma unroll
    for (int i = 0; i < 32; ++i) { const int kk = 2 * i + (lane >> 5); scr[kk * 33 + (lane & 31)] = wv[i]; }
    WAVE_SYNC();
    const int c = lane & 7;
#pragma unroll
    for (int j = 0; j < 4; ++j) { const int n = (lane >> 3) + 8 * j; const LAS float* s = scr + (8 * c) * 33 + n;
        u32x4 o; o.x = pk2(s[0 * 33], s[1 * 33]); o.y = pk2(s[2 * 33], s[3 * 33]); o.z = pk2(s[4 * 33], s[5 * 33]); o.w = pk2(s[6 * 33], s[7 * 33]);
        *(u32x4*)(WT + (size_t)(drow + n0 + n) * K + k0 + 8 * c) = o; }
    WAVE_SYNC();
}

__device__ __forceinline__ void convert_weights(PREF p, int l, LAS unsigned char* lds, int gw, int NGW, int wave, int lane) {
    LAS float* scr = (LAS float*)(lds + wave * 16384);
    unsigned char* ws = p.ws;
    bf16_t* W13 = (bf16_t*)(ws + WS_W13); bf16_t* W2 = (bf16_t*)(ws + WS_W2); bf16_t* WIN = (bf16_t*)(ws + WS_WIN); bf16_t* WOUT = (bf16_t*)(ws + WS_WOUT);
    constexpr int I_UP = 16 * 88, I_DN = 44 * 32, I_IN = 16 * 81, I_OUT = 16 * 32;
    constexpr int NIT = 4 * I_UP + 2 * I_DN + I_IN + I_OUT;
    for (int it = gw; it < NIT; it += NGW) {
        int r = it;
        if (r < 4 * I_UP) { const int seg = r / I_UP; r -= seg * I_UP; const int f = seg >> 1, is3 = seg & 1;
            const int kb = r / 88, nb = r % 88, n0 = nb * 32;
            const float* W = (is3 ? p.ffn_w3 : p.ffn_w1) + (size_t)(l * 2 + f) * DM * DFF;
            transpose_item(W, DM, DFF, W13 + (size_t)f * 5632 * DM, (n0 >> 7) * 256 + (n0 & 127) + is3 * 128 - n0, kb * 64, n0, scr, lane); continue; }
        r -= 4 * I_UP;
        if (r < 2 * I_DN) { const int f = r / I_DN; r -= f * I_DN; const int kb = r / 32, nb = r % 32;
            transpose_item(p.ffn_w2 + (size_t)(l * 2 + f) * DFF * DM, DFF, DM, W2 + (size_t)f * DM * DFF, 0, kb * 64, nb * 32, scr, lane); continue; }
        r -= 2 * I_DN;
        if (r < I_IN) { const int kb = r / 81, nb = r % 81;
            transpose_item(p.w_in + (size_t)l * DM * 2592, DM, 2592, WIN, 0, kb * 64, nb * 32, scr, lane); continue; }
        r -= I_IN;
        { const int kb = r / 32, nb = r % 32; transpose_item(p.w_out + (size_t)l * DM * DM, DM, DM, WOUT, 0, kb * 64, nb * 32, scr, lane); }
    }
}

__device__ __forceinline__ void phase_mods(PREF p, LAS unsigned char* lds, int tid, int wave, int lane) {
    LAS float* sS = (LAS float*)lds;
    LAS float* red = (LAS float*)(lds + 12288);
    float* mod = (float*)(p.ws + WS_MOD);
    for (int i = tid; i < 3072; i += NTHREADS) { const int g = i >> 10, k = i & 1023; const float xv = g < 2 ? p.c[g * 1024 + k] : p.c_ctx[k]; sS[i] = silu_f(xv); }
    __syncthreads();
    for (int item = blockIdx.x; item < NLAYER * 144; item += gridDim.x) {
        const int l = item / 144, nc = item % 144;
        const float* W = p.w_mod + (size_t)l * DM * (NMOD * DM) + nc * 64 + lane;
        float a0 = 0.f, a1 = 0.f, a2 = 0.f; const int k0 = wave * 128;
#pragma unroll 16
        for (int kk = 0; kk < 128; ++kk) { const int k = k0 + kk; const float w = W[(size_t)k * (NMOD * DM)]; a0 += sS[k] * w; a1 += sS[1024 + k] * w; a2 += sS[2048 + k] * w; }
        red[(wave * 3 + 0) * 64 + lane] = a0; red[(wave * 3 + 1) * 64 + lane] = a1; red[(wave * 3 + 2) * 64 + lane] = a2;
        __syncthreads();
        if (wave < 3) { float s = p.b_mod[l * (NMOD * DM) + nc * 64 + lane];
#pragma unroll
            for (int w = 0; w < 8; ++w) s += red[(w * 3 + wave) * 64 + lane];
            mod[(size_t)(l * 3 + wave) * (NMOD * DM) + nc * 64 + lane] = s; }
        __syncthreads();
    }
}

__device__ __forceinline__ void phase_gatew(PREF p, int gtid, int gthreads) {
    bf16_t* WgT = (bf16_t*)(p.ws + WS_WG);
    for (int e = gtid; e < NLAYER * 2 * 2 * 8 * 4096; e += gthreads) {
        const int i = e & 63, j = (e >> 6) & 63, h = (e >> 12) & 7, ty = (e >> 15) & 1, d = (e >> 16) & 1, l = e >> 17;
        const float* src = ty ? p.rg_wi : p.rg_wa;
        WgT[e] = (bf16_t)f2bf(src[(size_t)((l * 2 + d) * 8 + h) * 4096 + i * 64 + j]);
    }
}

__device__ __forceinline__ void phase_norm(PREF p, int l, int jn, int rbeg, int rend, bool first, int nsplit, int gw, int NGW, int lane) {
    const float* mod = (const float*)(p.ws + WS_MOD); const float* hctx = (const float*)(p.ws + WS_HCTX); bf16_t* U = (bf16_t*)(p.ws + WS_U); float* SS = (float*)(p.ws + WS_SS);
    const float* ng = p.norm_g + (size_t)(l * 3 + jn) * DM;
    for (int row = rbeg + gw; row < rend; row += NGW) {
        const float* src = row < TL ? ((first ? p.x : p.out) + (size_t)row * DM) : ((first ? p.ctx : hctx) + (size_t)(row - TL) * DM);
        const float* mb = mod + (size_t)(l * 3 + (row >> 14)) * (NMOD * DM);
        f32x4 v[4]; float ss = 0.f;
#pragma unroll
        for (int j = 0; j < 4; ++j) v[j] = *(const f32x4*)(src + 4 * lane + 256 * j);
        if (row >= TL && nsplit > 0) {
            const float* pr = (const float*)(p.ws + WS_PART) + (size_t)(row - TL) * DM + 4 * lane;
            for (int k = 0; k < nsplit; ++k)
#pragma unroll
                for (int j = 0; j < 4; ++j) v[j] += *(const f32x4*)(pr + (size_t)k * (TC * DM) + 256 * j);
            float* dst = (float*)(p.ws + WS_HCTX) + (size_t)(row - TL) * DM + 4 * lane;
#pragma unroll
            for (int j = 0; j < 4; ++j) *(f32x4*)(dst + 256 * j) = v[j];
        }
#pragma unroll
        for (int j = 0; j < 4; ++j) ss += (v[j][0] * v[j][0] + v[j][1] * v[j][1]) + (v[j][2] * v[j][2] + v[j][3] * v[j][3]);
        ss = wave_sum(ss, lane);
        if (lane == 0) ((float*)(p.ws + WS_RS))[row] = __builtin_amdgcn_rsqf(ss * (1.f / DM) + 1e-6f);
#pragma unroll
        for (int j = 0; j < 4; ++j) { const int col = 4 * lane + 256 * j;
            const f32x4 g = *(const f32x4*)(ng + col), sc = *(const f32x4*)(mb + (3 * jn + 1) * DM + col);
            const f32x4 o = v[j] * g * (sc + 1.f);
            u32x2 w; w.x = pk2(o[0], o[1]); w.y = pk2(o[2], o[3]);
            *(u32x2*)(U + (size_t)row * DM + col) = w; }
    }
}
__device__ __forceinline__ void phase_rs(PREF p, int gtid, int gthreads) {
    const float* SS = (const float*)(p.ws + WS_SS); float* RS = (float*)(p.ws + WS_RS);
    for (int row = gtid; row < TL; row += gthreads) {
        const f32x4 a = *(const f32x4*)(SS + (size_t)row * 16), b = *(const f32x4*)(SS + (size_t)row * 16 + 4), c = *(const f32x4*)(SS + (size_t)row * 16 + 8), d = *(const f32x4*)(SS + (size_t)row * 16 + 12);
        const float t = (((a[0] + a[1]) + (a[2] + a[3])) + ((b[0] + b[1]) + (b[2] + b[3]))) + (((c[0] + c[1]) + (c[2] + c[3])) + ((d[0] + d[1]) + (d[2] + d[3])));
        RS[row] = __builtin_amdgcn_rsqf(t * (1.f / DM) + 1e-6f);
    }
}
__device__ __forceinline__ void phase_bias(PREF p, int l, LAS unsigned char* lds, int tid, int wave, int lane) {
    LAS float* sS = (LAS float*)lds;
    LAS float* red = (LAS float*)(lds + 12288);
    const float* mod = (const float*)(p.ws + WS_MOD); float* BIAS = (float*)(p.ws + WS_BIAS);
    for (int item = blockIdx.x; item < 217; item += gridDim.x) {
        int mi, nc;
        if (item < 44) { mi = 0; nc = item; } else if (item < 88) { mi = 1; nc = item - 44; } else if (item < 129) { mi = 2; nc = item - 88; } else if (item < 173) { mi = 3; nc = item - 129; } else { mi = 4; nc = item - 173; }
        const int jn = mi < 2 ? 0 : (mi == 2 ? 1 : 2), slot = jn, boff = (mi == 1 || mi == 4) ? 2816 : 0, f = mi >= 3 ? 1 : 0;
        const int ldn = mi == 2 ? 2592 : DFF;
        const float* Wm = mi == 2 ? p.w_in + (size_t)l * DM * 2592 : ((mi == 1 || mi == 4) ? p.ffn_w3 : p.ffn_w1) + (size_t)(l * 2 + f) * DM * DFF;
        for (int i = tid; i < 3072; i += NTHREADS) { const int g = i >> 10, k = i & 1023; sS[i] = mod[(size_t)(l * 3 + g) * (NMOD * DM) + (3 * jn) * DM + k]; }
        __syncthreads();
        const int n = nc * 64 + lane; const bool nv = n < ldn;
        const float* W = Wm + (nv ? n : 0);
        float a0 = 0.f, a1 = 0.f, a2 = 0.f; const int k0 = wave * 128;
#pragma unroll 16
        for (int kk = 0; kk < 128; ++kk) { const int k = k0 + kk; const float w = W[(size_t)k * ldn]; a0 += sS[k] * w; a1 += sS[1024 + k] * w; a2 += sS[2048 + k] * w; }
        red[(wave * 3 + 0) * 64 + lane] = a0; red[(wave * 3 + 1) * 64 + lane] = a1; red[(wave * 3 + 2) * 64 + lane] = a2;
        __syncthreads();
        if (wave < 3 && nv) { float sum = 0.f;
#pragma unroll
            for (int w = 0; w < 8; ++w) sum += red[(w * 3 + wave) * 64 + lane];
            BIAS[(size_t)(slot * 3 + wave) * 5632 + boff + n] = sum; }
        __syncthreads();
    }
}
__device__ __forceinline__ void phase_final(PREF p, int gw, int NGW, int lane) {
    const bf16_t* U = (const bf16_t*)(p.ws + WS_U); const float* SS = (const float*)(p.ws + WS_SS);
    for (int row = gw; row < TL; row += NGW) {
        const f32x4 a = *(const f32x4*)(SS + (size_t)row * 16), b = *(const f32x4*)(SS + (size_t)row * 16 + 4), c = *(const f32x4*)(SS + (size_t)row * 16 + 8), d = *(const f32x4*)(SS + (size_t)row * 16 + 12);
        const float t = (((a[0] + a[1]) + (a[2] + a[3])) + ((b[0] + b[1]) + (b[2] + b[3]))) + (((c[0] + c[1]) + (c[2] + c[3])) + ((d[0] + d[1]) + (d[2] + d[3])));
        const float rs = __builtin_amdgcn_rsqf(t * (1.f / DM) + 1e-6f);
        u32x2 w[4];
#pragma unroll
        for (int j = 0; j < 4; ++j) w[j] = *(const u32x2*)(U + (size_t)row * DM + 4 * lane + 256 * j);
#pragma unroll
        for (int j = 0; j < 4; ++j) { f32x4 v; v[0] = bf2f(w[j].x & 0xffffu); v[1] = __builtin_bit_cast(float, w[j].x & 0xffff0000u); v[2] = bf2f(w[j].y & 0xffffu); v[3] = __builtin_bit_cast(float, w[j].y & 0xffff0000u);
            *(f32x4*)(p.out + (size_t)row * DM + 4 * lane + 256 * j) = v * rs; }
    }
}

__device__ __forceinline__ int scan_order(int d, int step) { return d == 0 ? step : (step < 4 ? 3 - step : 263 - step); }

template <bool FINAL, int D>
__device__ __forceinline__ void rg_dir(PREF p, int l, int h, int ch, int sidx, int rowbase  , LAS bf16_t* sXc, LAS float* stg, int lane) {
    const bf16_t* __restrict__ P = (const bf16_t*)(p.ws + WS_GP); const bf16_t* __restrict__ WgT = (const bf16_t*)(p.ws + WS_WG);
    float* __restrict__ RGA = (float*)(p.ws + WS_RGA); float* __restrict__ RGH = (float*)(p.ws + WS_RGH); const float* __restrict__ RGC = (const float*)(p.ws + WS_RGC);
    bf16_t* __restrict__ MIX = (bf16_t*)(p.ws + WS_MIX);
    bf16_t* __restrict__ TMP = (bf16_t*)(p.ws + WS_HB);
    const bf16_t* wr_ = WgT + (size_t)(((l * 2 + D) * 2 + 0) * 8 + h) * 4096; const bf16_t* wi_ = WgT + (size_t)(((l * 2 + D) * 2 + 1) * 8 + h) * 4096;
    const float ba = p.rg_ba[(l * 2 + D) * 512 + ch], bi = p.rg_bi[(l * 2 + D) * 512 + ch], lam = p.rg_lam[(l * 2 + D) * 512 + ch];
    const float e_ = __expf(-lam), u_ = 1.f + e_;
    const float l1p = (u_ == 1.f) ? e_ : __logf(u_) * e_ * rcpf_(u_ - 1.f);
    const float sp8 = -8.f * 1.4426950408889634f * l1p;
    float hc = FINAL ? RGC[sidx] : 0.f, Ap = 1.f;
    bf16x8 Br[4][2], Bi[4][2];
#pragma unroll
    for (int nt = 0; nt < 4; ++nt) { const int o0 = (nt * 16 + (lane & 15)) * 64 + (lane >> 4) * 8;
        Br[nt][0] = *(const bf16x8*)(wr_ + o0); Br[nt][1] = *(const bf16x8*)(wr_ + o0 + 32); Bi[nt][0] = *(const bf16x8*)(wi_ + o0); Bi[nt][1] = *(const bf16x8*)(wi_ + o0 + 32); }
    if (FINAL && D == 1) asm volatile("s_waitcnt vmcnt(0)" ::: "memory");
#pragma unroll 1
    for (int mi = 0; mi < 4; ++mi) { const int mt = D ? 3 - mi : mi;
        float grv[16], hfv[16];
        if (FINAL && D == 1) {
#pragma unroll
            for (int ti = 0; ti < 16; ++ti) { const size_t row = (size_t)(rowbase + mt * 16 + 15 - ti); grv[ti] = __builtin_bit_cast(float, (unsigned)P[row * PW + 512 + ch]); hfv[ti] = __builtin_bit_cast(float, (unsigned)TMP[row * 512 + ch]); }
            __builtin_amdgcn_sched_barrier(0);
#pragma unroll
            for (int ti = 0; ti < 16; ++ti) { grv[ti] = bf2f(__builtin_bit_cast(unsigned, grv[ti])); hfv[ti] = bf2f(__builtin_bit_cast(unsigned, hfv[ti])); }
        }
        const bf16x8 A0 = *(const LAS bf16x8*)(sXc + (mt * 16 + (lane & 15)) * 72 + (lane >> 4) * 8), A1 = *(const LAS bf16x8*)(sXc + (mt * 16 + (lane & 15)) * 72 + 32 + (lane >> 4) * 8);
        f32x4 ar[4], ai[4];
#pragma unroll
        for (int nt = 0; nt < 4; ++nt) { const f32x4 z = {0.f, 0.f, 0.f, 0.f};
            ar[nt] = mfma16(A0, Br[nt][0], z); ar[nt] = mfma16(A1, Br[nt][1], ar[nt]); ai[nt] = mfma16(A0, Bi[nt][0], z); ai[nt] = mfma16(A1, Bi[nt][1], ai[nt]); }
        WAVE_SYNC();
#pragma unroll
        for (int nt = 0; nt < 4; ++nt)
#pragma unroll
            for (int j = 0; j < 4; ++j) { const int o = ((lane >> 4) * 4 + j) * 64 + nt * 16 + (lane & 15); stg[o] = ar[nt][j]; stg[1024 + o] = ai[nt][j]; }
        WAVE_SYNC();
        float av[16], iv[16];
#pragma unroll
        for (int ti = 0; ti < 16; ++ti) { const int tk = D ? 15 - ti : ti;
            const float zr = stg[tk * 64 + lane] + ba, zi = stg[1024 + tk * 64 + lane] + bi;
            const float r = sigmoid_f(zr), ig = sigmoid_f(zi);
            const float a = __builtin_amdgcn_exp2f(r * sp8);
            const float xc = bf2f(sXc[(mt * 16 + tk) * 72 + lane]);
            av[ti] = a; iv[ti] = __builtin_amdgcn_sqrtf(fmaxf(1.f - a * a, 0.f)) * ig * xc;
            if (FINAL && D == 1) grv[ti] = gelu_tanh_f(grv[ti]);
        }
#pragma unroll
        for (int ti = 0; ti < 16; ++ti) { const int tk = D ? 15 - ti : ti;
            hc = av[ti] * hc + iv[ti]; Ap *= av[ti];
            if (FINAL) { const size_t row = (size_t)(rowbase + mt * 16 + tk);
                if (D == 0) TMP[row * 512 + ch] = (bf16_t)f2bf(hc);
                else MIX[row * DM + ch] = (bf16_t)f2bf(grv[ti] * (hfv[ti] + hc)); }
        }
    }
    if (!FINAL) { RGA[sidx] = Ap; RGH[sidx] = hc; }
}

template <bool FINAL>
__device__ __forceinline__ void rg_item(PREF p, int l, int item, LAS unsigned char* wl, int lane) {
    const bf16_t* __restrict__ P = (const bf16_t*)(p.ws + WS_GP);
    const int h = item & 7, rest = item >> 3;
    const int ci = rest < 512 ? 4 + (rest & 255) : ((rest - 512) & 3), b = rest < 512 ? (rest >> 8) : ((rest - 512) >> 2);
    const int seq_row0 = ci < 4 ? TL + b * 256 : b * 16384;
    const int t0 = ci < 4 ? ci * 64 : (ci - 4) * 64;
    const int seqlen = ci < 4 ? 256 : 16384;
    const int ch = h * 64 + lane;
    LAS bf16_t* sXc = (LAS bf16_t*)wl;
    LAS float* stg = (LAS float*)(wl + 9216);
    {
        const float cw0 = p.conv_w[(l * 4 + 0) * 512 + ch], cw1 = p.conv_w[(l * 4 + 1) * 512 + ch], cw2 = p.conv_w[(l * 4 + 2) * 512 + ch], cw3 = p.conv_w[(l * 4 + 3) * 512 + ch];
        const float cb = p.conv_b[l * 512 + ch];
        float xv[67]; unsigned xr_[67];
#pragma unroll
        for (int i = 0; i < 67; ++i) { const int t = t0 - 2 + i; const int tc = t < 0 ? 0 : (t >= seqlen ? seqlen - 1 : t);
            xr_[i] = P[(size_t)(seq_row0 + tc) * PW + ch]; }
        __builtin_amdgcn_sched_barrier(0);
#pragma unroll
        for (int i = 0; i < 67; ++i) { const int t = t0 - 2 + i; const int tc = t < 0 ? 0 : (t >= seqlen ? seqlen - 1 : t); xv[i] = (t == tc) ? bf2f(xr_[i]) : 0.f; }
#pragma unroll
        for (int tt = 0; tt < 64; ++tt) { const float xc = xv[tt] * cw0 + xv[tt + 1] * cw1 + xv[tt + 2] * cw2 + xv[tt + 3] * cw3 + cb; sXc[tt * 72 + lane] = (bf16_t)f2bf(xc); }
    }
    WAVE_SYNC();
    const int sidx0 = ((b * NCH + ci) * 2) * 512 + ch;
    rg_dir<FINAL, 0>(p, l, h, ch, sidx0, seq_row0 + t0, sXc, stg, lane);
    rg_dir<FINAL, 1>(p, l, h, ch, sidx0 + 512, seq_row0 + t0, sXc, stg, lane);
    WAVE_SYNC();
}

__device__ __forceinline__ void rg_carry(PREF p, int wave, int lane) {
    if (wave != 0 || blockIdx.x < 128 || blockIdx.x >= 160) return;
    const int gtid = ((int)blockIdx.x - 128) * 64 + lane;
    const float* __restrict__ RGA = (const float*)(p.ws + WS_RGA); const float* __restrict__ RGH = (const float*)(p.ws + WS_RGH); float* __restrict__ RGC = (float*)(p.ws + WS_RGC);
    const int b = gtid >> 10, d = (gtid >> 9) & 1, ch = gtid & 511;
    float h = 0.f;
    for (int s0 = 0; s0 < NCH; s0 += 26) {
        float av[26], hv[26];
#pragma unroll
        for (int k = 0; k < 26; ++k) { const int idx = ((b * NCH + scan_order(d, s0 + k)) * 2 + d) * 512 + ch; av[k] = RGA[idx]; hv[k] = RGH[idx]; }
#pragma unroll
        for (int k = 0; k < 26; ++k) { const int idx = ((b * NCH + scan_order(d, s0 + k)) * 2 + d) * 512 + ch; RGC[idx] = h; h = av[k] * h + hv[k]; }
    }
}

__device__ __forceinline__ void gla_rows(int b, int cj, int& row0, int& rstride) {
    if (cj < 4) { row0 = TL + b * 256 + cj * 64; rstride = 1; }
    else { const int q = cj - 4; row0 = b * 16384 + ((q & 3) * 64) * 64 + (q >> 2); rstride = 64; }
}

__device__ __forceinline__ void gl1_item(PREF p, int l, int item, bool valid, LAS unsigned char* pl, int sw, int lane) {
    const bf16_t* __restrict__ P = (const bf16_t*)(p.ws + WS_GP); bf16_t* __restrict__ QK = (bf16_t*)(p.ws + WS_QK);
    float* __restrict__ GLS = (float*)(p.ws + WS_GLS); float* __restrict__ GLD = (float*)(p.ws + WS_GLD);
    LAS bf16_t* sVt = (LAS bf16_t*)pl;
    LAS bf16_t* sKt = (LAS bf16_t*)(pl + 18432 + sw * 9216);
    LAS float* sD = (LAS float*)(pl + 36864 + sw * 256);
    const int d = sw;
    const int h = item & 3, rest = item >> 2;
    const int cj = rest < 512 ? 4 + (rest & 255) : ((rest - 512) & 3), b = rest < 512 ? (rest >> 8) : ((rest - 512) >> 2);
    int row0, rstride; gla_rows(b, cj, row0, rstride);
    const int seq = (b * 4 + h) * 2 + d;
    if (valid) {
        const bf16_t* prl = P + (size_t)(row0 + lane * rstride) * PW + 2560 + d * 16;
        const u32x4 lra = *(const u32x4*)prl, lrb = *(const u32x4*)(prl + 8);
        unsigned lrp[8] = {lra.x, lra.y, lra.z, lra.w, lrb.x, lrb.y, lrb.z, lrb.w};
        float qc[16], kc[16];
#pragma unroll
        for (int ss = 0; ss < 16; ++ss) { const int i = d ? 63 - ss : ss; const bf16_t* pr = P + (size_t)(row0 + i * rstride) * PW + h * 64 + lane;
            qc[ss] = __builtin_bit_cast(float, (unsigned)pr[1024]); kc[ss] = __builtin_bit_cast(float, (unsigned)pr[1280]); }
        __builtin_amdgcn_sched_barrier(0);
#pragma unroll
        for (int ss = 0; ss < 16; ++ss) { qc[ss] = bf2f(__builtin_bit_cast(unsigned, qc[ss])); kc[ss] = bf2f(__builtin_bit_cast(unsigned, kc[ss])); }
        unsigned wupp[8];
#pragma unroll
        for (int r2 = 0; r2 < 8; ++r2) wupp[r2] = pk2(p.gla_wup[(size_t)((l * 2 + d) * 16 + 2 * r2) * 256 + h * 64 + lane], p.gla_wup[(size_t)((l * 2 + d) * 16 + 2 * r2 + 1) * 256 + h * 64 + lane]);
        const float bup = p.gla_bup[(l * 2 + d) * 256 + h * 64 + lane];
#pragma unroll 1
        for (int g2 = 0; g2 < 2; ++g2) {
            unsigned vr[16];
#pragma unroll
            for (int ii = 0; ii < 16; ++ii) { const int i = 32 * sw + g2 * 16 + ii; vr[ii] = *(const unsigned*)(P + (size_t)(row0 + i * rstride) * PW + 1536 + h * 128 + 2 * lane); }
#pragma unroll
            for (int ii = 0; ii < 16; ++ii) { const int i = 32 * sw + g2 * 16 + ii; sVt[(2 * lane) * 72 + i] = (bf16_t)(vr[ii] & 0xffffu); sVt[(2 * lane + 1) * 72 + i] = (bf16_t)(vr[ii] >> 16); }
        }
        float bc = 0.f;
#pragma unroll 1
        for (int g4 = 0; g4 < 4; ++g4) {
            float qn[16], kn[16];
            if (g4 < 3) {
#pragma unroll
                for (int ss = 0; ss < 16; ++ss) { const int s = (g4 + 1) * 16 + ss; const int i = d ? 63 - s : s; const bf16_t* pr = P + (size_t)(row0 + i * rstride) * PW + h * 64 + lane;
                    qn[ss] = __builtin_bit_cast(float, (unsigned)pr[1024]); kn[ss] = __builtin_bit_cast(float, (unsigned)pr[1280]); }
                __builtin_amdgcn_sched_barrier(0);
            }
            float gv[16];
#pragma unroll
            for (int ss = 0; ss < 16; ++ss) { const int s = g4 * 16 + ss; const int i = d ? 63 - s : s;
                float z = bup;
#pragma unroll
                for (int r2 = 0; r2 < 8; ++r2) { const unsigned w = (unsigned)__builtin_amdgcn_readlane((int)lrp[r2], i);
                    z = __builtin_amdgcn_fdot2_f32_bf16(__builtin_bit_cast(bf16x2_t, w), __builtin_bit_cast(bf16x2_t, wupp[r2]), z, false); }
                gv[ss] = -(fmaxf(-z, 0.f) + __logf(1.f + __expf(-fabsf(z)))) * (1.f / 16.f);
                __builtin_amdgcn_sched_barrier(0);
            }
#pragma unroll
            for (int ss = 0; ss < 16; ++ss) { const int s = g4 * 16 + ss; const int i = d ? 63 - s : s; const size_t rowi = (size_t)(row0 + i * rstride);
                bc += gv[ss];
                const float en = __expf(-bc), ep = __expf(bc);
                const float kt = kc[ss] * en, qt = qc[ss] * 0.125f * ep;
                const unsigned ktb = f2bf(kt);
                sKt[lane * 72 + i] = (bf16_t)ktb;
                QK[rowi * 1024 + d * 512 + h * 64 + lane] = (bf16_t)f2bf(qt);
                QK[rowi * 1024 + d * 512 + 256 + h * 64 + lane] = (bf16_t)ktb;
            }
#pragma unroll
            for (int ss = 0; ss < 16; ++ss) { qc[ss] = bf2f(__builtin_bit_cast(unsigned, qn[ss])); kc[ss] = bf2f(__builtin_bit_cast(unsigned, kn[ss])); }
        }
        const float Dv = __expf(bc);
        sD[lane] = Dv; GLD[(size_t)(seq * NCH + cj) * 64 + lane] = Dv;
    }
    __syncthreads();
    if (valid) {
        bf16x8 Ak[4][2]; f32x4 Dm[4];
#pragma unroll
        for (int mt = 0; mt < 4; ++mt) { Dm[mt] = *(const LAS f32x4*)(sD + mt * 16 + (lane >> 4) * 4);
#pragma unroll
            for (int ks = 0; ks < 2; ++ks) Ak[mt][ks] = *(const LAS bf16x8*)(sKt + (mt * 16 + (lane & 15)) * 72 + ks * 32 + (lane >> 4) * 8); }
        bf16_t* So = (bf16_t*)GLS + (size_t)(seq * NCH + cj) * 8192;
#pragma unroll 2
        for (int nt = 0; nt < 8; ++nt) {
            const bf16x8 B0 = *(const LAS bf16x8*)(sVt + (nt * 16 + (lane & 15)) * 72 + (lane >> 4) * 8), B1 = *(const LAS bf16x8*)(sVt + (nt * 16 + (lane & 15)) * 72 + 32 + (lane >> 4) * 8);
#pragma unroll
            for (int mt = 0; mt < 4; ++mt) { f32x4 acc = {0.f, 0.f, 0.f, 0.f}; acc = mfma16(Ak[mt][0], B0, acc); acc = mfma16(Ak[mt][1], B1, acc);
                acc = acc * Dm[mt];
                u32x2 w; w.x = pk2(acc[0], acc[1]); w.y = pk2(acc[2], acc[3]);
                *(u32x2*)(So + (nt * 16 + (lane & 15)) * 64 + mt * 16 + (lane >> 4) * 4) = w; }
        }
    }
    __syncthreads();
}

__device__ __forceinline__ void gl2_scan(PREF p, int gtid, int gthreads) {
    unsigned* __restrict__ GLS = (unsigned*)(p.ws + WS_GLS); const float* __restrict__ GLD = (const float*)(p.ws + WS_GLD);
    for (int g = gtid; g < 16 * 4096; g += gthreads) {
        const int seq = g >> 12, e2 = g & 4095, kk = (e2 * 2) & 63, d = seq & 1;
        float S0 = 0.f, S1 = 0.f;
        for (int s0 = 0; s0 < NCH; s0 += 20) {
            unsigned dv[20]; float D0[20], D1[20];
#pragma unroll
            for (int k = 0; k < 20; ++k) { const int cj = scan_order(d, s0 + k); dv[k] = GLS[(size_t)(seq * NCH + cj) * 4096 + e2];
                const float* dp = GLD + (size_t)(seq * NCH + cj) * 64 + kk; D0[k] = dp[0]; D1[k] = dp[1]; }
#pragma unroll
            for (int k = 0; k < 20; ++k) { const int cj = scan_order(d, s0 + k); GLS[(size_t)(seq * NCH + cj) * 4096 + e2] = pk2(S0, S1);
                S0 = D0[k] * S0 + bf2f(dv[k] & 0xffffu); S1 = D1[k] * S1 + __builtin_bit_cast(float, dv[k] & 0xffff0000u); }
        }
    }
}

__device__ __forceinline__ void gl3_item(PREF p, int l, int item, bool valid, LAS unsigned char* sl, int w4, int t256, int lane) {
    const bf16_t* __restrict__ P = (const bf16_t*)(p.ws + WS_GP); const bf16_t* __restrict__ QK = (const bf16_t*)(p.ws + WS_QK);
    const float* __restrict__ GLS = (const float*)(p.ws + WS_GLS); bf16_t* __restrict__ MIX = (bf16_t*)(p.ws + WS_MIX);
    LAS bf16_t* sVt = (LAS bf16_t*)sl;
    LAS bf16_t* sS = (LAS bf16_t*)(sl + 18432);
    LAS bf16_t* sAtt = (LAS bf16_t*)(sl + 55296);
    const int h = item & 3, rest = item >> 2;
    const int cj = rest < 512 ? 4 + (rest & 255) : ((rest - 512) & 3), b = rest < 512 ? (rest >> 8) : ((rest - 512) >> 2);
    int row0, rstride; gla_rows(b, cj, row0, rstride);
    f32x4 o[8];
#pragma unroll
    for (int nt = 0; nt < 8; ++nt) o[nt] = (f32x4){0.f, 0.f, 0.f, 0.f};
    bf16x8 Aq[2][2], Bk[4][2];
    const size_t rowi_a = (size_t)(row0 + (16 * w4 + (lane & 15)) * rstride);
    if (valid) {
        unsigned vr[16]; u32x4 sv[2][4];
#pragma unroll
        for (int ii = 0; ii < 16; ++ii) { const int i = 16 * w4 + ii; vr[ii] = *(const unsigned*)(P + (size_t)(row0 + i * rstride) * PW + 1536 + h * 128 + 2 * lane); }
#pragma unroll
        for (int d = 0; d < 2; ++d) { const bf16_t* Sg = (const bf16_t*)GLS + (size_t)(((b * 4 + h) * 2 + d) * NCH + cj) * 8192;
#pragma unroll
            for (int r = 0; r < 4; ++r) sv[d][r] = *(const u32x4*)(Sg + (r * 256 + t256) * 8); }
#pragma unroll
        for (int d = 0; d < 2; ++d)
#pragma unroll
            for (int ks = 0; ks < 2; ++ks) Aq[d][ks] = *(const bf16x8*)(QK + rowi_a * 1024 + d * 512 + h * 64 + ks * 32 + (lane >> 4) * 8);
#pragma unroll
        for (int nt = 0; nt < 4; ++nt) { const size_t rows = (size_t)(row0 + (nt * 16 + (lane & 15)) * rstride);
#pragma unroll
            for (int ks = 0; ks < 2; ++ks) Bk[nt][ks] = *(const bf16x8*)(QK + rows * 1024 + 256 + h * 64 + ks * 32 + (lane >> 4) * 8); }
#pragma unroll
        for (int ii = 0; ii < 16; ++ii) { const int i = 16 * w4 + ii; sVt[(2 * lane) * 72 + i] = (bf16_t)(vr[ii] & 0xffffu); sVt[(2 * lane + 1) * 72 + i] = (bf16_t)(vr[ii] >> 16); }
#pragma unroll
        for (int d = 0; d < 2; ++d)
#pragma unroll
            for (int r = 0; r < 4; ++r) { const int e = (r * 256 + t256) * 8; *(LAS u32x4*)(sS + d * 9216 + (e >> 6) * 72 + (e & 63)) = sv[d][r]; }
    }
    __syncthreads();
    if (valid) {
#pragma unroll
        for (int d = 0; d < 2; ++d) {
            f32x4 att[4];
#pragma unroll
            for (int nt = 0; nt < 4; ++nt) { att[nt] = (f32x4){0.f, 0.f, 0.f, 0.f};
#pragma unroll
                for (int ks = 0; ks < 2; ++ks) att[nt] = mfma16(Aq[d][ks], Bk[nt][ks], att[nt]); }
            if (d == 0) {
#pragma unroll
                for (int nt = 0; nt < 4; ++nt) { const size_t rows = (size_t)(row0 + (nt * 16 + (lane & 15)) * rstride);
#pragma unroll
                    for (int ks = 0; ks < 2; ++ks) Bk[nt][ks] = *(const bf16x8*)(QK + rows * 1024 + 512 + 256 + h * 64 + ks * 32 + (lane >> 4) * 8); }
            }
            WAVE_SYNC();
#pragma unroll
            for (int nt = 0; nt < 4; ++nt)
#pragma unroll
                for (int j = 0; j < 4; ++j) { const int i_ = 16 * w4 + (lane >> 4) * 4 + j, s_ = nt * 16 + (lane & 15); const bool keep = d == 0 ? (s_ <= i_) : (s_ >= i_);
                    sAtt[i_ * 72 + s_] = keep ? (bf16_t)f2bf(att[nt][j]) : (bf16_t)0; }
            WAVE_SYNC();
            bf16x8 Aa[2];
#pragma unroll
            for (int ks = 0; ks < 2; ++ks) Aa[ks] = *(const LAS bf16x8*)(sAtt + (16 * w4 + (lane & 15)) * 72 + ks * 32 + (lane >> 4) * 8);
#pragma unroll
            for (int nt = 0; nt < 8; ++nt)
#pragma unroll
                for (int ks = 0; ks < 2; ++ks) { const int bo = (nt * 16 + (lane & 15)) * 72 + ks * 32 + (lane >> 4) * 8;
                    o[nt] = mfma16(Aa[ks], *(const LAS bf16x8*)(sVt + bo), o[nt]); o[nt] = mfma16(Aq[d][ks], *(const LAS bf16x8*)(sS + d * 9216 + bo), o[nt]); }
        }
        const float* gn = p.gla_norm_g + l * 512 + h * 128;
        unsigned ogr[4][8];
#pragma unroll
        for (int j = 0; j < 4; ++j) { const size_t rowi = (size_t)(row0 + (16 * w4 + (lane >> 4) * 4 + j) * rstride);
#pragma unroll
            for (int nt = 0; nt < 8; ++nt) ogr[j][nt] = P[rowi * PW + 2048 + h * 128 + nt * 16 + (lane & 15)]; }
        __builtin_amdgcn_sched_barrier(0);
#pragma unroll
        for (int j = 0; j < 4; ++j) {
            float ss = 0.f;
#pragma unroll
            for (int nt = 0; nt < 8; ++nt) ss += o[nt][j] * o[nt][j];
            ss += shx(ss, 1, lane); ss += shx(ss, 2, lane); ss += shx(ss, 4, lane); ss += shx(ss, 8, lane);
            const float rs = __builtin_amdgcn_rsqf(ss * (1.f / 128.f) + 1e-6f);
            const size_t rowi = (size_t)(row0 + (16 * w4 + (lane >> 4) * 4 + j) * rstride);
            float ogv[8];
#pragma unroll
            for (int nt = 0; nt < 8; ++nt) ogv[nt] = bf2f(ogr[j][nt]);
#pragma unroll
            for (int nt = 0; nt < 8; ++nt) { const int vv = nt * 16 + (lane & 15);
                MIX[rowi * DM + 512 + h * 128 + vv] = (bf16_t)f2bf(o[nt][j] * rs * gn[vv] * silu_f(ogv[nt])); }
        }
    }
    __syncthreads();
}

#define XB_TMO      128
#define XB_XCNT(j)  (256  + 64 * (j))
#define XB_XSUB(j)  (1280 + 64 * (j))
#define XB_XGEN(j)  (2304 + 64 * (j))
#define XB_TOP      3328
#define XB_TOPGEN   3392
#define XCD_BAR_WORDS 3456
#define XB_SPIN_CAP (1u << 18)

__device__ __forceinline__ unsigned xb_ld(unsigned* p)              { return __hip_atomic_load(p, __ATOMIC_RELAXED, __HIP_MEMORY_SCOPE_AGENT); }
__device__ __forceinline__ unsigned xb_add(unsigned* p, unsigned v) { return __hip_atomic_fetch_add(p, v, __ATOMIC_RELAXED, __HIP_MEMORY_SCOPE_AGENT); }
__device__ __forceinline__ unsigned xb_xcc_id() { return (unsigned)__builtin_amdgcn_s_getreg((3 << 11) | 20) & 0xFu; }
#define XB_SPIN(cond, bar) do { unsigned _sp = 0; while (cond) { __builtin_amdgcn_s_sleep(1); \
    if ((++_sp & 255u) == 0u) { if (xb_ld(&(bar)[XB_TMO])) break; if (_sp > XB_SPIN_CAP) { atomicAdd(&(bar)[XB_TMO], 1u); break; } } } } while (0)

struct XcdBarrier {
    unsigned* bar; unsigned x;
    volatile LAS unsigned* st;
};

__device__ __forceinline__ XcdBarrier xcd_barrier_post(unsigned* bar, volatile LAS unsigned* st) {
    XcdBarrier b; b.bar = bar; b.x = xb_xcc_id(); b.st = st;
    if (threadIdx.x == 0) (void)xb_add(&bar[XB_XCNT(b.x)], 1u);
    return b;
}
__device__ __forceinline__ void xcd_barrier_complete(unsigned* bar, unsigned x, unsigned& nloc, unsigned& nx) {
    const unsigned G = gridDim.x * gridDim.y * gridDim.z;
    unsigned sum, cnt, mine, sp = 0u;
    for (;;) {
        sum = 0u; cnt = 0u; mine = 0u;
#pragma unroll
        for (unsigned j = 0; j < 16; ++j) { const unsigned c = xb_ld(&bar[XB_XCNT(j)]); sum += c; cnt += (c > 0u) ? 1u : 0u; mine = (j == x) ? c : mine; }
        if (sum == G) break;
        __builtin_amdgcn_s_sleep(1);
        if ((++sp & 255u) == 0u) { if (xb_ld(&bar[XB_TMO])) break; if (sp > XB_SPIN_CAP) { atomicAdd(&bar[XB_TMO], 1u); break; } }
    }
    nloc = mine > 0u ? mine : 1u; nx = cnt > 0u ? cnt : 1u;
}

__device__ __forceinline__ void xcd_barrier(const XcdBarrier& b, int xb_tid) {
    asm volatile("s_waitcnt vmcnt(0)" ::: "memory");
    __syncthreads();
    if (xb_tid == 0) {
        unsigned* bar = b.bar;
        __builtin_amdgcn_s_waitcnt(0);
        unsigned nloc = b.st[0], nx = b.st[1];
        if (nloc == 0u) { xcd_barrier_complete(bar, b.x, nloc, nx); b.st[0] = nloc; b.st[1] = nx; }
        const unsigned old = xb_add(&bar[XB_XSUB(b.x)], 1u);
        const unsigned gen = old / nloc;
        if (old + 1u == (gen + 1u) * nloc) {
            __builtin_amdgcn_fence(__ATOMIC_RELEASE, "agent");
            asm volatile("s_waitcnt vmcnt(0)" ::: "memory");
            const unsigned og = xb_add(&bar[XB_TOP], 1u);
            const unsigned tg = og / nx;
            if (og + 1u == (tg + 1u) * nx) xb_add(&bar[XB_TOPGEN], 1u);
            else XB_SPIN(xb_ld(&bar[XB_TOPGEN]) == tg, bar);
            __builtin_amdgcn_fence(__ATOMIC_ACQUIRE, "agent");
            xb_add(&bar[XB_XGEN(b.x)], 1u);
            asm volatile("s_waitcnt vmcnt(0)" ::: "memory");
        } else {
            XB_SPIN(xb_ld(&bar[XB_XGEN(b.x)]) == gen, bar);
            __builtin_amdgcn_fence(__ATOMIC_ACQUIRE, "agent");
            asm volatile("s_waitcnt vmcnt(0)" ::: "memory");
        }
    }
    __syncthreads();
}

__device__ __forceinline__ int lane_id_volatile() { int l; asm volatile("v_mbcnt_lo_u32_b32 %0, -1, 0\n\tv_mbcnt_hi_u32_b32 %0, -1, %0" : "=v"(l)); return l; }
__global__ void __launch_bounds__(NTHREADS, 2) mega_fwd(Params p_arg) {
    extern __shared__ __attribute__((aligned(16))) unsigned char lds_raw[];
    LAS unsigned char* lds = (LAS unsigned char*)lds_raw;
    cg::grid_group grid = cg::this_grid();
    const int G = gridDim.x, NGW = G * 8, gthreads = G * NTHREADS;
    const int wave_s = __builtin_amdgcn_readfirstlane((int)threadIdx.x >> 6);
#define MYTID() (wave_s * 64 + lane_id_volatile())
    volatile LAS unsigned* bst = (volatile LAS unsigned*)(lds + LDS_BYTES - 64);
    if (threadIdx.x < 2) bst[threadIdx.x] = 0u;
    if (blockIdx.x == 0) { unsigned* bw = (unsigned*)(p_arg.ws + WS_BAR); for (int i = threadIdx.x; i < XCD_BAR_WORDS; i += NTHREADS) bw[i] = 0u; }
#define KARGS() const __attribute__((address_space(4))) Params* pk_ = (const __attribute__((address_space(4))) Params*)__builtin_amdgcn_kernarg_segment_ptr(); asm volatile("" : "+s"(pk_)); PREF p = *pk_;

    {
    KARGS();
    const int tid = threadIdx.x, lane = tid & 63, wave = __builtin_amdgcn_readfirstlane(tid >> 6);
    const int gw = blockIdx.x * 8 + wave, gtid = blockIdx.x * NTHREADS + tid;
    phase_mods(p, lds, tid, wave, lane);
    phase_gatew(p, gtid, gthreads);
    { float* z_ = (float*)(p.ws + WS_MOD + 768 * 1024); for (int i = gtid; i < 2 * NMOD * DM; i += gthreads) z_[i] = 0.f; }
    { float* hc_ = (float*)(p.ws + WS_HCTX); for (int i = gtid; i < TC * DM / 4; i += gthreads) ((f32x4*)hc_)[i] = ((const f32x4*)p.ctx)[i]; }
    __syncthreads();
    convert_weights(p, 0, lds, gw, NGW, wave, lane);
    }
    grid.sync();
    (void)xcd_barrier_post((unsigned*)(p_arg.ws + WS_BAR), bst);

    for (int st = 0; st < NLAYER * 12; ++st) {
#ifndef DUP_MASK
#define DUP_MASK 0
#endif
        const int s_ = st % 12;
        const int sbit = (s_ == 0 || s_ == 3 || s_ == 9) ? 1 : (s_ == 1 || s_ == 10) ? 2 : (s_ == 4) ? 4 : (s_ == 5) ? 8 : (s_ == 7) ? 16 : 0;
        const int nrep = (DUP_MASK & sbit) ? 2 : 1;
        for (int rep = 0; rep < nrep; ++rep) {
        KARGS();
        unsigned char* ws = p.ws;
        bf16_t* U = (bf16_t*)(ws + WS_U); bf16_t* MIX = (bf16_t*)(ws + WS_MIX); bf16_t* GP = (bf16_t*)(ws + WS_GP);
        float* hctx = (float*)(ws + WS_HCTX); const float* mod = (const float*)(ws + WS_MOD);
#define PHASE_IDS() const int tid = MYTID(); const int lane = tid & 63, wave = __builtin_amdgcn_readfirstlane(tid >> 6); const int gw = blockIdx.x * 8 + wave, gtid = blockIdx.x * NTHREADS + tid; (void)gw; (void)gtid; (void)lane;
        const int l = st / 12, s = st % 12;
        const bool lastl = (l == NLAYER - 1);
        const int rows = (lastl && s >= 8) ? TL : TT;
        switch (s) {
        case 0: case 3: case 9: {
            PHASE_IDS();
            const int jn = s == 0 ? 0 : (s == 3 ? 1 : 2);
            if (s == 0) { phase_bias(p, l, lds, tid, wave, lane); if (l > 0) convert_weights(p, l, lds, gw, NGW, wave, lane); }
            if (st != 0) phase_rs(p, gtid, gthreads);
            phase_norm(p, l, jn, st == 0 ? 0 : TL, rows, st == 0, s == 0 ? (l > 0 ? DFF / 256 : 0) : (s == 3 ? DFF / 256 : DM / 256), gw, NGW, lane);
        } break;
        case 1: case 10: {
            PHASE_IDS();
            const int f = s == 1 ? 0 : 1;
            pg8::Gemm g{U, (const bf16_t*)(ws + WS_W13) + (size_t)f * 5632 * DM, rows, 5632, DM, DM};
            pg8::StaticOrder S; S.init(rows, 5632, G, (int)blockIdx.x);
            EpiSwiglu E{GP, (const float*)(ws + WS_RS), (const float*)(ws + WS_BIAS) + (size_t)(f ? 2 : 0) * 3 * 5632};
            pg8::gemm_phase<EpiSwiglu, pg8::StaticOrder, true, true>(lds, g, S, E, tid);
        } break;
        case 2: case 8: case 11: {
            PHASE_IDS();
            const bool isout = (s == 8);
            const int f = s == 2 ? 0 : 1;
            const int Kd = isout ? DM : DFF;
            const bf16_t* Ad = isout ? MIX : GP; const bf16_t* Bd = isout ? (const bf16_t*)(ws + WS_WOUT) : (const bf16_t*)(ws + WS_W2) + (size_t)f * DM * DFF;
            const int gidx = s == 2 ? 2 : (s == 8 ? 5 : 8);
            const bool first = (st == 2);
            const float* gate = mod + (size_t)l * 3 * (NMOD * DM) + gidx * DM; const float coef = isout ? 1.f : 0.5f;
            pg8::Gemm g{Ad, Bd, rows, DM, Kd, Kd};
            DownOrder S; S.so.init(TL, DM, G, (int)blockIdx.x); S.sk.init(TL / 256, TC / 256, DM / 256, Kd / 256, 256, G, (int)blockIdx.x); S.nlat = (TL / 256) * (DM / 256); S.nctx = rows == TT ? S.sk.nun : 0; S.inv = isout ? 16384 : 5958;
            const int ln = s == 11 ? l + 1 : l, jnn = s == 2 ? 1 : (s == 8 ? 2 : 0), jp = s == 2 ? 0 : (s == 8 ? 1 : 2);
            const bool emit = ln < NLAYER;
            EpiResid E{ws, gate, p.norm_g + (size_t)(l * 3 + jp) * DM, mod + (size_t)l * 3 * (NMOD * DM) + (3 * jp + 1) * DM,
                       emit ? p.norm_g + (size_t)(ln * 3 + jnn) * DM : p.final_g, emit ? mod + (size_t)ln * 3 * (NMOD * DM) + (3 * jnn + 1) * DM : (const float*)(ws + WS_MOD + 768 * 1024), coef, 1};
            pg8::gemm_phase<EpiResid, DownOrder, true, true>(lds, g, S, E, tid);
        } break;
        case 4: {
            PHASE_IDS();
            pg8::Gemm g{U, (const bf16_t*)(ws + WS_WIN), rows, PW, DM, DM};
            pg8::StaticOrder S; S.init(rows, PW, G, (int)blockIdx.x);
            EpiStore E{GP, PW, (const float*)(ws + WS_RS), (const float*)(ws + WS_BIAS) + (size_t)1 * 3 * 5632};
            pg8::gemm_phase<EpiStore, pg8::StaticOrder, true, true>(lds, g, S, E, tid);
        } break;
        case 5: {
            PHASE_IDS();
            for (int r2 = 0; r2 < ((DUP_MASK & 32) ? 2 : 1); ++r2)
            for (int item = gw; item < 2 * NCH * 8; item += NGW) rg_item<false>(p, l, item, lds + wave * 18432, lane);
            __syncthreads();
            const int NP = G * 4, pgid = NP - 1 - (blockIdx.x * 4 + (wave >> 1));
            for (int r2 = 0; r2 < ((DUP_MASK & (64 | 128)) ? 2 : 1); ++r2)
            for (int it = 0; it * NP < 2 * NCH * 4; ++it) { const int item = it * NP + pgid; gl1_item(p, l, item, item < 2 * NCH * 4, lds + (wave >> 1) * 37376, wave & 1, lane); }
        } break;
        case 6: {
            PHASE_IDS();
            rg_carry(p, wave, lane);
            gl2_scan(p, gtid, gthreads);
        } break;
        case 7: {
            PHASE_IDS();
            const int nrg = lastl ? 2 * 256 * 8 : 2 * NCH * 8, ngl = lastl ? 2 * 256 * 4 : 2 * NCH * 4;
            for (int item = gw; item < nrg; item += NGW) rg_item<true>(p, l, item, lds + wave * 18432, lane);
            __syncthreads();
            const int NS = G * 2, sgid = NS - 1 - (blockIdx.x * 2 + (wave >> 2));
            for (int r2 = 0; r2 < ((DUP_MASK & (64 | 256)) ? 2 : 1); ++r2)
            for (int it = 0; it * NS < ngl; ++it) { const int item = it * NS + sgid; gl3_item(p, l, item, item < ngl, lds + (wave >> 2) * 64512, wave & 3, tid & 255, lane); }
        } break;
        }
        { XcdBarrier xb_; xb_.bar = (unsigned*)(p.ws + WS_BAR); xb_.x = xb_xcc_id(); xb_.st = (volatile LAS unsigned*)(lds + LDS_BYTES - 64); xcd_barrier(xb_, MYTID()); }
        }
    }
    { KARGS(); const int tid = MYTID(), lane = tid & 63, wave = __builtin_amdgcn_readfirstlane(tid >> 6); phase_final(p, blockIdx.x * 8 + wave, NGW, lane); }
}

extern "C" void kernel_launch(void* const* d_in, const int* in_sizes, int n_in, void* d_out, int out_size, void* d_ws, size_t ws_size, hipStream_t stream) {
    static int grid_blocks = 0;
    if (grid_blocks == 0) {
        if (n_in != 23 || ws_size < WS_END) { fprintf(stderr, "kernel_launch: unexpected n_in %d or ws_size %zu (< %zu)\n", n_in, ws_size, (size_t)WS_END); grid_blocks = -1; return; }
        int dev = 0, cus = 0, per_cu = 0;
        hipGetDevice(&dev);
        hipDeviceGetAttribute(&cus, hipDeviceAttributeMultiprocessorCount, dev);
        if (hipFuncSetAttribute((const void*)mega_fwd, hipFuncAttributeMaxDynamicSharedMemorySize, LDS_BYTES) != hipSuccess) { fprintf(stderr, "kernel_launch: hipFuncSetAttribute failed\n"); grid_blocks = -1; return; }
        if (hipOccupancyMaxActiveBlocksPerMultiprocessor(&per_cu, (const void*)mega_fwd, NTHREADS, LDS_BYTES) != hipSuccess || per_cu < 1) { fprintf(stderr, "kernel_launch: occupancy query says %d\n", per_cu); per_cu = 1; }
        (void)hipGetLastError();
        grid_blocks = cus;
    }
    if (grid_blocks < 0) return;
    Params p{};
    const float** pp = (const float**)&p;
    for (int i = 0; i < 23; ++i) pp[i] = (const float*)d_in[i];
    p.out = (float*)d_out; p.ws = (unsigned char*)d_ws;
    void* args[] = {&p};
    hipError_t e = hipLaunchCooperativeKernel((const void*)mega_fwd, dim3(grid_blocks), dim3(NTHREADS), args, LDS_BYTES, stream);
    if (e != hipSuccess) fprintf(stderr, "cooperative launch failed: %s (grid %d)\n", hipGetErrorString(e), grid_blocks);
}
```

```cpp
#include <hip/hip_runtime.h>
#include <hip/hip_cooperative_groups.h>
#include <cstdio>
#include <cstdint>
namespace cg = cooperative_groups;
namespace pg8 {
#define PG8_LAS __attribute__((address_space(3)))
typedef unsigned short bf16_t;
typedef short bf16x8 __attribute__((ext_vector_type(8)));
typedef float f32x4 __attribute__((ext_vector_type(4)));
typedef unsigned u32x4 __attribute__((ext_vector_type(4)));
constexpr int BM = 256, BK = 64, HALF = 128, HTB = HALF * BK * 2  , STAGE_BYTES = 8 * HTB, NXCD = 8, WGM = 8;

__host__ __device__ __forceinline__ int lds_byte(int r, int c) { const int st = (r >> 4) * 2 + (c >> 5), rr = r & 15, cc = c & 31, ob = rr * 64 + cc * 2; return st * 1024 + (ob ^ (((ob >> 9) & 1) << 5)); }
__host__ __device__ __forceinline__ void stage_rc(int b, int& R, int& C) { const int st = b / 1024, sb = b % 1024, swz = sb ^ (((sb >> 9) & 1) << 5); R = (st >> 1) * 16 + swz / 64; C = (st & 1) * 32 + (swz % 64) / 2; }
__host__ __device__ __forceinline__ int perm32(int rho) { const int n = rho >> 4, i = rho & 15; return 8 * (i >> 2) + 4 * n + (i & 3); }

struct Unit { int pm, pn, kb, nk; };
struct Gemm { const bf16_t* A; const bf16_t* Bt; int M, N, K, ldk; };

struct StaticOrder {
    int nM, nN, nwg, G, c;
    __host__ __device__ void init(int M, int N, int G_, int c_) { nM = M / BM; nN = N / BM; nwg = nM * nN; G = G_; c = c_; }
    __host__ __device__ bool next(int i, Unit& u) const {
        const long L = (long)i * G + c; if (L >= nwg) return false;
        int wgid = (int)L; { const int q = nwg / NXCD, r = nwg % NXCD, xcd = wgid % NXCD, off = wgid / NXCD; wgid = (xcd < r ? xcd * (q + 1) : r * (q + 1) + (xcd - r) * q) + off; }
        const int nig = WGM * nN, gid = wgid / nig, fm = gid * WGM, gsz = (nM - fm) < WGM ? (nM - fm) : WGM;
        u.pm = fm + ((wgid % nig) % gsz); u.pn = (wgid % nig) / gsz; u.kb = 0; u.nk = 0; return true;
    }
    __device__ __forceinline__ void a_ready(const Unit&) const {}
    __device__ __forceinline__ void done(const Unit&) const {}
};
struct SplitKOrder {
    int pm0, nN, nsplit, kc, nun, G, c;
    __host__ __device__ void init(int pm0_, int nM_, int nN_, int nsplit_, int kc_, int G_, int c_) { pm0 = pm0_; nN = nN_; nsplit = nsplit_; kc = kc_; nun = nM_ * nN_ * nsplit_; G = G_; c = c_; }
    __host__ __device__ bool next(int i, Unit& u) const {
        const int L = i * G + c; if (L >= nun) return false;
        const int tile = L / nsplit, ks = L - tile * nsplit;
        u.pm = pm0 + tile / nN; u.pn = tile % nN; u.kb = ks * kc; u.nk = kc / BK; return true;
    }
    __device__ __forceinline__ void a_ready(const Unit&) const {}
    __device__ __forceinline__ void done(const Unit&) const {}
};
__device__ __forceinline__ unsigned cvt_pk_bf16(float lo, float hi) { unsigned r; asm volatile("v_cvt_pk_bf16_f32 %0, %1, %2" : "=v"(r) : "v"(lo), "v"(hi)); return r; }
template <class Epi, class Sched, bool ALIGN_EPI = false, bool SP2 = false>
__device__ __forceinline__ void gemm_phase(PG8_LAS unsigned char* lds, const Gemm g, const Sched& S, const Epi& E, int tid_in) {
    int tid = tid_in; asm volatile("" : "+v"(tid));
    const int wid = __builtin_amdgcn_readfirstlane(tid >> 6), lane = tid & 63, wr = wid >> 2, wc = wid & 3, fr = lane & 15, fq = lane >> 4;
    const int K = g.ldk, nt_all = g.K / BK;
    unsigned voffA[2], voffB[2];
#pragma unroll
    for (int i = 0; i < 2; ++i) { int R, C; stage_rc(tid * 16 + i * 8192, R, C); const int Rb = Epi::PERM ? ((R & ~31) + perm32(R & 31)) : R;
        voffA[i] = (unsigned)(R * K + C) * 2u; voffB[i] = (unsigned)(Rb * K + C) * 2u; }
    const size_t kstep = (size_t)(BK * 2);
    const size_t hstep = (size_t)HALF * K * 2;
    const size_t tstep = 2 * hstep;
    const unsigned ldsw = (unsigned)wid * 1024u;
    const int aoff = lds_byte(wr * 64 + fr, fq * 8), boff = lds_byte(wc * 32 + fr, fq * 8);
#define PG8_SA(b, h) (((b) * 2 + (h)) * HTB)
#define PG8_SB(b, h) ((4 + (b) * 2 + (h)) * HTB)
#define PG8_STAGE(bufoff, gbase, voff) do { _Pragma("unroll") for (int _i = 0; _i < 2; ++_i) \
        __builtin_amdgcn_global_load_lds((const unsigned*)((const char*)(gbase) + (voff)[_i]), (PG8_LAS unsigned*)(lds + (bufoff) + ldsw + _i * 8192), 16, 0, 0); } while (0)
#define PG8_LDA(dst, b, h) do { _Pragma("unroll") for (int m = 0; m < 4; ++m) _Pragma("unroll") for (int k = 0; k < 2; ++k) dst[m][k] = *(const PG8_LAS bf16x8*)(lds + PG8_SA(b, h) + aoff + m * 2048 + k * 1024); } while (0)
#define PG8_LDB(dst, b, h) do { _Pragma("unroll") for (int n = 0; n < 2; ++n) _Pragma("unroll") for (int k = 0; k < 2; ++k) dst[n][k] = *(const PG8_LAS bf16x8*)(lds + PG8_SB(b, h) + boff + n * 2048 + k * 1024); } while (0)
#define PG8_MMA(ai, bj, At, Bt) do { __builtin_amdgcn_s_setprio(1); _Pragma("unroll") for (int m = 0; m < 4; ++m) _Pragma("unroll") for (int n = 0; n < 2; ++n) _Pragma("unroll") for (int k = 0; k < 2; ++k) \
        acc[ai][bj][m][n] = __builtin_amdgcn_mfma_f32_16x16x32_bf16(Bt[n][k], At[m][k], acc[ai][bj][m][n], 0, 0, 0); __builtin_amdgcn_s_setprio(0); } while (0)
#define PG8_WAIT_V(n) asm volatile("s_waitcnt vmcnt(" #n ")" ::: "memory")
#define PG8_WAIT_L(n) asm volatile("s_waitcnt lgkmcnt(" #n ")" ::: "memory")
#define PG8_BAR __builtin_amdgcn_s_barrier()
#define PG8_SCHED __builtin_amdgcn_sched_barrier(0)
    Unit cur, nxt; int ui = 0;
    if (!S.next(0, cur)) return;
    f32x4 acc[2][2][4][2];
#pragma unroll
    for (int a = 0; a < 2; ++a)
#pragma unroll
        for (int b = 0; b < 2; ++b)
#pragma unroll
            for (int m = 0; m < 4; ++m)
#pragma unroll
                for (int n = 0; n < 2; ++n) acc[a][b][m][n] = (f32x4){0.f, 0.f, 0.f, 0.f};
    bf16x8 At[4][2], B0[2][2], B1[2][2];
    const char* cA = (const char*)g.A + (size_t)cur.pm * tstep + (size_t)cur.kb * 2; const char* cB = (const char*)g.Bt + (size_t)cur.pn * tstep + (size_t)cur.kb * 2;
    S.a_ready(cur);
    if constexpr (SP2) {
        PG8_STAGE(PG8_SB(0, 0), cB, voffB); PG8_STAGE(PG8_SB(0, 1), cB + hstep, voffB); PG8_STAGE(PG8_SA(0, 0), cA, voffA); PG8_STAGE(PG8_SA(0, 1), cA + hstep, voffA);
        if (wr == 1) PG8_BAR;
        PG8_WAIT_V(2); PG8_BAR;
        PG8_STAGE(PG8_SB(1, 0), cB + kstep, voffB); PG8_STAGE(PG8_SA(1, 0), cA + kstep, voffA); PG8_STAGE(PG8_SB(1, 1), cB + hstep + kstep, voffB);
        PG8_WAIT_V(6); PG8_BAR;
    } else {
        PG8_STAGE(PG8_SB(0, 0), cB, voffB); PG8_STAGE(PG8_SA(0, 0), cA, voffA); PG8_STAGE(PG8_SB(0, 1), cB + hstep, voffB); PG8_STAGE(PG8_SA(0, 1), cA + hstep, voffA);
        if (wr == 1) PG8_BAR;
        PG8_WAIT_V(4); PG8_BAR;
        PG8_STAGE(PG8_SB(1, 0), cB + kstep, voffB); PG8_STAGE(PG8_SA(1, 0), cA + kstep, voffA); PG8_STAGE(PG8_SB(1, 1), cB + hstep + kstep, voffB);
        PG8_WAIT_V(6); PG8_BAR;
    }
    for (;;) {
        const bool has_next = S.next(ui + 1, nxt);
        const char* nA = has_next ? (const char*)g.A + (size_t)nxt.pm * tstep + (size_t)nxt.kb * 2 : cA; const char* nB = has_next ? (const char*)g.Bt + (size_t)nxt.pn * tstep + (size_t)nxt.kb * 2 : cB;
        const int nt = cur.nk ? cur.nk : nt_all;
        for (int t = 0; t < nt; t += 2) {
            const bool last = (t == nt - 2);
            const char* a1 = cA + (size_t)(t + 1) * kstep;
            const char* a2 = last ? nA : cA + (size_t)(t + 2) * kstep; const char* b2 = last ? nB : cB + (size_t)(t + 2) * kstep;
            const char* a3 = a2 + kstep; const char* b3 = b2 + kstep;
            if (last && has_next) S.a_ready(nxt);
            if constexpr (SP2) {
            PG8_LDB(B0, 0, 0); PG8_LDB(B1, 0, 1); PG8_SCHED; PG8_LDA(At, 0, 0); PG8_STAGE(PG8_SA(1, 1), a1 + hstep, voffA);
            PG8_WAIT_V(8); PG8_WAIT_L(0); PG8_BAR; PG8_MMA(0, 0, At, B0); PG8_MMA(0, 1, At, B1); PG8_BAR; PG8_SCHED;
            PG8_LDA(At, 0, 1); PG8_STAGE(PG8_SB(0, 0), b2, voffB); PG8_STAGE(PG8_SB(0, 1), b2 + hstep, voffB); PG8_STAGE(PG8_SA(0, 0), a2, voffA);
            PG8_WAIT_V(8); PG8_WAIT_L(0); PG8_BAR; PG8_MMA(1, 0, At, B0); PG8_MMA(1, 1, At, B1); PG8_BAR; PG8_SCHED;
            PG8_LDB(B0, 1, 0); PG8_LDB(B1, 1, 1); PG8_SCHED; PG8_LDA(At, 1, 0); PG8_STAGE(PG8_SA(0, 1), a2 + hstep, voffA);
            PG8_WAIT_V(8); PG8_WAIT_L(0); PG8_BAR; PG8_MMA(0, 0, At, B0); PG8_MMA(0, 1, At, B1); PG8_BAR; PG8_SCHED;
            PG8_LDA(At, 1, 1); PG8_STAGE(PG8_SB(1, 0), b3, voffB); PG8_STAGE(PG8_SB(1, 1), b3 + hstep, voffB); PG8_STAGE(PG8_SA(1, 0), a3, voffA);
            PG8_WAIT_V(8); PG8_WAIT_L(0); PG8_BAR; PG8_MMA(1, 0, At, B0); PG8_MMA(1, 1, At, B1); PG8_BAR; PG8_SCHED;
            } else {
            PG8_LDB(B0, 0, 0); PG8_SCHED; PG8_LDA(At, 0, 0); PG8_STAGE(PG8_SA(1, 1), a1 + hstep, voffA);
            PG8_WAIT_L(8); PG8_BAR; PG8_WAIT_L(0); PG8_MMA(0, 0, At, B0); PG8_BAR; PG8_SCHED;
            PG8_LDB(B1, 0, 1); PG8_STAGE(PG8_SB(0, 0), b2, voffB);
            PG8_BAR; PG8_WAIT_L(0); PG8_MMA(0, 1, At, B1); PG8_BAR;
            PG8_LDA(At, 0, 1); PG8_STAGE(PG8_SA(0, 0), a2, voffA);
            PG8_BAR; PG8_WAIT_L(0); PG8_MMA(1, 0, At, B0); PG8_BAR; PG8_SCHED;
            PG8_STAGE(PG8_SB(0, 1), b2 + hstep, voffB);
            PG8_WAIT_V(6); PG8_BAR; PG8_MMA(1, 1, At, B1); PG8_BAR;
            PG8_LDB(B0, 1, 0); PG8_SCHED; PG8_LDA(At, 1, 0); PG8_STAGE(PG8_SA(0, 1), a2 + hstep, voffA);
            PG8_WAIT_L(8); PG8_BAR; PG8_WAIT_L(0); PG8_MMA(0, 0, At, B0); PG8_BAR; PG8_SCHED;
            PG8_LDB(B1, 1, 1); PG8_STAGE(PG8_SB(1, 0), b3, voffB);
            PG8_BAR; PG8_WAIT_L(0); PG8_MMA(0, 1, At, B1); PG8_BAR;
            PG8_LDA(At, 1, 1); PG8_STAGE(PG8_SA(1, 0), a3, voffA);
            PG8_BAR; PG8_WAIT_L(0); PG8_MMA(1, 0, At, B0); PG8_BAR; PG8_SCHED;
            PG8_STAGE(PG8_SB(1, 1), b3 + hstep, voffB);
            PG8_WAIT_V(6); PG8_BAR; PG8_MMA(1, 1, At, B1); PG8_BAR;
            }
        }
        if constexpr (ALIGN_EPI) { if (wr == 0) PG8_BAR; }
        if constexpr (!Epi::AFTER_DRAIN) { E(acc, cur, wr, wc, fr, fq); S.done(cur); }
        if (!has_next) break;
#pragma unroll
        for (int a = 0; a < 2; ++a)
#pragma unroll
            for (int b = 0; b < 2; ++b)
#pragma unroll
                for (int m = 0; m < 4; ++m)
#pragma unroll
                    for (int n = 0; n < 2; ++n) acc[a][b][m][n] = (f32x4){0.f, 0.f, 0.f, 0.f};
        cur = nxt; cA = nA; cB = nB; ++ui;
        if constexpr (ALIGN_EPI) { if (wr == 1) PG8_BAR; }
    }
    PG8_WAIT_V(0);
    if constexpr (!ALIGN_EPI) { if (wr == 0) PG8_BAR; }
    PG8_BAR;
    if constexpr (Epi::AFTER_DRAIN) { E.fused(acc, cur, wr, wc, fr, fq, lds, wid, lane); S.done(cur); }
#undef PG8_SA
#undef PG8_SB
#undef PG8_STAGE
#undef PG8_LDA
#undef PG8_LDB
#undef PG8_MMA
#undef PG8_WAIT_V
#undef PG8_WAIT_L
#undef PG8_BAR
#undef PG8_SCHED
}
}

#define LAS __attribute__((address_space(3)))
typedef unsigned short bf16_t;
typedef short bf16x8 __attribute__((ext_vector_type(8)));
typedef float f32x4 __attribute__((ext_vector_type(4)));
typedef unsigned u32x4 __attribute__((ext_vector_type(4)));
typedef unsigned u32x2 __attribute__((ext_vector_type(2)));
typedef __bf16 bf16x2_t __attribute__((ext_vector_type(2)));

constexpr int DM = 1024, DFF = 2816, NLAYER = 4, NMOD = 9;
constexpr int TL = 32768, TC = 512, TT = TL + TC;
constexpr int PW = 2816;
constexpr int NCH = 260;
constexpr int LDS_BYTES = 157696;
constexpr int NTHREADS = 512;

constexpr size_t MiB = 1u << 20;
constexpr size_t WS_MOD = 0, WS_HCTX = 1 * MiB, WS_WG = 3 * MiB, WS_RGA = 4 * MiB, WS_RGH = 7 * MiB, WS_RGC = 10 * MiB, WS_GLD = 13 * MiB,
                 WS_BAR = 15 * MiB, WS_W13 = 16 * MiB, WS_W2 = 38 * MiB, WS_WIN = 49 * MiB, WS_WOUT = 55 * MiB, WS_U = 58 * MiB, WS_MIX = 123 * MiB,
                 WS_GP = 188 * MiB, WS_QK = 367 * MiB, WS_GLS = 432 * MiB, WS_HB = 497 * MiB  , WS_PART = 562 * MiB, WS_SS = 585 * MiB, WS_BIAS = 588 * MiB, WS_RS = 588 * MiB + 512 * 1024, WS_END = 589 * MiB;

struct Params {
    const float *x, *c, *ctx, *c_ctx, *w_mod, *b_mod, *norm_g, *ffn_w1, *ffn_w3, *ffn_w2, *w_in, *conv_w, *conv_b, *rg_lam, *rg_wa, *rg_ba, *rg_wi, *rg_bi,
        *gla_wup, *gla_bup, *gla_norm_g, *w_out, *final_g;
    float* out; unsigned char* ws;
};

typedef const __attribute__((address_space(4))) Params& PREF;
#define WAVE_SYNC() asm volatile("s_waitcnt lgkmcnt(0)" ::: "memory")

__device__ __forceinline__ unsigned f2bf(float f) { unsigned r; asm("v_cvt_pk_bf16_f32 %0, %1, %1" : "=v"(r) : "v"(f)); return r & 0xffffu; }
__device__ __forceinline__ unsigned pk2(float lo, float hi) { unsigned r; asm("v_cvt_pk_bf16_f32 %0, %1, %2" : "=v"(r) : "v"(lo), "v"(hi)); return r; }
__device__ __forceinline__ float bf2f(unsigned h) { return __builtin_bit_cast(float, h << 16); }
__device__ __forceinline__ float rcpf_(float x) { return __builtin_amdgcn_rcpf(x); }
__device__ __forceinline__ float sigmoid_f(float x) { return rcpf_(1.f + __expf(-x)); }
__device__ __forceinline__ float silu_f(float x) { return x * sigmoid_f(x); }
__device__ __forceinline__ float gelu_tanh_f(float x) { const float y = 0.7978845608028654f * (x + 0.044715f * x * x * x); return x * sigmoid_f(2.f * y); }
__device__ __forceinline__ float shx(float v, int m, int lane) { return __builtin_bit_cast(float, __builtin_amdgcn_ds_bpermute((lane ^ m) << 2, __builtin_bit_cast(int, v))); }
__device__ __forceinline__ float wave_sum(float v, int lane) {
#pragma unroll
    for (int o = 1; o < 64; o <<= 1) v += shx(v, o, lane);
    return v;
}
__device__ __forceinline__ f32x4 mfma16(bf16x8 a, bf16x8 b, f32x4 c) { return __builtin_amdgcn_mfma_f32_16x16x32_bf16(a, b, c, 0, 0, 0); }

__device__ __forceinline__ float row_rs(const float* rsv, int row) { return rsv[row]; }
struct EpiSwiglu {
    static constexpr bool PERM = true, AFTER_DRAIN = false;
    bf16_t* G; const LAS float* side; mutable int ui;
    __device__ __forceinline__ void operator()(const f32x4 (&acc)[2][2][4][2], const pg8::Unit& u, int wr, int wc, int fr, int fq) const {
        asm volatile("" : "+v"(fr), "+v"(fq));
        const int row0 = u.pm * 256 + wr * 64 + fr, col0 = u.pn * 128 + wc * 32 + 8 * fq;
        const LAS float* sp = side + ui * 512; ++ui;
        const LAS float* bp = sp + 256 + wc * 32 + 8 * fq;
        const f32x4 c10 = *(const LAS f32x4*)bp, c11 = *(const LAS f32x4*)(bp + 4), c30 = *(const LAS f32x4*)(bp + 128), c31 = *(const LAS f32x4*)(bp + 128 + 4);
#pragma unroll
        for (int ai = 0; ai < 2; ++ai)
#pragma unroll
            for (int m = 0; m < 4; ++m) {
                const int row = row0 + ai * 128 + m * 16; const float rs = sp[ai * 128 + wr * 64 + m * 16 + fr];
                const f32x4 a0 = acc[ai][0][m][0] * rs + c10, a1 = acc[ai][0][m][1] * rs + c11, b0 = acc[ai][1][m][0] * rs + c30, b1 = acc[ai][1][m][1] * rs + c31;
                u32x4 w;
                w.x = pk2(silu_f(a0[0]) * b0[0], silu_f(a0[1]) * b0[1]); w.y = pk2(silu_f(a0[2]) * b0[2], silu_f(a0[3]) * b0[3]);
                w.z = pk2(silu_f(a1[0]) * b1[0], silu_f(a1[1]) * b1[1]); w.w = pk2(silu_f(a1[2]) * b1[2], silu_f(a1[3]) * b1[3]);
                *(u32x4*)(G + (size_t)row * PW + col0) = w;
            }
    }
};
struct EpiStore {
    static constexpr bool PERM = true, AFTER_DRAIN = false;
    bf16_t* O; int ldc; const float* ss; const float* bias;
    __device__ __forceinline__ void operator()(const f32x4 (&acc)[2][2][4][2], const pg8::Unit& u, int wr, int wc, int fr, int fq) const {
        asm volatile("" : "+v"(fr), "+v"(fq));
        const int row0 = u.pm * 256 + wr * 64 + fr, col0 = u.pn * 256 + wc * 32 + 8 * fq;
        const float* bp = bias + (size_t)((u.pm * 256) >> 14) * 5632 + col0;
        f32x4 cb[2][2];
#pragma unroll
        for (int bj = 0; bj < 2; ++bj) { cb[bj][0] = *(const f32x4*)(bp + bj * 128); cb[bj][1] = *(const f32x4*)(bp + bj * 128 + 4); }
#pragma unroll
        for (int ai = 0; ai < 2; ++ai)
#pragma unroll
            for (int m = 0; m < 4; ++m) {
                const int row = row0 + ai * 128 + m * 16; const float rs = row_rs(ss, row);
#pragma unroll
                for (int bj = 0; bj < 2; ++bj) {
                    const f32x4 v0 = acc[ai][bj][m][0] * rs + cb[bj][0], v1 = acc[ai][bj][m][1] * rs + cb[bj][1];
                    u32x4 w; w.x = pk2(v0[0], v0[1]); w.y = pk2(v0[2], v0[3]); w.z = pk2(v1[0], v1[1]); w.w = pk2(v1[2], v1[3]);
                    *(u32x4*)(O + (size_t)row * ldc + col0 + bj * 128) = w;
                }
            }
    }
};
struct EpiResid {
    static constexpr bool PERM = true, AFTER_DRAIN = false;
    unsigned char* wsb; const float* gate; const float* ngp; const float* scp; const float* ngn; const float* scn; float coef; int emit;
    __device__ __forceinline__ void operator()(const f32x4 (&acc)[2][2][4][2], const pg8::Unit& u, int wr, int wc, int fr, int fq) const {
        asm volatile("" : "+v"(fr), "+v"(fq));
        float* const hout_ctx = (float*)(wsb + WS_HCTX); float* const part = (float*)(wsb + WS_PART); int em_ = __builtin_amdgcn_readfirstlane(emit); asm volatile("" : "+s"(em_)); bf16_t* const Un = em_ ? (bf16_t*)(wsb + WS_U) : (bf16_t*)nullptr; float* const ssn = (float*)(wsb + WS_SS);
        const int rowt = u.pm * 256; const int grp = rowt >> 14;
        const bool isctx = rowt >= TL;
        if (isctx) {
            const int row0 = rowt - TL + wr * 64 + fr, col0 = u.pn * 256 + wc * 32 + 8 * fq;
            const float* gp = gate + (size_t)2 * (NMOD * DM) + col0;
            float* pb = part + (size_t)(u.kb >> 8) * (TC * DM);
#pragma unroll
            for (int bj = 0; bj < 2; ++bj) {
                const f32x4 g0 = *(const f32x4*)(gp + bj * 128) * coef, g1 = *(const f32x4*)(gp + bj * 128 + 4) * coef;
#pragma unroll
                for (int ai = 0; ai < 2; ++ai)
#pragma unroll
                    for (int m = 0; m < 4; ++m) {
                        float* o = pb + (size_t)(row0 + ai * 128 + m * 16) * DM + col0 + bj * 128;
                        *(f32x4*)o = g0 * acc[ai][bj][m][0]; *(f32x4*)(o + 4) = g1 * acc[ai][bj][m][1];
                    }
            }
            return;
        }
        const int row0 = rowt + wr * 64 + fr, col0 = u.pn * 256 + wc * 32 + 8 * fq;
        const float* gp = gate + (size_t)grp * (NMOD * DM) + col0;
        float sq[2][4];
#pragma unroll
        for (int ai = 0; ai < 2; ++ai)
#pragma unroll
            for (int m = 0; m < 4; ++m) sq[ai][m] = 0.f;
#pragma unroll
        for (int bj = 0; bj < 2; ++bj) {
            const f32x4 g0 = *(const f32x4*)(gp + bj * 128) * coef, g1 = *(const f32x4*)(gp + bj * 128 + 4) * coef;
            f32x4 s0, s1, i0, i1;
            { const float* np_ = ngn + col0 + bj * 128; const float* sp_ = scn + (size_t)grp * (NMOD * DM) + col0 + bj * 128;
                s0 = *(const f32x4*)np_ * (*(const f32x4*)sp_ + 1.f); s1 = *(const f32x4*)(np_ + 4) * (*(const f32x4*)(sp_ + 4) + 1.f);
                const float* pp_ = ngp + col0 + bj * 128; const float* qp_ = scp + (size_t)grp * (NMOD * DM) + col0 + bj * 128;
                const f32x4 p0 = *(const f32x4*)pp_ * (*(const f32x4*)qp_ + 1.f), p1 = *(const f32x4*)(pp_ + 4) * (*(const f32x4*)(qp_ + 4) + 1.f);
                i0 = (f32x4){rcpf_(p0[0]), rcpf_(p0[1]), rcpf_(p0[2]), rcpf_(p0[3])}; i1 = (f32x4){rcpf_(p1[0]), rcpf_(p1[1]), rcpf_(p1[2]), rcpf_(p1[3])}; }
#pragma unroll
            for (int ai = 0; ai < 2; ++ai) {
                u32x4 rr[4];
#pragma unroll
                for (int m = 0; m < 4; ++m) rr[m] = *(const u32x4*)(Un + (size_t)(row0 + ai * 128 + m * 16) * DM + col0 + bj * 128);
                __builtin_amdgcn_sched_barrier(0);
#pragma unroll
                for (int m = 0; m < 4; ++m) {
                    const size_t off = (size_t)(row0 + ai * 128 + m * 16) * DM + col0 + bj * 128;
                    const u32x4 r = rr[m];
                    f32x4 h0 = (f32x4){bf2f(r.x & 0xffffu), __builtin_bit_cast(float, r.x & 0xffff0000u), bf2f(r.y & 0xffffu), __builtin_bit_cast(float, r.y & 0xffff0000u)};
                    f32x4 h1 = (f32x4){bf2f(r.z & 0xffffu), __builtin_bit_cast(float, r.z & 0xffff0000u), bf2f(r.w & 0xffffu), __builtin_bit_cast(float, r.w & 0xffff0000u)};
                    h0 = h0 * i0 + g0 * acc[ai][bj][m][0]; h1 = h1 * i1 + g1 * acc[ai][bj][m][1];
                    sq[ai][m] += ((h0[0] * h0[0] + h0[1] * h0[1]) + (h0[2] * h0[2] + h0[3] * h0[3])) + ((h1[0] * h1[0] + h1[1] * h1[1]) + (h1[2] * h1[2] + h1[3] * h1[3]));
                    asm volatile("" : "+v"(sq[ai][m]));
                    const f32x4 u0 = h0 * s0, u1 = h1 * s1;
                    u32x4 w; w.x = pk2(u0[0], u0[1]); w.y = pk2(u0[2], u0[3]); w.z = pk2(u1[0], u1[1]); w.w = pk2(u1[2], u1[3]);
                    *(u32x4*)(Un + off) = w;
                }
                __builtin_amdgcn_sched_barrier(0);
            }
        }
        if (Un) {
#pragma unroll
            for (int ai = 0; ai < 2; ++ai)
#pragma unroll
                for (int m = 0; m < 4; ++m) { float t = sq[ai][m]; t += shx(t, 16, fq * 16 + fr); t += shx(t, 32, fq * 16 + fr);
                    if (fq == 0) ssn[(size_t)(row0 + ai * 128 + m * 16) * 16 + u.pn * 4 + wc] = t; }
        }
    }
};

struct DownOrder {
    pg8::StaticOrder so; pg8::SplitKOrder sk; int nlat, nctx, inv;
    __device__ bool next(int i, pg8::Unit& u) const {
        const int L = i * so.G + so.c;
        if (L < nlat) return so.next(i, u);
        const int Lc = L - nlat; if (Lc >= nctx) return false;
        const int tile = (Lc * inv) >> 16, ks = Lc - tile * sk.nsplit;
        u.pm = sk.pm0 + (tile >> 2); u.pn = tile & 3; u.kb = ks * 256; u.nk = 4; return true;
    }
    __device__ __forceinline__ void a_ready(const pg8::Unit&) const {}
    __device__ __forceinline__ void done(const pg8::Unit&) const {}
};

__device__ __forceinline__ void transpose_item(const float* __restrict__ W, int K, int ldn, bf16_t* __restrict__ WT, int drow, int k0, int n0, LAS float* scr, int lane) {
    float wv[32];
#pragma unroll
    for (int i = 0; i < 32; ++i) { const int kk = 2 * i + (lane >> 5); wv[i] = W[(size_t)(k0 + kk) * ldn + n0 + (lane & 31)]; }
#pragma unroll
    for (int i = 0; i < 32; ++i) { const int kk = 2 * i + (lane >> 5); scr[kk * 33 + (lane & 31)] = wv[i]; }
    WAVE_SYNC();
    const int c = lane & 7;
#pragma unroll
    for (int j = 0; j < 4; ++j) { const int n = (lane >> 3) + 8 * j; const LAS float* s = scr + (8 * c) * 33 + n;
        u32x4 o; o.x = pk2(s[0 * 33], s[1 * 33]); o.y = pk2(s[2 * 33], s[3 * 33]); o.z = pk2(s[4 * 33], s[5 * 33]); o.w = pk2(s[6 * 33], s[7 * 33]);
        *(u32x4*)(WT + (size_t)(drow + n0 + n) * K + k0 + 8 * c) = o; }
    WAVE_SYNC();
}

__device__ __forceinline__ void convert_weights(PREF p, int l, LAS unsigned char* lds, int gw, int NGW, int wave, int lane) {
    LAS float* scr = (LAS float*)(lds + wave * 16384);
    unsigned char* ws = p.ws;
    bf16_t* W13 = (bf16_t*)(ws + WS_W13); bf16_t* W2 = (bf16_t*)(ws + WS_W2); bf16_t* WIN = (bf16_t*)(ws + WS_WIN); bf16_t* WOUT = (bf16_t*)(ws + WS_WOUT);
    constexpr int I_UP = 16 * 88, I_DN = 44 * 32, I_IN = 16 * 81, I_OUT = 16 * 32;
    constexpr int NIT = 4 * I_UP + 2 * I_DN + I_IN + I_OUT;
    for (int it = gw; it < NIT; it += NGW) {
        int r = it;
        if (r < 4 * I_UP) { const int seg = r / I_UP; r -= seg * I_UP; const int f = seg >> 1, is3 = seg & 1;
            const int kb = r / 88, nb = r % 88, n0 = nb * 32;
            const float* W = (is3 ? p.ffn_w3 : p.ffn_w1) + (size_t)(l * 2 + f) * DM * DFF;
            transpose_item(W, DM, DFF, W13 + (size_t)f * 5632 * DM, (n0 >> 7) * 256 + (n0 & 127) + is3 * 128 - n0, kb * 64, n0, scr, lane); continue; }
        r -= 4 * I_UP;
        if (r < 2 * I_DN) { const int f = r / I_DN; r -= f * I_DN; const int kb = r / 32, nb = r % 32;
            transpose_item(p.ffn_w2 + (size_t)(l * 2 + f) * DFF * DM, DFF, DM, W2 + (size_t)f * DM * DFF, 0, kb * 64, nb * 32, scr, lane); continue; }
        r -= 2 * I_DN;
        if (r < I_IN) { const int kb = r / 81, nb = r % 81;
            transpose_item(p.w_in + (size_t)l * DM * 2592, DM, 2592, WIN, 0, kb * 64, nb * 32, scr, lane); continue; }
        r -= I_IN;
        { const int kb = r / 32, nb = r % 32; transpose_item(p.w_out + (size_t)l * DM * DM, DM, DM, WOUT, 0, kb * 64, nb * 32, scr, lane); }
    }
}

__device__ __forceinline__ void phase_mods(PREF p, LAS unsigned char* lds, int tid, int wave, int lane) {
    LAS float* sS = (LAS float*)lds;
    LAS float* red = (LAS float*)(lds + 12288);
    float* mod = (float*)(p.ws + WS_MOD);
    for (int i = tid; i < 3072; i += NTHREADS) { const int g = i >> 10, k = i & 1023; const float xv = g < 2 ? p.c[g * 1024 + k] : p.c_ctx[k]; sS[i] = silu_f(xv); }
    __syncthreads();
    for (int item = blockIdx.x; item < NLAYER * 144; item += gridDim.x) {
        const int l = item / 144, nc = item % 144;
        const float* W = p.w_mod + (size_t)l * DM * (NMOD * DM) + nc * 64 + lane;
        float a0 = 0.f, a1 = 0.f, a2 = 0.f; const int k0 = wave * 128;
#pragma unroll 16
        for (int kk = 0; kk < 128; ++kk) { const int k = k0 + kk; const float w = W[(size_t)k * (NMOD * DM)]; a0 += sS[k] * w; a1 += sS[1024 + k] * w; a2 += sS[2048 + k] * w; }
        red[(wave * 3 + 0) * 64 + lane] = a0; red[(wave * 3 + 1) * 64 + lane] = a1; red[(wave * 3 + 2) * 64 + lane] = a2;
        __syncthreads();
        if (wave < 3) { float s = p.b_mod[l * (NMOD * DM) + nc * 64 + lane];
#pragma unroll
            for (int w = 0; w < 8; ++w) s += red[(w * 3 + wave) * 64 + lane];
            mod[(size_t)(l * 3 + wave) * (NMOD * DM) + nc * 64 + lane] = s; }
        __syncthreads();
    }
}

__device__ __forceinline__ void phase_gatew(PREF p, int gtid, int gthreads) {
    bf16_t* WgT = (bf16_t*)(p.ws + WS_WG);
    for (int e = gtid; e < NLAYER * 2 * 2 * 8 * 4096; e += gthreads) {
        const int i = e & 63, j = (e >> 6) & 63, h = (e >> 12) & 7, ty = (e >> 15) & 1, d = (e >> 16) & 1, l = e >> 17;
        const float* src = ty ? p.rg_wi : p.rg_wa;
        WgT[e] = (bf16_t)f2bf(src[(size_t)((l * 2 + d) * 8 + h) * 4096 + i * 64 + j]);
    }
}

__device__ __forceinline__ void phase_norm(PREF p, int l, int jn, int rbeg, int rend, bool first, int nsplit, int gw, int NGW, int lane) {
    const float* mod = (const float*)(p.ws + WS_MOD); const float* hctx = (const float*)(p.ws + WS_HCTX); bf16_t* U = (bf16_t*)(p.ws + WS_U); float* SS = (float*)(p.ws + WS_SS);
    const float* ng = p.norm_g + (size_t)(l * 3 + jn) * DM;
    for (int row = rbeg + gw; row < rend; row += NGW) {
        const float* src = row < TL ? ((first ? p.x : p.out) + (size_t)row * DM) : ((first ? p.ctx : hctx) + (size_t)(row - TL) * DM);
        const float* mb = mod + (size_t)(l * 3 + (row >> 14)) * (NMOD * DM);
        f32x4 v[4]; float ss = 0.f;
#pragma unroll
        for (int j = 0; j < 4; ++j) v[j] = *(const f32x4*)(src + 4 * lane + 256 * j);
        if (row >= TL && nsplit > 0) {
            const float* pr = (const float*)(p.ws + WS_PART) + (size_t)(row - TL) * DM + 4 * lane;
            for (int k = 0; k < nsplit; ++k)
#pragma unroll
                for (int j = 0; j < 4; ++j) v[j] += *(const f32x4*)(pr + (size_t)k * (TC * DM) + 256 * j);
            float* dst = (float*)(p.ws + WS_HCTX) + (size_t)(row - TL) * DM + 4 * lane;
#pragma unroll
            for (int j = 0; j < 4; ++j) *(f32x4*)(dst + 256 * j) = v[j];
        }
#pragma unroll
        for (int j = 0; j < 4; ++j) ss += (v[j][0] * v[j][0] + v[j][1] * v[j][1]) + (v[j][2] * v[j][2] + v[j][3] * v[j][3]);
        ss = wave_sum(ss, lane);
        if (lane == 0) ((float*)(p.ws + WS_RS))[row] = __builtin_amdgcn_rsqf(ss * (1.f / DM) + 1e-6f);
#pragma unroll
        for (int j = 0; j < 4; ++j) { const int col = 4 * lane + 256 * j;
            const f32x4 g = *(const f32x4*)(ng + col), sc = *(const f32x4*)(mb + (3 * jn + 1) * DM + col);
            const f32x4 o = v[j] * g * (sc + 1.f);
            u32x2 w; w.x = pk2(o[0], o[1]); w.y = pk2(o[2], o[3]);
            *(u32x2*)(U + (size_t)row * DM + col) = w; }
    }
}
__device__ __forceinline__ void phase_rs(PREF p, int gtid, int gthreads) {
    const float* SS = (const float*)(p.ws + WS_SS); float* RS = (float*)(p.ws + WS_RS);
    for (int row = gtid; row < TL; row += gthreads) {
        const f32x4 a = *(const f32x4*)(SS + (size_t)row * 16), b = *(const f32x4*)(SS + (size_t)row * 16 + 4), c = *(const f32x4*)(SS + (size_t)row * 16 + 8), d = *(const f32x4*)(SS + (size_t)row * 16 + 12);
        const float t = (((a[0] + a[1]) + (a[2] + a[3])) + ((b[0] + b[1]) + (b[2] + b[3]))) + (((c[0] + c[1]) + (c[2] + c[3])) + ((d[0] + d[1]) + (d[2] + d[3])));
        RS[row] = __builtin_amdgcn_rsqf(t * (1.f / DM) + 1e-6f);
    }
}
__device__ __forceinline__ void phase_bias(PREF p, int l, LAS unsigned char* lds, int tid, int wave, int lane) {
    LAS float* sS = (LAS float*)lds;
    LAS float* red = (LAS float*)(lds + 12288);
    const float* mod = (const float*)(p.ws + WS_MOD); float* BIAS = (float*)(p.ws + WS_BIAS);
    for (int item = blockIdx.x; item < 217; item += gridDim.x) {
        int mi, nc;
        if (item < 44) { mi = 0; nc = item; } else if (item < 88) { mi = 1; nc = item - 44; } else if (item < 129) { mi = 2; nc = item - 88; } else if (item < 173) { mi = 3; nc = item - 129; } else { mi = 4; nc = item - 173; }
        const int jn = mi < 2 ? 0 : (mi == 2 ? 1 : 2), slot = jn, boff = (mi == 1 || mi == 4) ? 2816 : 0, f = mi >= 3 ? 1 : 0;
        const int ldn = mi == 2 ? 2592 : DFF;
        const float* Wm = mi == 2 ? p.w_in + (size_t)l * DM * 2592 : ((mi == 1 || mi == 4) ? p.ffn_w3 : p.ffn_w1) + (size_t)(l * 2 + f) * DM * DFF;
        for (int i = tid; i < 3072; i += NTHREADS) { const int g = i >> 10, k = i & 1023; sS[i] = mod[(size_t)(l * 3 + g) * (NMOD * DM) + (3 * jn) * DM + k]; }
        __syncthreads();
        const int n = nc * 64 + lane; const bool nv = n < ldn;
        const float* W = Wm + (nv ? n : 0);
        float a0 = 0.f, a1 = 0.f, a2 = 0.f; const int k0 = wave * 128;
#pragma unroll 16
        for (int kk = 0; kk < 128; ++kk) { const int k = k0 + kk; const float w = W[(size_t)k * ldn]; a0 += sS[k] * w; a1 += sS[1024 + k] * w; a2 += sS[2048 + k] * w; }
        red[(wave * 3 + 0) * 64 + lane] = a0; red[(wave * 3 + 1) * 64 + lane] = a1; red[(wave * 3 + 2) * 64 + lane] = a2;
        __syncthreads();
        if (wave < 3 && nv) { float sum = 0.f;
#pragma unroll
            for (int w = 0; w < 8; ++w) sum += red[(w * 3 + wave) * 64 + lane];
            BIAS[(size_t)(slot * 3 + wave) * 5632 + boff + n] = sum; }
        __syncthreads();
    }
}
__device__ __forceinline__ void phase_final(PREF p, int gw, int NGW, int lane) {
    const bf16_t* U = (const bf16_t*)(p.ws + WS_U); const float* SS = (const float*)(p.ws + WS_SS);
    for (int row = gw; row < TL; row += NGW) {
        const f32x4 a = *(const f32x4*)(SS + (size_t)row * 16), b = *(const f32x4*)(SS + (size_t)row * 16 + 4), c = *(const f32x4*)(SS + (size_t)row * 16 + 8), d = *(const f32x4*)(SS + (size_t)row * 16 + 12);
        const float t = (((a[0] + a[1]) + (a[2] + a[3])) + ((b[0] + b[1]) + (b[2] + b[3]))) + (((c[0] + c[1]) + (c[2] + c[3])) + ((d[0] + d[1]) + (d[2] + d[3])));
        const float rs = __builtin_amdgcn_rsqf(t * (1.f / DM) + 1e-6f);
        u32x2 w[4];
#pragma unroll
        for (int j = 0; j < 4; ++j) w[j] = *(const u32x2*)(U + (size_t)row * DM + 4 * lane + 256 * j);
#pragma unroll
        for (int j = 0; j < 4; ++j) { f32x4 v; v[0] = bf2f(w[j].x & 0xffffu); v[1] = __builtin_bit_cast(float, w[j].x & 0xffff0000u); v[2] = bf2f(w[j].y & 0xffffu); v[3] = __builtin_bit_cast(float, w[j].y & 0xffff0000u);
            *(f32x4*)(p.out + (size_t)row * DM + 4 * lane + 256 * j) = v * rs; }
    }
}

__device__ __forceinline__ int scan_order(int d, int step) { return d == 0 ? step : (step < 4 ? 3 - step : 263 - step); }

template <bool FINAL, int D>
__device__ __forceinline__ void rg_dir(PREF p, int l, int h, int ch, int sidx, int rowbase  , LAS bf16_t* sXc, LAS float* stg, int lane) {
    const bf16_t* __restrict__ P = (const bf16_t*)(p.ws + WS_GP); const bf16_t* __restrict__ WgT = (const bf16_t*)(p.ws + WS_WG);
    float* __restrict__ RGA = (float*)(p.ws + WS_RGA); float* __restrict__ RGH = (float*)(p.ws + WS_RGH); const float* __restrict__ RGC = (const float*)(p.ws + WS_RGC);
    bf16_t* __restrict__ MIX = (bf16_t*)(p.ws + WS_MIX);
    bf16_t* __restrict__ TMP = (bf16_t*)(p.ws + WS_HB);
    const bf16_t* wr_ = WgT + (size_t)(((l * 2 + D) * 2 + 0) * 8 + h) * 4096; const bf16_t* wi_ = WgT + (size_t)(((l * 2 + D) * 2 + 1) * 8 + h) * 4096;
    const float ba = p.rg_ba[(l * 2 + D) * 512 + ch], bi = p.rg_bi[(l * 2 + D) * 512 + ch], lam = p.rg_lam[(l * 2 + D) * 512 + ch];
    const float e_ = __expf(-lam), u_ = 1.f + e_;
    const float l1p = (u_ == 1.f) ? e_ : __logf(u_) * e_ * rcpf_(u_ - 1.f);
    const float sp8 = -8.f * 1.4426950408889634f * l1p;
    float hc = FINAL ? RGC[sidx] : 0.f, Ap = 1.f;
    bf16x8 Br[4][2], Bi[4][2];
#pragma unroll
    for (int nt = 0; nt < 4; ++nt) { const int o0 = (nt * 16 + (lane & 15)) * 64 + (lane >> 4) * 8;
        Br[nt][0] = *(const bf16x8*)(wr_ + o0); Br[nt][1] = *(const bf16x8*)(wr_ + o0 + 32); Bi[nt][0] = *(const bf16x8*)(wi_ + o0); Bi[nt][1] = *(const bf16x8*)(wi_ + o0 + 32); }
    if (FINAL && D == 1) asm volatile("s_waitcnt vmcnt(0)" ::: "memory");
#pragma unroll 1
    for (int mi = 0; mi < 4; ++mi) { const int mt = D ? 3 - mi : mi;
        float grv[16], hfv[16];
        if (FINAL && D == 1) {
#pragma unroll
            for (int ti = 0; ti < 16; ++ti) { const size_t row = (size_t)(rowbase + mt * 16 + 15 - ti); grv[ti] = __builtin_bit_cast(float, (unsigned)P[row * PW + 512 + ch]); hfv[ti] = __builtin_bit_cast(float, (unsigned)TMP[row * 512 + ch]); }
            __builtin_amdgcn_sched_barrier(0);
#pragma unroll
            for (int ti = 0; ti < 16; ++ti) { grv[ti] = bf2f(__builtin_bit_cast(unsigned, grv[ti])); hfv[ti] = bf2f(__builtin_bit_cast(unsigned, hfv[ti])); }
        }
        const bf16x8 A0 = *(const LAS bf16x8*)(sXc + (mt * 16 + (lane & 15)) * 72 + (lane >> 4) * 8), A1 = *(const LAS bf16x8*)(sXc + (mt * 16 + (lane & 15)) * 72 + 32 + (lane >> 4) * 8);
        f32x4 ar[4], ai[4];
#pragma unroll
        for (int nt = 0; nt < 4; ++nt) { const f32x4 z = {0.f, 0.f, 0.f, 0.f};
            ar[nt] = mfma16(A0, Br[nt][0], z); ar[nt] = mfma16(A1, Br[nt][1], ar[nt]); ai[nt] = mfma16(A0, Bi[nt][0], z); ai[nt] = mfma16(A1, Bi[nt][1], ai[nt]); }
        WAVE_SYNC();
#pragma unroll
        for (int nt = 0; nt < 4; ++nt)
#pragma unroll
            for (int j = 0; j < 4; ++j) { const int o = ((lane >> 4) * 4 + j) * 64 + nt * 16 + (lane & 15); stg[o] = ar[nt][j]; stg[1024 + o] = ai[nt][j]; }
        WAVE_SYNC();
        float av[16], iv[16];
#pragma unroll
        for (int ti = 0; ti < 16; ++ti) { const int tk = D ? 15 - ti : ti;
            const float zr = stg[tk * 64 + lane] + ba, zi = stg[1024 + tk * 64 + lane] + bi;
            const float r = sigmoid_f(zr), ig = sigmoid_f(zi);
            const float a = __builtin_amdgcn_exp2f(r * sp8);
            const float xc = bf2f(sXc[(mt * 16 + tk) * 72 + lane]);
            av[ti] = a; iv[ti] = __builtin_amdgcn_sqrtf(fmaxf(1.f - a * a, 0.f)) * ig * xc;
            if (FINAL && D == 1) grv[ti] = gelu_tanh_f(grv[ti]);
        }
#pragma unroll
        for (int ti = 0; ti < 16; ++ti) { const int tk = D ? 15 - ti : ti;
            hc = av[ti] * hc + iv[ti]; Ap *= av[ti];
            if (FINAL) { const size_t row = (size_t)(rowbase + mt * 16 + tk);
                if (D == 0) TMP[row * 512 + ch] = (bf16_t)f2bf(hc);
                else MIX[row * DM + ch] = (bf16_t)f2bf(grv[ti] * (hfv[ti] + hc)); }
        }
    }
    if (!FINAL) { RGA[sidx] = Ap; RGH[sidx] = hc; }
}

template <bool FINAL>
__device__ __forceinline__ void rg_item(PREF p, int l, int item, LAS unsigned char* wl, int lane) {
    const bf16_t* __restrict__ P = (const bf16_t*)(p.ws + WS_GP);
    const int h = item & 7, rest = item >> 3;
    const int ci = rest < 512 ? 4 + (rest & 255) : ((rest - 512) & 3), b = rest < 512 ? (rest >> 8) : ((rest - 512) >> 2);
    const int seq_row0 = ci < 4 ? TL + b * 256 : b * 16384;
    const int t0 = ci < 4 ? ci * 64 : (ci - 4) * 64;
    const int seqlen = ci < 4 ? 256 : 16384;
    const int ch = h * 64 + lane;
    LAS bf16_t* sXc = (LAS bf16_t*)wl;
    LAS float* stg = (LAS float*)(wl + 9216);
    {
        const float cw0 = p.conv_w[(l * 4 + 0) * 512 + ch], cw1 = p.conv_w[(l * 4 + 1) * 512 + ch], cw2 = p.conv_w[(l * 4 + 2) * 512 + ch], cw3 = p.conv_w[(l * 4 + 3) * 512 + ch];
        const float cb = p.conv_b[l * 512 + ch];
        float xv[67]; unsigned xr_[67];
#pragma unroll
        for (int i = 0; i < 67; ++i) { const int t = t0 - 2 + i; const int tc = t < 0 ? 0 : (t >= seqlen ? seqlen - 1 : t);
            xr_[i] = P[(size_t)(seq_row0 + tc) * PW + ch]; }
        __builtin_amdgcn_sched_barrier(0);
#pragma unroll
        for (int i = 0; i < 67; ++i) { const int t = t0 - 2 + i; const int tc = t < 0 ? 0 : (t >= seqlen ? seqlen - 1 : t); xv[i] = (t == tc) ? bf2f(xr_[i]) : 0.f; }
#pragma unroll
        for (int tt = 0; tt < 64; ++tt) { const float xc = xv[tt] * cw0 + xv[tt + 1] * cw1 + xv[tt + 2] * cw2 + xv[tt + 3] * cw3 + cb; sXc[tt * 72 + lane] = (bf16_t)f2bf(xc); }
    }
    WAVE_SYNC();
    const int sidx0 = ((b * NCH + ci) * 2) * 512 + ch;
    rg_dir<FINAL, 0>(p, l, h, ch, sidx0, seq_row0 + t0, sXc, stg, lane);
    rg_dir<FINAL, 1>(p, l, h, ch, sidx0 + 512, seq_row0 + t0, sXc, stg, lane);
    WAVE_SYNC();
}

__device__ __forceinline__ void rg_carry(PREF p, int wave, int lane) {
    if (wave != 0 || blockIdx.x < 128 || blockIdx.x >= 160) return;
    const int gtid = ((int)blockIdx.x - 128) * 64 + lane;
    const float* __restrict__ RGA = (const float*)(p.ws + WS_RGA); const float* __restrict__ RGH = (const float*)(p.ws + WS_RGH); float* __restrict__ RGC = (float*)(p.ws + WS_RGC);
    const int b = gtid >> 10, d = (gtid >> 9) & 1, ch = gtid & 511;
    float h = 0.f;
    for (int s0 = 0; s0 < NCH; s0 += 26) {
        float av[26], hv[26];
#pragma unroll
        for (int k = 0; k < 26; ++k) { const int idx = ((b * NCH + scan_order(d, s0 + k)) * 2 + d) * 512 + ch; av[k] = RGA[idx]; hv[k] = RGH[idx]; }
#pragma unroll
        for (int k = 0; k < 26; ++k) { const int idx = ((b * NCH + scan_order(d, s0 + k)) * 2 + d) * 512 + ch; RGC[idx] = h; h = av[k] * h + hv[k]; }
    }
}

__device__ __forceinline__ void gla_rows(int b, int cj, int& row0, int& rstride) {
    if (cj < 4) { row0 = TL + b * 256 + cj * 64; rstride = 1; }
    else { const int q = cj - 4; row0 = b * 16384 + ((q & 3) * 64) * 64 + (q >> 2); rstride = 64; }
}

__device__ __forceinline__ void gl1_item(PREF p, int l, int item, bool valid, LAS unsigned char* pl, int sw, int lane) {
    const bf16_t* __restrict__ P = (const bf16_t*)(p.ws + WS_GP); bf16_t* __restrict__ QK = (bf16_t*)(p.ws + WS_QK);
    float* __restrict__ GLS = (float*)(p.ws + WS_GLS); float* __restrict__ GLD = (float*)(p.ws + WS_GLD);
    LAS bf16_t* sVt = (LAS bf16_t*)pl;
    LAS bf16_t* sKt = (LAS bf16_t*)(pl + 18432 + sw * 9216);
    LAS float* sD = (LAS float*)(pl + 36864 + sw * 256);
    const int d = sw;
    const int h = item & 3, rest = item >> 2;
    const int cj = rest < 512 ? 4 + (rest & 255) : ((rest - 512) & 3), b = rest < 512 ? (rest >> 8) : ((rest - 512) >> 2);
    int row0, rstride; gla_rows(b, cj, row0, rstride);
    const int seq = (b * 4 + h) * 2 + d;
    if (valid) {
        const bf16_t* prl = P + (size_t)(row0 + lane * rstride) * PW + 2560 + d * 16;
        const u32x4 lra = *(const u32x4*)prl, lrb = *(const u32x4*)(prl + 8);
        unsigned lrp[8] = {lra.x, lra.y, lra.z, lra.w, lrb.x, lrb.y, lrb.z, lrb.w};
        float qc[16], kc[16];
#pragma unroll
        for (int ss = 0; ss < 16; ++ss) { const int i = d ? 63 - ss : ss; const bf16_t* pr = P + (size_t)(row0 + i * rstride) * PW + h * 64 + lane;
            qc[ss] = __builtin_bit_cast(float, (unsigned)pr[1024]); kc[ss] = __builtin_bit_cast(float, (unsigned)pr[1280]); }
        __builtin_amdgcn_sched_barrier(0);
#pragma unroll
        for (int ss = 0; ss < 16; ++ss) { qc[ss] = bf2f(__builtin_bit_cast(unsigned, qc[ss])); kc[ss] = bf2f(__builtin_bit_cast(unsigned, kc[ss])); }
        unsigned wupp[8];
#pragma unroll
        for (int r2 = 0; r2 < 8; ++r2) wupp[r2] = pk2(p.gla_wup[(size_t)((l * 2 + d) * 16 + 2 * r2) * 256 + h * 64 + lane], p.gla_wup[(size_t)((l * 2 + d) * 16 + 2 * r2 + 1) * 256 + h * 64 + lane]);
        const float bup = p.gla_bup[(l * 2 + d) * 256 + h * 64 + lane];
#pragma unroll 1
        for (int g2 = 0; g2 < 2; ++g2) {
            unsigned vr[16];
#pragma unroll
            for (int ii = 0; ii < 16; ++ii) { const int i = 32 * sw + g2 * 16 + ii; vr[ii] = *(const unsigned*)(P + (size_t)(row0 + i * rstride) * PW + 1536 + h * 128 + 2 * lane); }
#pragma unroll
            for (int ii = 0; ii < 16; ++ii) { const int i = 32 * sw + g2 * 16 + ii; sVt[(2 * lane) * 72 + i] = (bf16_t)(vr[ii] & 0xffffu); sVt[(2 * lane + 1) * 72 + i] = (bf16_t)(vr[ii] >> 16); }
        }
        float bc = 0.f;
#pragma unroll 1
        for (int g4 = 0; g4 < 4; ++g4) {
            float qn[16], kn[16];
            if (g4 < 3) {
#pragma unroll
                for (int ss = 0; ss < 16; ++ss) { const int s = (g4 + 1) * 16 + ss; const int i = d ? 63 - s : s; const bf16_t* pr = P + (size_t)(row0 + i * rstride) * PW + h * 64 + lane;
                    qn[ss] = __builtin_bit_cast(float, (unsigned)pr[1024]); kn[ss] = __builtin_bit_cast(float, (unsigned)pr[1280]); }
                __builtin_amdgcn_sched_barrier(0);
            }
            float gv[16];
#pragma unroll
            for (int ss = 0; ss < 16; ++ss) { const int s = g4 * 16 + ss; const int i = d ? 63 - s : s;
                float z = bup;
#pragma unroll
                for (int r2 = 0; r2 < 8; ++r2) { const unsigned w = (unsigned)__builtin_amdgcn_readlane((int)lrp[r2], i);
                    z = __builtin_amdgcn_fdot2_f32_bf16(__builtin_bit_cast(bf16x2_t, w), __builtin_bit_cast(bf16x2_t, wupp[r2]), z, false); }
                gv[ss] = -(fmaxf(-z, 0.f) + __logf(1.f + __expf(-fabsf(z)))) * (1.f / 16.f);
                __builtin_amdgcn_sched_barrier(0);
            }
#pragma unroll
            for (int ss = 0; ss < 16; ++ss) { const int s = g4 * 16 + ss; const int i = d ? 63 - s : s; const size_t rowi = (size_t)(row0 + i * rstride);
                bc += gv[ss];
                const float en = __expf(-bc), ep = __expf(bc);
                const float kt = kc[ss] * en, qt = qc[ss] * 0.125f * ep;
                const unsigned ktb = f2bf(kt);
                sKt[lane * 72 + i] = (bf16_t)ktb;
                QK[rowi * 1024 + d * 512 + h * 64 + lane] = (bf16_t)f2bf(qt);
                QK[rowi * 1024 + d * 512 + 256 + h * 64 + lane] = (bf16_t)ktb;
            }
#pragma unroll
            for (int ss = 0; ss < 16; ++ss) { qc[ss] = bf2f(__builtin_bit_cast(unsigned, qn[ss])); kc[ss] = bf2f(__builtin_bit_cast(unsigned, kn[ss])); }
        }
        const float Dv = __expf(bc);
        sD[lane] = Dv; GLD[(size_t)(seq * NCH + cj) * 64 + lane] = Dv;
    }
    __syncthreads();
    if (valid) {
        bf16x8 Ak[4][2]; f32x4 Dm[4];
#pragma unroll
        for (int mt = 0; mt < 4; ++mt) { Dm[mt] = *(const LAS f32x4*)(sD + mt * 16 + (lane >> 4) * 4);
#pragma unroll
            for (int ks = 0; ks < 2; ++ks) Ak[mt][ks] = *(const LAS bf16x8*)(sKt + (mt * 16 + (lane & 15)) * 72 + ks * 32 + (lane >> 4) * 8); }
        bf16_t* So = (bf16_t*)GLS + (size_t)(seq * NCH + cj) * 8192;
#pragma unroll 2
        for (int nt = 0; nt < 8; ++nt) {
            const bf16x8 B0 = *(const LAS bf16x8*)(sVt + (nt * 16 + (lane & 15)) * 72 + (lane >> 4) * 8), B1 = *(const LAS bf16x8*)(sVt + (nt * 16 + (lane & 15)) * 72 + 32 + (lane >> 4) * 8);
#pragma unroll
            for (int mt = 0; mt < 4; ++mt) { f32x4 acc = {0.f, 0.f, 0.f, 0.f}; acc = mfma16(Ak[mt][0], B0, acc); acc = mfma16(Ak[mt][1], B1, acc);
                acc = acc * Dm[mt];
                u32x2 w; w.x = pk2(acc[0], acc[1]); w.y = pk2(acc[2], acc[3]);
                *(u32x2*)(So + (nt * 16 + (lane & 15)) * 64 + mt * 16 + (lane >> 4) * 4) = w; }
        }
    }
    __syncthreads();
}

__device__ __forceinline__ void gl2_scan(PREF p, int gtid, int gthreads) {
    unsigned* __restrict__ GLS = (unsigned*)(p.ws + WS_GLS); const float* __restrict__ GLD = (const float*)(p.ws + WS_GLD);
    for (int g = gtid; g < 16 * 4096; g += gthreads) {
        const int seq = g >> 12, e2 = g & 4095, kk = (e2 * 2) & 63, d = seq & 1;
        float S0 = 0.f, S1 = 0.f;
        for (int s0 = 0; s0 < NCH; s0 += 20) {
            unsigned dv[20]; float D0[20], D1[20];
#pragma unroll
            for (int k = 0; k < 20; ++k) { const int cj = scan_order(d, s0 + k); dv[k] = GLS[(size_t)(seq * NCH + cj) * 4096 + e2];
                const float* dp = GLD + (size_t)(seq * NCH + cj) * 64 + kk; D0[k] = dp[0]; D1[k] = dp[1]; }
#pragma unroll
            for (int k = 0; k < 20; ++k) { const int cj = scan_order(d, s0 + k); GLS[(size_t)(seq * NCH + cj) * 4096 + e2] = pk2(S0, S1);
                S0 = D0[k] * S0 + bf2f(dv[k] & 0xffffu); S1 = D1[k] * S1 + __builtin_bit_cast(float, dv[k] & 0xffff0000u); }
        }
    }
}

__device__ __forceinline__ void gl3_item(PREF p, int l, int item, bool valid, LAS unsigned char* sl, int w4, int t256, int lane) {
    const bf16_t* __restrict__ P = (const bf16_t*)(p.ws + WS_GP); const bf16_t* __restrict__ QK = (const bf16_t*)(p.ws + WS_QK);
    const float* __restrict__ GLS = (const float*)(p.ws + WS_GLS); bf16_t* __restrict__ MIX = (bf16_t*)(p.ws + WS_MIX);
    LAS bf16_t* sVt = (LAS bf16_t*)sl;
    LAS bf16_t* sS = (LAS bf16_t*)(sl + 18432);
    LAS bf16_t* sAtt = (LAS bf16_t*)(sl + 55296);
    const int h = item & 3, rest = item >> 2;
    const int cj = rest < 512 ? 4 + (rest & 255) : ((rest - 512) & 3), b = rest < 512 ? (rest >> 8) : ((rest - 512) >> 2);
    int row0, rstride; gla_rows(b, cj, row0, rstride);
    f32x4 o[8];
#pragma unroll
    for (int nt = 0; nt < 8; ++nt) o[nt] = (f32x4){0.f, 0.f, 0.f, 0.f};
    bf16x8 Aq[2][2], Bk[4][2];
    const size_t rowi_a = (size_t)(row0 + (16 * w4 + (lane & 15)) * rstride);
    if (valid) {
        unsigned vr[16]; u32x4 sv[2][4];
#pragma unroll
        for (int ii = 0; ii < 16; ++ii) { const int i = 16 * w4 + ii; vr[ii] = *(const unsigned*)(P + (size_t)(row0 + i * rstride) * PW + 1536 + h * 128 + 2 * lane); }
#pragma unroll
        for (int d = 0; d < 2; ++d) { const bf16_t* Sg = (const bf16_t*)GLS + (size_t)(((b * 4 + h) * 2 + d) * NCH + cj) * 8192;
#pragma unroll
            for (int r = 0; r < 4; ++r) sv[d][r] = *(const u32x4*)(Sg + (r * 256 + t256) * 8); }
#pragma unroll
        for (int d = 0; d < 2; ++d)
#pragma unroll
            for (int ks = 0; ks < 2; ++ks) Aq[d][ks] = *(const bf16x8*)(QK + rowi_a * 1024 + d * 512 + h * 64 + ks * 32 + (lane >> 4) * 8);
#pragma unroll
        for (int nt = 0; nt < 4; ++nt) { const size_t rows = (size_t)(row0 + (nt * 16 + (lane & 15)) * rstride);
#pragma unroll
            for (int ks = 0; ks < 2; ++ks) Bk[nt][ks] = *(const bf16x8*)(QK + rows * 1024 + 256 + h * 64 + ks * 32 + (lane >> 4) * 8); }
#pragma unroll
        for (int ii = 0; ii < 16; ++ii) { const int i = 16 * w4 + ii; sVt[(2 * lane) * 72 + i] = (bf16_t)(vr[ii] & 0xffffu); sVt[(2 * lane + 1) * 72 + i] = (bf16_t)(vr[ii] >> 16); }
#pragma unroll
        for (int d = 0; d < 2; ++d)
#pragma unroll
            for (int r = 0; r < 4; ++r) { const int e = (r * 256 + t256) * 8; *(LAS u32x4*)(sS + d * 9216 + (e >> 6) * 72 + (e & 63)) = sv[d][r]; }
    }
    __syncthreads();
    if (valid) {
#pragma unroll
        for (int d = 0; d < 2; ++d) {
            f32x4 att[4];
#pragma unroll
            for (int nt = 0; nt < 4; ++nt) { att[nt] = (f32x4){0.f, 0.f, 0.f, 0.f};
#pragma unroll
                for (int ks = 0; ks < 2; ++ks) att[nt] = mfma16(Aq[d][ks], Bk[nt][ks], att[nt]); }
            if (d == 0) {
#pragma unroll
                for (int nt = 0; nt < 4; ++nt) { const size_t rows = (size_t)(row0 + (nt * 16 + (lane & 15)) * rstride);
#pragma unroll
                    for (int ks = 0; ks < 2; ++ks) Bk[nt][ks] = *(const bf16x8*)(QK + rows * 1024 + 512 + 256 + h * 64 + ks * 32 + (lane >> 4) * 8); }
            }
            WAVE_SYNC();
#pragma unroll
            for (int nt = 0; nt < 4; ++nt)
#pragma unroll
                for (int j = 0; j < 4; ++j) { const int i_ = 16 * w4 + (lane >> 4) * 4 + j, s_ = nt * 16 + (lane & 15); const bool keep = d == 0 ? (s_ <= i_) : (s_ >= i_);
                    sAtt[i_ * 72 + s_] = keep ? (bf16_t)f2bf(att[nt][j]) : (bf16_t)0; }
            WAVE_SYNC();
            bf16x8 Aa[2];
#pragma unroll
            for (int ks = 0; ks < 2; ++ks) Aa[ks] = *(const LAS bf16x8*)(sAtt + (16 * w4 + (lane & 15)) * 72 + ks * 32 + (lane >> 4) * 8);
#pragma unroll
            for (int nt = 0; nt < 8; ++nt)
#pragma unroll
                for (int ks = 0; ks < 2; ++ks) { const int bo = (nt * 16 + (lane & 15)) * 72 + ks * 32 + (lane >> 4) * 8;
                    o[nt] = mfma16(Aa[ks], *(const LAS bf16x8*)(sVt + bo), o[nt]); o[nt] = mfma16(Aq[d][ks], *(const LAS bf16x8*)(sS + d * 9216 + bo), o[nt]); }
        }
        const float* gn = p.gla_norm_g + l * 512 + h * 128;
        unsigned ogr[4][8];
#pragma unroll
        for (int j = 0; j < 4; ++j) { const size_t rowi = (size_t)(row0 + (16 * w4 + (lane >> 4) * 4 + j) * rstride);
#pragma unroll
            for (int nt = 0; nt < 8; ++nt) ogr[j][nt] = P[rowi * PW + 2048 + h * 128 + nt * 16 + (lane & 15)]; }
        __builtin_amdgcn_sched_barrier(0);
#pragma unroll
        for (int j = 0; j < 4; ++j) {
            float ss = 0.f;
#pragma unroll
            for (int nt = 0; nt < 8; ++nt) ss += o[nt][j] * o[nt][j];
            ss += shx(ss, 1, lane); ss += shx(ss, 2, lane); ss += shx(ss, 4, lane); ss += shx(ss, 8, lane);
            const float rs = __builtin_amdgcn_rsqf(ss * (1.f / 128.f) + 1e-6f);
            const size_t rowi = (size_t)(row0 + (16 * w4 + (lane >> 4) * 4 + j) * rstride);
            float ogv[8];
#pragma unroll
            for (int nt = 0; nt < 8; ++nt) ogv[nt] = bf2f(ogr[j][nt]);
#pragma unroll
            for (int nt = 0; nt < 8; ++nt) { const int vv = nt * 16 + (lane & 15);
                MIX[rowi * DM + 512 + h * 128 + vv] = (bf16_t)f2bf(o[nt][j] * rs * gn[vv] * silu_f(ogv[nt])); }
        }
    }
    __syncthreads();
}

#define XB_TMO      128
#define XB_XCNT(j)  (256  + 64 * (j))
#define XB_XSUB(j)  (1280 + 64 * (j))
#define XB_XGEN(j)  (2304 + 64 * (j))
#define XB_TOP      3328
#define XB_TOPGEN   3392
#define XCD_BAR_WORDS 3456
#define XB_SPIN_CAP (1u << 18)

__device__ __forceinline__ unsigned xb_ld(unsigned* p)              { return __hip_atomic_load(p, __ATOMIC_RELAXED, __HIP_MEMORY_SCOPE_AGENT); }
__device__ __forceinline__ unsigned xb_add(unsigned* p, unsigned v) { return __hip_atomic_fetch_add(p, v, __ATOMIC_RELAXED, __HIP_MEMORY_SCOPE_AGENT); }
__device__ __forceinline__ unsigned xb_xcc_id() { return (unsigned)__builtin_amdgcn_s_getreg((3 << 11) | 20) & 0xFu; }
#define XB_SPIN(cond, bar) do { unsigned _sp = 0; while (cond) { __builtin_amdgcn_s_sleep(1); \
    if ((++_sp & 255u) == 0u) { if (xb_ld(&(bar)[XB_TMO])) break; if (_sp > XB_SPIN_CAP) { atomicAdd(&(bar)[XB_TMO], 1u); break; } } } } while (0)

struct XcdBarrier {
    unsigned* bar; unsigned x;
    volatile LAS unsigned* st;
};

__device__ __forceinline__ XcdBarrier xcd_barrier_post(unsigned* bar, volatile LAS unsigned* st) {
    XcdBarrier b; b.bar = bar; b.x = xb_xcc_id(); b.st = st;
    if (threadIdx.x == 0) (void)xb_add(&bar[XB_XCNT(b.x)], 1u);
    return b;
}
__device__ __forceinline__ void xcd_barrier_complete(unsigned* bar, unsigned x, unsigned& nloc, unsigned& nx) {
    const unsigned G = gridDim.x * gridDim.y * gridDim.z;
    unsigned sum, cnt, mine, sp = 0u;
    for (;;) {
        sum = 0u; cnt = 0u; mine = 0u;
#pragma unroll
        for (unsigned j = 0; j < 16; ++j) { const unsigned c = xb_ld(&bar[XB_XCNT(j)]); sum += c; cnt += (c > 0u) ? 1u : 0u; mine = (j == x) ? c : mine; }
        if (sum == G) break;
        __builtin_amdgcn_s_sleep(1);
        if ((++sp & 255u) == 0u) { if (xb_ld(&bar[XB_TMO])) break; if (sp > XB_SPIN_CAP) { atomicAdd(&bar[XB_TMO], 1u); break; } }
    }
    nloc = mine > 0u ? mine : 1u; nx = cnt > 0u ? cnt : 1u;
}

__device__ __forceinline__ void xcd_barrier(const XcdBarrier& b, int xb_tid) {
    asm volatile("s_waitcnt vmcnt(0)" ::: "memory");
    __syncthreads();
    if (xb_tid == 0) {
        unsigned* bar = b.bar;
        __builtin_amdgcn_s_waitcnt(0);
        unsigned nloc = b.st[0], nx = b.st[1];
        if (nloc == 0u) { xcd_barrier_complete(bar, b.x, nloc, nx); b.st[0] = nloc; b.st[1] = nx; }
        const unsigned old = xb_add(&bar[XB_XSUB(b.x)], 1u);
        const unsigned gen = old / nloc;
        if (old + 1u == (gen + 1u) * nloc) {
            __builtin_amdgcn_fence(__ATOMIC_RELEASE, "agent");
            asm volatile("s_waitcnt vmcnt(0)" ::: "memory");
            const unsigned og = xb_add(&bar[XB_TOP], 1u);
            const unsigned tg = og / nx;
            if (og + 1u == (tg + 1u) * nx) xb_add(&bar[XB_TOPGEN], 1u);
            else XB_SPIN(xb_ld(&bar[XB_TOPGEN]) == tg, bar);
            __builtin_amdgcn_fence(__ATOMIC_ACQUIRE, "agent");
            xb_add(&bar[XB_XGEN(b.x)], 1u);
            asm volatile("s_waitcnt vmcnt(0)" ::: "memory");
        } else {
            XB_SPIN(xb_ld(&bar[XB_XGEN(b.x)]) == gen, bar);
            __builtin_amdgcn_fence(__ATOMIC_ACQUIRE, "agent");
            asm volatile("s_waitcnt vmcnt(0)" ::: "memory");
        }
    }
    __syncthreads();
}

__device__ __forceinline__ int lane_id_volatile() { int l; asm volatile("v_mbcnt_lo_u32_b32 %0, -1, 0\n\tv_mbcnt_hi_u32_b32 %0, -1, %0" : "=v"(l)); return l; }
__global__ void __launch_bounds__(NTHREADS, 2) mega_fwd(Params p_arg) {
    extern __shared__ __attribute__((aligned(16))) unsigned char lds_raw[];
    LAS unsigned char* lds = (LAS unsigned char*)lds_raw;
    cg::grid_group grid = cg::this_grid();
    const int G = gridDim.x, NGW = G * 8, gthreads = G * NTHREADS;
    const int wave_s = __builtin_amdgcn_readfirstlane((int)threadIdx.x >> 6);
#define MYTID() (wave_s * 64 + lane_id_volatile())
    volatile LAS unsigned* bst = (volatile LAS unsigned*)(lds + LDS_BYTES - 64);
    if (threadIdx.x < 2) bst[threadIdx.x] = 0u;
    if (blockIdx.x == 0) { unsigned* bw = (unsigned*)(p_arg.ws + WS_BAR); for (int i = threadIdx.x; i < XCD_BAR_WORDS; i += NTHREADS) bw[i] = 0u; }
#define KARGS() const __attribute__((address_space(4))) Params* pk_ = (const __attribute__((address_space(4))) Params*)__builtin_amdgcn_kernarg_segment_ptr(); asm volatile("" : "+s"(pk_)); PREF p = *pk_;

    {
    KARGS();
    const int tid = threadIdx.x, lane = tid & 63, wave = __builtin_amdgcn_readfirstlane(tid >> 6);
    const int gw = blockIdx.x * 8 + wave, gtid = blockIdx.x * NTHREADS + tid;
    phase_mods(p, lds, tid, wave, lane);
    phase_gatew(p, gtid, gthreads);
    { float* z_ = (float*)(p.ws + WS_MOD + 768 * 1024); for (int i = gtid; i < 2 * NMOD * DM; i += gthreads) z_[i] = 0.f; }
    { float* hc_ = (float*)(p.ws + WS_HCTX); for (int i = gtid; i < TC * DM / 4; i += gthreads) ((f32x4*)hc_)[i] = ((const f32x4*)p.ctx)[i]; }
    __syncthreads();
    convert_weights(p, 0, lds, gw, NGW, wave, lane);
    }
    grid.sync();
    (void)xcd_barrier_post((unsigned*)(p_arg.ws + WS_BAR), bst);

    for (int st = 0; st < NLAYER * 12; ++st) {
#ifndef DUP_MASK
#define DUP_MASK 0
#endif
        const int s_ = st % 12;
        const int sbit = (s_ == 0 || s_ == 3 || s_ == 9) ? 1 : (s_ == 1 || s_ == 10) ? 2 : (s_ == 4) ? 4 : (s_ == 5) ? 8 : (s_ == 7) ? 16 : 0;
        const int nrep = (DUP_MASK & sbit) ? 2 : 1;
        for (int rep = 0; rep < nrep; ++rep) {
        KARGS();
        unsigned char* ws = p.ws;
        bf16_t* U = (bf16_t*)(ws + WS_U); bf16_t* MIX = (bf16_t*)(ws + WS_MIX); bf16_t* GP = (bf16_t*)(ws + WS_GP);
        float* hctx = (float*)(ws + WS_HCTX); const float* mod = (const float*)(ws + WS_MOD);
#define PHASE_IDS() const int tid = MYTID(); const int lane = tid & 63, wave = __builtin_amdgcn_readfirstlane(tid >> 6); const int gw = blockIdx.x * 8 + wave, gtid = blockIdx.x * NTHREADS + tid; (void)gw; (void)gtid; (void)lane;
        const int l = st / 12, s = st % 12;
        const bool lastl = (l == NLAYER - 1);
        const int rows = (lastl && s >= 8) ? TL : TT;
        switch (s) {
        case 0: case 3: case 9: {
            PHASE_IDS();
            const int jn = s == 0 ? 0 : (s == 3 ? 1 : 2);
            if (s == 0) { phase_bias(p, l, lds, tid, wave, lane); if (l > 0) convert_weights(p, l, lds, gw, NGW, wave, lane); }
            if (st != 0) phase_rs(p, gtid, gthreads);
            phase_norm(p, l, jn, st == 0 ? 0 : TL, rows, st == 0, s == 0 ? (l > 0 ? DFF / 256 : 0) : (s == 3 ? DFF / 256 : DM / 256), gw, NGW, lane);
        } break;
        case 1: case 10: {
            PHASE_IDS();
            const int f = s == 1 ? 0 : 1;
            pg8::Gemm g{U, (const bf16_t*)(ws + WS_W13) + (size_t)f * 5632 * DM, rows, 5632, DM, DM};
            pg8::StaticOrder S; S.init(rows, 5632, G, (int)blockIdx.x);
            LAS float* side = (LAS float*)(lds + 131072);
            {
                const float* RSg = (const float*)(ws + WS_RS); const float* Bg = (const float*)(ws + WS_BIAS) + (size_t)(f ? 2 : 0) * 3 * 5632;
                pg8::Unit uu;
                for (int i = 0; S.next(i, uu); ++i) {
                    float v;
                    if (tid < 256) v = RSg[uu.pm * 256 + tid];
                    else { const int c = tid - 256; v = Bg[(size_t)((uu.pm * 256) >> 14) * 5632 + (c < 128 ? uu.pn * 128 + c : 2816 + uu.pn * 128 + c - 128)]; }
                    side[i * 512 + tid] = v;
                }
                __syncthreads();
            }
            EpiSwiglu E{GP, side, 0};
            pg8::gemm_phase<EpiSwiglu, pg8::StaticOrder, true, true>(lds, g, S, E, tid);
        } break;
        case 2: case 8: case 11: {
            PHASE_IDS();
            const bool isout = (s == 8);
            const int f = s == 2 ? 0 : 1;
            const int Kd = isout ? DM : DFF;
            const bf16_t* Ad = isout ? MIX : GP; const bf16_t* Bd = isout ? (const bf16_t*)(ws + WS_WOUT) : (const bf16_t*)(ws + WS_W2) + (size_t)f * DM * DFF;
            const int gidx = s == 2 ? 2 : (s == 8 ? 5 : 8);
            const bool first = (st == 2);
            const float* gate = mod + (size_t)l * 3 * (NMOD * DM) + gidx * DM; const float coef = isout ? 1.f : 0.5f;
            pg8::Gemm g{Ad, Bd, rows, DM, Kd, Kd};
            DownOrder S; S.so.init(TL, DM, G, (int)blockIdx.x); S.sk.init(TL / 256, TC / 256, DM / 256, Kd / 256, 256, G, (int)blockIdx.x); S.nlat = (TL / 256) * (DM / 256); S.nctx = rows == TT ? S.sk.nun : 0; S.inv = isout ? 16384 : 5958;
            const int ln = s == 11 ? l + 1 : l, jnn = s == 2 ? 1 : (s == 8 ? 2 : 0), jp = s == 2 ? 0 : (s == 8 ? 1 : 2);
            const bool emit = ln < NLAYER;
            EpiResid E{ws, gate, p.norm_g + (size_t)(l * 3 + jp) * DM, mod + (size_t)l * 3 * (NMOD * DM) + (3 * jp + 1) * DM,
                       emit ? p.norm_g + (size_t)(ln * 3 + jnn) * DM : p.final_g, emit ? mod + (size_t)ln * 3 * (NMOD * DM) + (3 * jnn + 1) * DM : (const float*)(ws + WS_MOD + 768 * 1024), coef, 1};
            pg8::gemm_phase<EpiResid, DownOrder, true, true>(lds, g, S, E, tid);
        } break;
        case 4: {
            PHASE_IDS();
            pg8::Gemm g{U, (const bf16_t*)(ws + WS_WIN), rows, PW, DM, DM};
            pg8::StaticOrder S; S.init(rows, PW, G, (int)blockIdx.x);
            EpiStore E{GP, PW, (const float*)(ws + WS_RS), (const float*)(ws + WS_BIAS) + (size_t)1 * 3 * 5632};
            pg8::gemm_phase<EpiStore, pg8::StaticOrder, true, true>(lds, g, S, E, tid);
        } break;
        case 5: {
            PHASE_IDS();
            for (int r2 = 0; r2 < ((DUP_MASK & 32) ? 2 : 1); ++r2)
            for (int item = gw; item < 2 * NCH * 8; item += NGW) rg_item<false>(p, l, item, lds + wave * 18432, lane);
            __syncthreads();
            const int NP = G * 4, pgid = NP - 1 - (blockIdx.x * 4 + (wave >> 1));
            for (int r2 = 0; r2 < ((DUP_MASK & (64 | 128)) ? 2 : 1); ++r2)
            for (int it = 0; it * NP < 2 * NCH * 4; ++it) { const int item = it * NP + pgid; gl1_item(p, l, item, item < 2 * NCH * 4, lds + (wave >> 1) * 37376, wave & 1, lane); }
        } break;
        case 6: {
            PHASE_IDS();
            rg_carry(p, wave, lane);
            gl2_scan(p, gtid, gthreads);
        } break;
        case 7: {
            PHASE_IDS();
            const int nrg = lastl ? 2 * 256 * 8 : 2 * NCH * 8, ngl = lastl ? 2 * 256 * 4 : 2 * NCH * 4;
            for (int item = gw; item < nrg; item += NGW) rg_item<true>(p, l, item, lds + wave * 18432, lane);
            __syncthreads();
            const int NS = G * 2, sgid = NS - 1 - (blockIdx.x * 2 + (wave >> 2));
            for (int r2 = 0; r2 < ((DUP_MASK & (64 | 256)) ? 2 : 1); ++r2)
            for (int it = 0; it * NS < ngl; ++it) { const int item = it * NS + sgid; gl3_item(p, l, item, item < ngl, lds + (wave >> 2) * 64512, wave & 3, tid & 255, lane); }
        } break;
        }
        { XcdBarrier xb_; xb_.bar = (unsigned*)(p.ws + WS_BAR); xb_.x = xb_xcc_id(); xb_.st = (volatile LAS unsigned*)(lds + LDS_BYTES - 64); xcd_barrier(xb_, MYTID()); }
        }
    }
    { KARGS(); const int tid = MYTID(), lane = tid & 63, wave = __builtin_amdgcn_readfirstlane(tid >> 6); phase_final(p, blockIdx.x * 8 + wave, NGW, lane); }
}

extern "C" void kernel_launch(void* const* d_in, const int* in_sizes, int n_in, void* d_out, int out_size, void* d_ws, size_t ws_size, hipStream_t stream) {
    static int grid_blocks = 0;
    if (grid_blocks == 0) {
        if (n_in != 23 || ws_size < WS_END) { fprintf(stderr, "kernel_launch: unexpected n_in %d or ws_size %zu (< %zu)\n", n_in, ws_size, (size_t)WS_END); grid_blocks = -1; return; }
        int dev = 0, cus = 0, per_cu = 0;
        hipGetDevice(&dev);
        hipDeviceGetAttribute(&cus, hipDeviceAttributeMultiprocessorCount, dev);
        if (hipFuncSetAttribute((const void*)mega_fwd, hipFuncAttributeMaxDynamicSharedMemorySize, LDS_BYTES) != hipSuccess) { fprintf(stderr, "kernel_launch: hipFuncSetAttribute failed\n"); grid_blocks = -1; return; }
        if (hipOccupancyMaxActiveBlocksPerMultiprocessor(&per_cu, (const void*)mega_fwd, NTHREADS, LDS_BYTES) != hipSuccess || per_cu < 1) { fprintf(stderr, "kernel_launch: occupancy query says %d\n", per_cu); per_cu = 1; }
        (void)hipGetLastError();
        grid_blocks = cus;
    }
    if (grid_blocks < 0) return;
    Params p{};
    const float** pp = (const float**)&p;
    for (int i = 0; i < 23; ++i) pp[i] = (const float*)d_in[i];
    p.out = (float*)d_out; p.ws = (unsigned char*)d_ws;
    void* args[] = {&p};
    hipError_t e = hipLaunchCooperativeKernel((const void*)mega_fwd, dim3(grid_blocks), dim3(NTHREADS), args, LDS_BYTES, stream);
    if (e != hipSuccess) fprintf(stderr, "cooperative launch failed: %s (grid %d)\n", hipGetErrorString(e), grid_blocks);
}
```
